# Optimizing an MI355X kernel written in HIP

```python
import math
import jax, jax.numpy as jnp
from jax import lax
import numpy as np

D_MODEL = 1024
BATCH = 32
SEQ = 256
DEPTH = 2
DEC_BATCH = 4
DEC_SEQ = 2048
PAST_LEN = 512

GRID_W = 64
HEAD_DIM = 64
BRANCH_W = 256
N_BRANCH = 4
Q_BLOCK = 128
A_HEADS = 4
A_KV_HEADS = 2
A_GROUP = A_HEADS // A_KV_HEADS
A_WINDOW = 128
MLA_HEADS = 4
MLA_Q_LORA = 256
MLA_KV_LORA = 128
MLA_NOPE = 64
MLA_ROPE = 32
MLA_V = 64
S5_CH = 16
S5_GROUPS = BRANCH_W // S5_CH
S5_STATE = 64
NAT_HEADS = 4
NAT_ROWS = 8
NAT_COLS = 16
ROPE_BASE = 10000.0
EPS = 1e-6
NEG = -1e30
IN_SIZES = (A_HEADS * HEAD_DIM, A_KV_HEADS * HEAD_DIM, A_KV_HEADS * HEAD_DIM, BRANCH_W,
            MLA_Q_LORA, MLA_KV_LORA, MLA_ROPE, BRANCH_W,
            BRANCH_W, BRANCH_W,
            NAT_HEADS * HEAD_DIM, NAT_HEADS * HEAD_DIM, NAT_HEADS * HEAD_DIM, BRANCH_W)
IN_COLS = sum(IN_SIZES)

kernel_name = 'hybrid_diffusion_prefix_trunk'


def rmsnorm(x, g):
    x32 = x.astype(jnp.float32)
    y = x32 * lax.rsqrt(jnp.mean(x32 * x32, axis=-1, keepdims=True) + EPS)
    return (y * g.astype(jnp.float32)).astype(x.dtype)


def rope_1d(x, pos):
    half = x.shape[-1] // 2
    inv = ROPE_BASE ** (-jnp.arange(half, dtype=jnp.float32) / half)
    ang = pos[:, None] * inv[None, :]
    cos = jnp.cos(ang)[:, None, :]
    sin = jnp.sin(ang)[:, None, :]
    x32 = x.astype(jnp.float32)
    x1, x2 = x32[..., :half], x32[..., half:]
    return jnp.concatenate([x1 * cos - x2 * sin, x1 * sin + x2 * cos], axis=-1).astype(x.dtype)


def axial_rope(x):
    L = x.shape[1]
    t = jnp.arange(L)
    row = (t // GRID_W).astype(jnp.float32)
    col = (t % GRID_W).astype(jnp.float32)
    half = x.shape[-1] // 2
    return jnp.concatenate([rope_1d(x[..., :half], row), rope_1d(x[..., half:], col)], axis=-1)


def softmax_sink(s, sink_col):
    m = jnp.maximum(jnp.max(s, axis=-1, keepdims=True), sink_col)
    e = jnp.exp(s - m)
    return e / (jnp.sum(e, axis=-1, keepdims=True) + jnp.exp(sink_col - m))


def dense_attention(q, k, v, sink=None):
    B, Lq, Hk, G, dq = q.shape
    nb = Lq // Q_BLOCK
    scale = dq ** -0.5
    qb = jnp.moveaxis(q.reshape(B, nb, Q_BLOCK, Hk, G, dq), 1, 0)

    def block(qi):
        s = jnp.einsum('bqhgd,bkhd->bhgqk', qi, k).astype(jnp.float32) * scale
        if sink is None:
            p = jax.nn.softmax(s, axis=-1)
        else:
            p = softmax_sink(s, sink.astype(jnp.float32).reshape(Hk, G)[None, :, :, None, None])
        return jnp.einsum('bhgqk,bkhd->bqhgd', p.astype(v.dtype), v)

    o = lax.map(block, qb)
    return jnp.moveaxis(o, 0, 1).reshape(B, Lq, Hk * G * v.shape[-1])


def window_attention_latent(q, k, v, k_ctx, v_ctx, sink):
    B, L, Hk, G, d = q.shape
    nb = L // Q_BLOCK
    scale = d ** -0.5
    pad = ((0, 0), (Q_BLOCK, Q_BLOCK), (0, 0), (0, 0))
    kp = jnp.pad(k, pad).reshape(B, nb + 2, Q_BLOCK, Hk, d)
    vp = jnp.pad(v, pad).reshape(B, nb + 2, Q_BLOCK, Hk, d)
    kw = jnp.concatenate([kp[:, :-2], kp[:, 1:-1], kp[:, 2:]], axis=2)
    vw = jnp.concatenate([vp[:, :-2], vp[:, 1:-1], vp[:, 2:]], axis=2)
    blk = jnp.arange(nb)[:, None] * Q_BLOCK
    qpos = blk + jnp.arange(Q_BLOCK)[None, :]
    kpos = blk - Q_BLOCK + jnp.arange(3 * Q_BLOCK)[None, :]
    mask = ((jnp.abs(qpos[:, :, None] - kpos[:, None, :]) <= A_WINDOW)
            & (kpos >= 0)[:, None, :] & (kpos < L)[:, None, :])
    qb = q.reshape(B, nb, Q_BLOCK, Hk, G, d)
    s_win = jnp.einsum('bnqhgd,bnkhd->bnhgqk', qb, kw).astype(jnp.float32) * scale
    s_win = jnp.where(mask[None, :, None, None], s_win, NEG)
    s_ctx = jnp.einsum('bnqhgd,bkhd->bnhgqk', qb, k_ctx).astype(jnp.float32) * scale
    sink_col = sink.astype(jnp.float32).reshape(Hk, G)[None, None, :, :, None, None]
    p = softmax_sink(jnp.concatenate([s_win, s_ctx], axis=-1), sink_col).astype(v.dtype)
    nw = 3 * Q_BLOCK
    o = (jnp.einsum('bnhgqk,bnkhd->bnqhgd', p[..., :nw], vw)
         + jnp.einsum('bnhgqk,bkhd->bnqhgd', p[..., nw:], v_ctx))
    return o.reshape(B, L, Hk * G * d)


def neighbourhood_attention_latent(q, k, v, k_ctx, v_ctx, rpb):
    B, L, H, d = q.shape
    rows = L // GRID_W
    kr_n = min(NAT_ROWS, rows)
    scale = d ** -0.5
    qg = q.reshape(B, rows, GRID_W, H, d)
    kg = k.reshape(B, rows, GRID_W, H, d)
    vg = v.reshape(B, rows, GRID_W, H, d)
    r = jnp.arange(rows)
    row_start = jnp.clip(r - kr_n // 2, 0, rows - kr_n)
    row_idx = row_start[:, None] + jnp.arange(kr_n)[None, :]
    kr = kg[:, row_idx]
    vr = vg[:, row_idx]
    cidx = jnp.arange(GRID_W)
    col_start = jnp.clip(cidx - NAT_COLS // 2, 0, GRID_W - NAT_COLS)
    rel = cidx[None, :] - col_start[:, None]
    col_mask = (rel >= 0) & (rel < NAT_COLS)
    col_off = jnp.clip(cidx[None, :] - cidx[:, None], -(NAT_COLS - 1), NAT_COLS - 1) + NAT_COLS - 1
    row_off = row_idx - r[:, None] + NAT_ROWS - 1
    bias = rpb[:, row_off[:, :, None, None], col_off[None, None, :, :]]
    bias = jnp.transpose(bias, (1, 0, 3, 2, 4)).astype(jnp.float32)
    s_lat = jnp.einsum('brqhd,brjkhd->brhqjk', qg, kr).astype(jnp.float32) * scale + bias[None]
    s_lat = jnp.where(col_mask[:, None, :], s_lat, NEG)
    n_lat = kr_n * GRID_W
    s_ctx = jnp.einsum('brqhd,bkhd->brhqk', qg, k_ctx).astype(jnp.float32) * scale
    p = jax.nn.softmax(jnp.concatenate([s_lat.reshape(B, rows, H, GRID_W, n_lat), s_ctx], axis=-1), axis=-1)
    p = p.astype(v.dtype)
    p_lat = p[..., :n_lat].reshape(B, rows, H, GRID_W, kr_n, GRID_W)
    o = (jnp.einsum('brhqjk,brjkhd->brqhd', p_lat, vr)
         + jnp.einsum('brhqk,bkhd->brqhd', p[..., n_lat:], v_ctx))
    return o.reshape(B, L, H * d)


def s5_scan(u, a_bar, b_bar, h0):
    bu = jnp.einsum('blgc,gpc->blgp', u, b_bar)
    a = jnp.broadcast_to(a_bar, bu.shape)

    def combine(x, y):
        a1, b1 = x
        a2, b2 = y
        return a1 * a2, a2 * b1 + b2

    a_cum, h = lax.associative_scan(combine, (a, bu), axis=1)
    return h + a_cum * h0[:, None]


def s5_readout(h, c_re, c_im):
    return (jnp.einsum('blgp,gcp->blgc', jnp.real(h), c_re.astype(jnp.float32))
            - jnp.einsum('blgp,gcp->blgc', jnp.imag(h), c_im.astype(jnp.float32)))


def s5_mixer(u, lp, h0_f, h0_b):
    B, L, _ = u.shape
    ug = u.astype(jnp.float32).reshape(B, L, S5_GROUPS, S5_CH)
    lam = lax.complex(jnp.minimum(lp['s5_lam_re'].astype(jnp.float32), -1e-4),
                      lp['s5_lam_im'].astype(jnp.float32))
    dt = jnp.exp(lp['s5_log_dt'].astype(jnp.float32))[..., None]
    a_bar = jnp.exp(lam * dt)
    b_c = lax.complex(lp['s5_b_re'].astype(jnp.float32), lp['s5_b_im'].astype(jnp.float32))
    b_bar = ((a_bar - 1.0) / lam)[..., None] * b_c
    uc = ug.astype(jnp.complex64)
    h_f = s5_scan(uc, a_bar[0], b_bar[0], h0_f)
    h_b = jnp.flip(s5_scan(jnp.flip(uc, axis=1), a_bar[1], b_bar[1], h0_b), axis=1)
    y = (s5_readout(h_f, lp['s5_c_re'][0], lp['s5_c_im'][0])
         + s5_readout(h_b, lp['s5_c_re'][1], lp['s5_c_im'][1])
         + lp['s5_d'].astype(jnp.float32).reshape(S5_GROUPS, S5_CH) * ug)
    y = jax.nn.gelu(y.reshape(B, L, BRANCH_W))
    g = y @ lp['s5_w_glu'].astype(jnp.float32)
    y = g[..., :BRANCH_W] * jax.nn.sigmoid(g[..., BRANCH_W:])
    return y.astype(u.dtype), h_f[:, -1], h_b[:, 0]


def split_in(z):
    idx = [int(i) for i in np.cumsum(IN_SIZES)[:-1]]
    return jnp.split(z, idx, axis=-1)


def ada_pre(x, cond, lp):
    mod = jax.nn.silu(cond) @ lp['w_mod'] + lp['b_mod']
    shift, scale, gate = jnp.split(mod, 3, axis=-1)
    h = rmsnorm(x, lp['norm_g']) * (1.0 + scale) + shift
    return h, gate


def ada_post(x, h, gate, outs, gate_paths, lp):
    B, L, _ = x.shape
    br = jnp.stack([o.astype(x.dtype) * jax.nn.silu(g) for o, g in zip(outs, gate_paths)], axis=-2)
    proj = jnp.einsum('blkw,kwd->blkd', br, lp['w_branch'])
    mg = jax.nn.sigmoid(h @ lp['w_merge']).reshape(B, L, N_BRANCH, D_MODEL)
    y = jnp.sum(mg * proj, axis=-2) @ lp['w_out']
    return x + gate * y


def mla_queries(cq, lp):
    B, L, _ = cq.shape
    q = rmsnorm(cq, lp['mla_q_norm']) @ lp['mla_w_q_up']
    return q.reshape(B, L, MLA_HEADS, MLA_NOPE + MLA_ROPE)


def mla_kv(ckv_n, kpe, w_kv_up):
    B, L, _ = ckv_n.shape
    kv = (ckv_n @ w_kv_up).reshape(B, L, MLA_HEADS, MLA_NOPE + MLA_V)
    kpe_h = jnp.broadcast_to(kpe[:, :, None, :], (B, L, MLA_HEADS, MLA_ROPE)).astype(kv.dtype)
    k = jnp.concatenate([kv[..., :MLA_NOPE], kpe_h], axis=-1)
    return k, kv[..., MLA_NOPE:]


def layer_context(x, cond, lp):
    B, L, _ = x.shape
    h, gate = ada_pre(x, cond, lp)
    (a_q, a_k, a_v, a_g, b_cq, b_ckv, b_kpe, b_g, c_u, c_g, d_q, d_k, d_v, d_g) = split_in(h @ lp['w_in'])
    ka = a_k.reshape(B, L, A_KV_HEADS, HEAD_DIM)
    va = a_v.reshape(B, L, A_KV_HEADS, HEAD_DIM)
    oa = dense_attention(a_q.reshape(B, L, A_KV_HEADS, A_GROUP, HEAD_DIM), ka, va, lp['a_sink'])
    qm = mla_queries(b_cq, lp)
    ckv = rmsnorm(b_ckv, lp['mla_kv_norm'])
    km, vm = mla_kv(ckv, b_kpe, lp['mla_w_kv_up'])
    ob = dense_attention(qm[:, :, :, None], km, vm)
    zero = jnp.zeros((B, S5_GROUPS, S5_STATE), jnp.complex64)
    oc, hf, hb = s5_mixer(c_u, lp, zero, zero)
    kd = d_k.reshape(B, L, NAT_HEADS, HEAD_DIM)
    vd = d_v.reshape(B, L, NAT_HEADS, HEAD_DIM)
    od = dense_attention(d_q.reshape(B, L, NAT_HEADS, 1, HEAD_DIM), kd, vd)
    x = ada_post(x, h, gate, (oa, ob, oc, od), (a_g, b_g, c_g, d_g), lp)
    s = jnp.stack([hf, hb], axis=1)
    return x, (ka, va, ckv, b_kpe, kd, vd, jnp.real(s), jnp.imag(s))


def layer_latent(x, cond, cache, lp):
    k_a_ctx, v_a_ctx, ckv_ctx, kpe_ctx, k_n_ctx, v_n_ctx, s_re, s_im = cache
    B, L, _ = x.shape
    h, gate = ada_pre(x, cond, lp)
    (a_q, a_k, a_v, a_g, b_cq, b_ckv, b_kpe, b_g, c_u, c_g, d_q, d_k, d_v, d_g) = split_in(h @ lp['w_in'])
    qa = axial_rope(a_q.reshape(B, L, A_HEADS, HEAD_DIM)).reshape(B, L, A_KV_HEADS, A_GROUP, HEAD_DIM)
    ka = axial_rope(a_k.reshape(B, L, A_KV_HEADS, HEAD_DIM))
    va = a_v.reshape(B, L, A_KV_HEADS, HEAD_DIM)
    oa = window_attention_latent(qa, ka, va, k_a_ctx, v_a_ctx, lp['a_sink'])
    qm = mla_queries(b_cq, lp)
    qm = jnp.concatenate([qm[..., :MLA_NOPE], axial_rope(qm[..., MLA_NOPE:])], axis=-1)
    kpe_lat = axial_rope(b_kpe[:, :, None, :])[:, :, 0]
    k_lat, v_lat = mla_kv(rmsnorm(b_ckv, lp['mla_kv_norm']), kpe_lat, lp['mla_w_kv_up'])
    k_cx, v_cx = mla_kv(ckv_ctx, kpe_ctx, lp['mla_w_kv_up'])
    ob = dense_attention(qm[:, :, :, None], jnp.concatenate([k_lat, k_cx.astype(k_lat.dtype)], axis=1),
                         jnp.concatenate([v_lat, v_cx.astype(v_lat.dtype)], axis=1))
    h0 = lax.complex(s_re.astype(jnp.float32), s_im.astype(jnp.float32))
    oc, _, _ = s5_mixer(c_u, lp, h0[:, 0], h0[:, 1])
    od = neighbourhood_attention_latent(d_q.reshape(B, L, NAT_HEADS, HEAD_DIM),
                                        d_k.reshape(B, L, NAT_HEADS, HEAD_DIM),
                                        d_v.reshape(B, L, NAT_HEADS, HEAD_DIM),
                                        k_n_ctx, v_n_ctx, lp['na_rpb'])
    return ada_post(x, h, gate, (oa, ob, oc, od), (a_g, b_g, c_g, d_g), lp)


def setup_inputs(seed: int = 0) -> dict:
    key = jax.random.key(seed)
    keys = iter(jax.random.split(key, 48))

    def nrm(shape, scale):
        return jax.random.normal(next(keys), shape, jnp.float32) * scale

    D = D_MODEL
    inp = {}
    inp['x_prompt'] = nrm((BATCH, SEQ, D), 1.0)
    inp['x_sample'] = nrm((DEC_BATCH, DEC_SEQ, D), 1.0)
    inp['cache_a_k'] = nrm((DEC_BATCH, DEPTH, PAST_LEN, A_KV_HEADS, HEAD_DIM), 1.0)
    inp['cache_a_v'] = nrm((DEC_BATCH, DEPTH, PAST_LEN, A_KV_HEADS, HEAD_DIM), 1.0)
    inp['cache_mla_ckv'] = nrm((DEC_BATCH, DEPTH, PAST_LEN, MLA_KV_LORA), 1.0)
    inp['cache_mla_kpe'] = nrm((DEC_BATCH, DEPTH, PAST_LEN, MLA_ROPE), 1.0)
    inp['cache_na_k'] = nrm((DEC_BATCH, DEPTH, PAST_LEN, NAT_HEADS, HEAD_DIM), 1.0)
    inp['cache_na_v'] = nrm((DEC_BATCH, DEPTH, PAST_LEN, NAT_HEADS, HEAD_DIM), 1.0)
    inp['state_s5_re'] = nrm((DEC_BATCH, DEPTH, 2, S5_GROUPS, S5_STATE), 0.1)
    inp['state_s5_im'] = nrm((DEC_BATCH, DEPTH, 2, S5_GROUPS, S5_STATE), 0.1)
    inp['c'] = nrm((DEC_BATCH, D), 1.0)
    inp['c_ctx'] = nrm((D,), 1.0)
    inp['w_mod'] = nrm((DEPTH, D, 3 * D), D ** -0.5)
    inp['b_mod'] = nrm((DEPTH, 3 * D), 0.01)
    inp['norm_g'] = 1.0 + nrm((DEPTH, D), 0.01)
    inp['w_in'] = nrm((DEPTH, D, IN_COLS), D ** -0.5)
    inp['w_merge'] = nrm((DEPTH, D, N_BRANCH * D), D ** -0.5)
    inp['a_sink'] = nrm((DEPTH, A_HEADS), 0.5)
    inp['mla_q_norm'] = 1.0 + nrm((DEPTH, MLA_Q_LORA), 0.01)
    inp['mla_w_q_up'] = nrm((DEPTH, MLA_Q_LORA, MLA_HEADS * (MLA_NOPE + MLA_ROPE)), MLA_Q_LORA ** -0.5)
    inp['mla_kv_norm'] = 1.0 + nrm((DEPTH, MLA_KV_LORA), 0.01)
    inp['mla_w_kv_up'] = nrm((DEPTH, MLA_KV_LORA, MLA_HEADS * (MLA_NOPE + MLA_V)), MLA_KV_LORA ** -0.5)
    inp['s5_lam_re'] = -0.5 + nrm((DEPTH, 2, S5_GROUPS, S5_STATE), 0.01)
    inp['s5_lam_im'] = (math.pi * jnp.arange(S5_STATE, dtype=jnp.float32)[None, None, None, :]
                        + nrm((DEPTH, 2, S5_GROUPS, S5_STATE), 0.01))
    inp['s5_log_dt'] = jax.random.uniform(next(keys), (DEPTH, 2, S5_GROUPS), jnp.float32,
                                          minval=math.log(1e-3), maxval=math.log(1e-1))
    inp['s5_b_re'] = nrm((DEPTH, 2, S5_GROUPS, S5_STATE, S5_CH), (2 * S5_CH) ** -0.5)
    inp['s5_b_im'] = nrm((DEPTH, 2, S5_GROUPS, S5_STATE, S5_CH), (2 * S5_CH) ** -0.5)
    inp['s5_c_re'] = nrm((DEPTH, 2, S5_GROUPS, S5_CH, S5_STATE), S5_STATE ** -0.5)
    inp['s5_c_im'] = nrm((DEPTH, 2, S5_GROUPS, S5_CH, S5_STATE), S5_STATE ** -0.5)
    inp['s5_d'] = nrm((DEPTH, BRANCH_W), 1.0)
    inp['s5_w_glu'] = nrm((DEPTH, BRANCH_W, 2 * BRANCH_W), BRANCH_W ** -0.5)
    inp['na_rpb'] = nrm((DEPTH, NAT_HEADS, 2 * NAT_ROWS - 1, 2 * NAT_COLS - 1), 0.1)
    inp['w_branch'] = nrm((DEPTH, N_BRANCH, BRANCH_W, D), BRANCH_W ** -0.5)
    inp['w_out'] = nrm((DEPTH, D, D), D ** -0.5)
    inp['final_norm_g'] = 1.0 + nrm((D,), 0.01)
    return inp


def reference(x_prompt, x_sample, cache_a_k, cache_a_v, cache_mla_ckv, cache_mla_kpe, cache_na_k, cache_na_v,
              state_s5_re, state_s5_im, c, c_ctx, w_mod, b_mod, norm_g, w_in, w_merge, a_sink,
              mla_q_norm, mla_w_q_up, mla_kv_norm, mla_w_kv_up, s5_lam_re, s5_lam_im, s5_log_dt,
              s5_b_re, s5_b_im, s5_c_re, s5_c_im, s5_d, s5_w_glu, na_rpb, w_branch, w_out, final_norm_g):
    yp = x_prompt
    ys = x_sample
    ctx_states = []
    for i in range(DEPTH):
        lp = dict(w_mod=w_mod[i], b_mod=b_mod[i], norm_g=norm_g[i], w_in=w_in[i], w_merge=w_merge[i],
                  a_sink=a_sink[i], mla_q_norm=mla_q_norm[i], mla_w_q_up=mla_w_q_up[i],
                  mla_kv_norm=mla_kv_norm[i], mla_w_kv_up=mla_w_kv_up[i], s5_lam_re=s5_lam_re[i],
                  s5_lam_im=s5_lam_im[i], s5_log_dt=s5_log_dt[i], s5_b_re=s5_b_re[i], s5_b_im=s5_b_im[i],
                  s5_c_re=s5_c_re[i], s5_c_im=s5_c_im[i], s5_d=s5_d[i], s5_w_glu=s5_w_glu[i],
                  na_rpb=na_rpb[i], w_branch=w_branch[i], w_out=w_out[i])
        yp, st = layer_context(yp, c_ctx, lp)
        ctx_states.append(st)
        cache_i = (cache_a_k[:, i], cache_a_v[:, i], cache_mla_ckv[:, i], cache_mla_kpe[:, i],
                   cache_na_k[:, i], cache_na_v[:, i], state_s5_re[:, i], state_s5_im[:, i])
        ys = layer_latent(ys, c[:, None, :], cache_i, lp)
    y_prompt = rmsnorm(yp, final_norm_g)
    y_sample = rmsnorm(ys, final_norm_g)
    new_a_k = jnp.stack([st[0] for st in ctx_states], axis=1)
    new_a_v = jnp.stack([st[1] for st in ctx_states], axis=1)
    new_mla_ckv = jnp.stack([st[2] for st in ctx_states], axis=1)
    new_mla_kpe = jnp.stack([st[3] for st in ctx_states], axis=1)
    new_na_k = jnp.stack([st[4] for st in ctx_states], axis=1)
    new_na_v = jnp.stack([st[5] for st in ctx_states], axis=1)
    new_s5_re = jnp.stack([st[6] for st in ctx_states], axis=1)
    new_s5_im = jnp.stack([st[7] for st in ctx_states], axis=1)
    return (y_prompt, y_sample, new_a_k, new_a_v, new_mla_ckv, new_mla_kpe, new_na_k, new_na_v, new_s5_re, new_s5_im)
```

```cpp
#include <hip/hip_runtime.h>
#include <hip/hip_cooperative_groups.h>
#include <cstdio>
#include <cstdint>
namespace cg = cooperative_groups;

typedef _Float16 h16;
typedef __attribute__((ext_vector_type(8))) _Float16 h16x8;
typedef __attribute__((ext_vector_type(4))) _Float16 h16x4;
typedef __attribute__((ext_vector_type(4))) float f32x4;
typedef __attribute__((ext_vector_type(4))) unsigned int u32x4;

#define T_ALL 16384
#define T_CTX 8192
#define ZLD 2976
#define LOG2E 1.4426950408889634f

#define O_AK   16777216
#define O_AV   18874368
#define O_CKV  20971520
#define O_KPE  23068672
#define O_NK   23592960
#define O_NV   27787264
#define O_SRE  31981568
#define O_SIM  32112640

struct Params {
  const float *x_prompt, *x_sample, *cache_a_k, *cache_a_v, *cache_mla_ckv, *cache_mla_kpe, *cache_na_k, *cache_na_v,
      *state_re, *state_im, *c, *c_ctx, *w_mod, *b_mod, *norm_g, *w_in, *w_merge, *a_sink, *mla_q_norm, *mla_w_q_up,
      *mla_kv_norm, *mla_w_kv_up, *s5_lam_re, *s5_lam_im, *s5_log_dt, *s5_b_re, *s5_b_im, *s5_c_re, *s5_c_im, *s5_d,
      *s5_w_glu, *na_rpb, *w_branch, *w_out, *final_norm_g;
  float* out;
  h16 *wt_in, *wt_merge, *wt_branch, *wt_out, *wt_qup, *wt_kvup, *wt_kvraw, *wt_glu;
  h16 *hbuf, *zbuf, *br, *qm, *kmla, *kcx, *vt_a_ctx, *vt_a_lat, *vt_d_ctx, *vt_d_lat, *vt_m_ctx, *vt_m_lat, *vcx_t,
      *ck_a, *cvt_a, *ck_n, *cvt_n, *ckv_c, *s5_bmt, *s5_cmt;
  float *s5_abar, *s5_lamdt, *s5_dt, *s5_e, *modv, *cs16, *cs8;
};

__device__ __forceinline__ float sigmoidf_(float x) { return 1.f / (1.f + __expf(-x)); }
__device__ __forceinline__ float siluf_(float x) { return x * sigmoidf_(x); }
__device__ __forceinline__ float geluf_(float x) {
  float u = 0.7978845608028654f * (x + 0.044715f * x * x * x);
  return 0.5f * x * (1.f + tanhf(u));
}
__device__ __forceinline__ float wave_sum(float v) {
#pragma unroll
  for (int o = 32; o > 0; o >>= 1) v += __shfl_xor(v, o);
  return v;
}
__device__ __forceinline__ const float* xptr(const Params& p, int layer, int tok) {
  if (layer == 0) return tok < T_CTX ? p.x_prompt + (size_t)tok * 1024 : p.x_sample + (size_t)(tok - T_CTX) * 1024;
  return p.out + (size_t)tok * 1024;
}
__device__ __forceinline__ int cond_of(int tok) { return tok < T_CTX ? 0 : 1 + ((tok - T_CTX) >> 11); }

#define SWZ(row, slot) (((row) << 7) + ((((slot) ^ (((row) >> 1) & 7))) << 4))

template <int BM, int BN>
__device__ __forceinline__ void gemm_acc(f32x4 (&acc)[BM / 32][BN / 32], const h16* __restrict__ A, int lda,
                                         const h16* __restrict__ Bt, int ldb, int K, char* smem) {
  constexpr int MREP = BM / 32, NREP = BN / 32;
  constexpr int ACH = BM * 8 / 256, BCH = BN * 8 / 256;
  constexpr int ABYTES = BM * 128, STAGE = (BM + BN) * 128;
  const int tid = threadIdx.x, lane = tid & 63, wid = tid >> 6;
  const int wr = wid >> 1, wc = wid & 1;
  const int l15 = lane & 15, g = lane >> 4;
  u32x4 ra[ACH], rb[BCH];
  const int nk = K >> 6;
  const h16* Ap = A + (size_t)(tid >> 3) * lda + (tid & 7) * 8;
  const h16* Bp = Bt + (size_t)(tid >> 3) * ldb + (tid & 7) * 8;
#pragma unroll
  for (int i = 0; i < ACH; i++) ra[i] = *(const u32x4*)(Ap + (size_t)(i * 32) * lda);
#pragma unroll
  for (int i = 0; i < BCH; i++) rb[i] = *(const u32x4*)(Bp + (size_t)(i * 32) * ldb);
  {
    char* sa = smem;
    char* sb = smem + ABYTES;
#pragma unroll
    for (int i = 0; i < ACH; i++) *(u32x4*)(sa + SWZ((tid >> 3) + i * 32, tid & 7)) = ra[i];
#pragma unroll
    for (int i = 0; i < BCH; i++) *(u32x4*)(sb + SWZ((tid >> 3) + i * 32, tid & 7)) = rb[i];
  }
  __syncthreads();
  for (int kt = 0; kt < nk; kt++) {
    const bool more = (kt + 1 < nk);
    if (more) {
#pragma unroll
      for (int i = 0; i < ACH; i++) ra[i] = *(const u32x4*)(Ap + (size_t)(i * 32) * lda + (kt + 1) * 64);
#pragma unroll
      for (int i = 0; i < BCH; i++) rb[i] = *(const u32x4*)(Bp + (size_t)(i * 32) * ldb + (kt + 1) * 64);
    }
    const char* sa = smem + (kt & 1) * STAGE;
    const char* sb = sa + ABYTES;
#pragma unroll
    for (int ks = 0; ks < 2; ks++) {
      h16x8 af[MREP], bf[NREP];
#pragma unroll
      for (int mi = 0; mi < MREP; mi++) af[mi] = *(const h16x8*)(sa + SWZ(wr * (BM / 2) + mi * 16 + l15, ks * 4 + g));
#pragma unroll
      for (int ni = 0; ni < NREP; ni++) bf[ni] = *(const h16x8*)(sb + SWZ(wc * (BN / 2) + ni * 16 + l15, ks * 4 + g));
#pragma unroll
      for (int mi = 0; mi < MREP; mi++)
#pragma unroll
        for (int ni = 0; ni < NREP; ni++)
          acc[mi][ni] = __builtin_amdgcn_mfma_f32_16x16x32_f16(bf[ni], af[mi], acc[mi][ni], 0, 0, 0);
    }
    if (more) {
      char* wa = smem + ((kt + 1) & 1) * STAGE;
      char* wb = wa + ABYTES;
#pragma unroll
      for (int i = 0; i < ACH; i++) *(u32x4*)(wa + SWZ((tid >> 3) + i * 32, tid & 7)) = ra[i];
#pragma unroll
      for (int i = 0; i < BCH; i++) *(u32x4*)(wb + SWZ((tid >> 3) + i * 32, tid & 7)) = rb[i];
    }
    __syncthreads();
  }
}

template <int M, int N>
__device__ __forceinline__ void zero_acc(f32x4 (&a)[M][N]) {
#pragma unroll
  for (int i = 0; i < M; i++)
#pragma unroll
    for (int j = 0; j < N; j++) a[i][j] = f32x4{0.f, 0.f, 0.f, 0.f};
}

__device__ __forceinline__ void store_h4(h16* dst, float a, float b, float c, float d) {
  h16x4 v = {(h16)a, (h16)b, (h16)c, (h16)d};
  *(h16x4*)dst = v;
}

__device__ void tr_tile(const float* __restrict__ src, int lds_, h16* __restrict__ dst, int ldd, int k0, int n0, int N,
                        char* smem) {
  float* tile = (float*)smem;
  const int tid = threadIdx.x;
  const int r = tid >> 4, c4 = tid & 15;
#pragma unroll
  for (int rr = 0; rr < 4; rr++) {
    int kl = r + rr * 16;
    int n = n0 + c4 * 4;
    float4 v = make_float4(0.f, 0.f, 0.f, 0.f);
    if (n < N) v = *(const float4*)(src + (size_t)(k0 + kl) * lds_ + n);
    tile[kl * 65 + c4 * 4 + 0] = v.x;
    tile[kl * 65 + c4 * 4 + 1] = v.y;
    tile[kl * 65 + c4 * 4 + 2] = v.z;
    tile[kl * 65 + c4 * 4 + 3] = v.w;
  }
  __syncthreads();
  const int nl = tid >> 2, kq = tid & 3;
  h16x8 o0, o1;
#pragma unroll
  for (int i = 0; i < 8; i++) {
    o0[i] = (h16)tile[(kq * 16 + i) * 65 + nl];
    o1[i] = (h16)tile[(kq * 16 + 8 + i) * 65 + nl];
  }
  h16* d = dst + (size_t)(n0 + nl) * ldd + k0 + kq * 16;
  *(h16x8*)d = o0;
  *(h16x8*)(d + 8) = o1;
  __syncthreads();
}

__device__ void phase_prep(const Params& p, char* smem) {
  const int tid = threadIdx.x;
  const size_t gtid = (size_t)blockIdx.x * 256 + tid, gsz = (size_t)gridDim.x * 256;
  for (size_t i = gtid; i < 2 * 384 * 256; i += gsz) {
    int l = i / (384 * 256), r = i % (384 * 256), n = r / 256, k = r % 256;
    p.wt_qup[i] = (h16)(p.mla_q_norm[l * 256 + k] * p.mla_w_q_up[(size_t)l * 256 * 384 + k * 384 + n]);
  }
  for (size_t i = gtid; i < 2 * 512 * 128; i += gsz) {
    int l = i / (512 * 128), r = i % (512 * 128), n = r / 128, k = r % 128;
    float w = p.mla_w_kv_up[(size_t)l * 128 * 512 + k * 512 + n];
    p.wt_kvraw[i] = (h16)w;
    p.wt_kvup[i] = (h16)(w * p.mla_kv_norm[l * 128 + k]);
  }
  for (size_t i = gtid; i < 2 * 512 * 256; i += gsz) {
    int l = i / (512 * 256), r = i % (512 * 256), n = r / 256, k = r % 256;
    int q = n >> 5, w = n & 31;
    int orig = (w < 16) ? (q * 16 + w) : (256 + q * 16 + (w - 16));
    p.wt_glu[i] = (h16)p.s5_w_glu[(size_t)l * 256 * 512 + k * 512 + orig];
  }
  for (size_t i = gtid; i < 524288; i += gsz) {
    p.ck_a[i] = (h16)p.cache_a_k[i];
    p.ckv_c[i] = (h16)p.cache_mla_ckv[i];
  }
  for (size_t i = gtid; i < 1048576; i += gsz) p.ck_n[i] = (h16)p.cache_na_k[i];
  for (size_t i = gtid; i < 4096; i += gsz) {
    int ldg = i >> 6;
    float lr = fminf(p.s5_lam_re[i], -1e-4f), li = p.s5_lam_im[i];
    float dt = __expf(p.s5_log_dt[ldg]);
    float er = expf(lr * dt), sn, cs;
    sincosf(li * dt, &sn, &cs);
    float ar = er * cs, ai = er * sn;
    p.s5_abar[i * 2] = ar;
    p.s5_abar[i * 2 + 1] = ai;
    p.s5_lamdt[i * 2] = lr * dt;
    p.s5_lamdt[i * 2 + 1] = li * dt;
    if ((i & 63) == 0) p.s5_dt[ldg] = dt;
    float nr = ar - 1.f, ni = ai, den = lr * lr + li * li;
    float cr = (nr * lr + ni * li) / den / dt, ci = (ni * lr - nr * li) / den / dt;
    int pp = i & 63;
    for (int c = 0; c < 16; c++) {
      float br_ = p.s5_b_re[i * 16 + c], bi_ = p.s5_b_im[i * 16 + c];
      p.s5_bmt[((size_t)ldg * 128 + pp) * 16 + c] = (h16)(cr * br_ - ci * bi_);
      p.s5_bmt[((size_t)ldg * 128 + 64 + pp) * 16 + c] = (h16)(cr * bi_ + ci * br_);
      p.s5_cmt[((size_t)ldg * 16 + c) * 128 + pp] = (h16)p.s5_c_re[((size_t)ldg * 16 + c) * 64 + pp];
      p.s5_cmt[((size_t)ldg * 16 + c) * 128 + 64 + pp] = (h16)(-p.s5_c_im[((size_t)ldg * 16 + c) * 64 + pp]);
    }
  }
  for (size_t i = gtid; i < 64 * 16; i += gsz) {
    int pos = i >> 4, k = i & 15;
    float inv = powf(10000.f, -(float)k / 16.f), sn, cs;
    sincosf((float)pos * inv, &sn, &cs);
    p.cs16[i * 2] = cs;
    p.cs16[i * 2 + 1] = sn;
  }
  for (size_t i = gtid; i < 64 * 8; i += gsz) {
    int pos = i >> 3, k = i & 7;
    float inv = powf(10000.f, -(float)k / 8.f), sn, cs;
    sincosf((float)pos * inv, &sn, &cs);
    p.cs8[i * 2] = cs;
    p.cs8[i * 2 + 1] = sn;
  }
  for (int it = blockIdx.x; it < 384; it += gridDim.x) {
    float* sc = (float*)smem;
    float* red = sc + 5 * 1024;
    const int layer = it / 192, col0 = (it % 192) * 16;
    for (int i = tid; i < 5120; i += 256) {
      int c = i >> 10, k = i & 1023;
      float v = (c == 0) ? p.c_ctx[k] : p.c[(c - 1) * 1024 + k];
      sc[i] = siluf_(v);
    }
    __syncthreads();
    const int cl = tid & 15, kg = tid >> 4;
    float a0 = 0, a1 = 0, a2 = 0, a3 = 0, a4 = 0;
    const float* w = p.w_mod + (size_t)layer * 1024 * 3072 + col0 + cl;
#pragma unroll 8
    for (int kk = 0; kk < 64; kk++) {
      int k = kg * 64 + kk;
      float wv = w[(size_t)k * 3072];
      a0 += sc[k] * wv;
      a1 += sc[1024 + k] * wv;
      a2 += sc[2048 + k] * wv;
      a3 += sc[3072 + k] * wv;
      a4 += sc[4096 + k] * wv;
    }
    red[(kg * 5 + 0) * 16 + cl] = a0;
    red[(kg * 5 + 1) * 16 + cl] = a1;
    red[(kg * 5 + 2) * 16 + cl] = a2;
    red[(kg * 5 + 3) * 16 + cl] = a3;
    red[(kg * 5 + 4) * 16 + cl] = a4;
    __syncthreads();
    if (tid < 80) {
      int c = tid >> 4, cc = tid & 15;
      float s = 0;
      for (int q = 0; q < 16; q++) s += red[(q * 5 + c) * 16 + cc];
      p.modv[(layer * 5 + c) * 3072 + col0 + cc] = s + p.b_mod[layer * 3072 + col0 + cc];
    }
    __syncthreads();
  }
  for (int it = blockIdx.x; it < 4992; it += gridDim.x) {
    const float* src; h16* dst; int lds_, ldd, N, NT, tile;
    if (it < 4608) {
      int l = it / 2304, r = it % 2304;
      if (r < 768) { src = p.w_in + (size_t)l * 1024 * 2976; lds_ = 2976; dst = p.wt_in + (size_t)l * 3072 * 1024; ldd = 1024; N = 2976; NT = 48; tile = r; }
      else if (r < 1792) { src = p.w_merge + (size_t)l * 1024 * 4096; lds_ = 4096; dst = p.wt_merge + (size_t)l * 4096 * 1024; ldd = 1024; N = 4096; NT = 64; tile = r - 768; }
      else if (r < 2048) { int k = (r - 1792) >> 6; src = p.w_branch + (size_t)(l * 4 + k) * 256 * 1024; lds_ = 1024; dst = p.wt_branch + (size_t)(l * 4 + k) * 1024 * 256; ldd = 256; N = 1024; NT = 16; tile = (r - 1792) & 63; }
      else { src = p.w_out + (size_t)l * 1048576; lds_ = 1024; dst = p.wt_out + (size_t)l * 1048576; ldd = 1024; N = 1024; NT = 16; tile = r - 2048; }
    } else {
      int r = it - 4608;
      if (r < 128) { int m = r >> 4; src = p.cache_a_v + (size_t)m * 512 * 128; lds_ = 128; dst = p.cvt_a + (size_t)m * 128 * 512; ldd = 512; N = 128; NT = 2; tile = r & 15; }
      else { r -= 128; int m = r >> 5; src = p.cache_na_v + (size_t)m * 512 * 256; lds_ = 256; dst = p.cvt_n + (size_t)m * 256 * 512; ldd = 512; N = 256; NT = 4; tile = r & 31; }
    }
    tr_tile(src, lds_, dst, ldd, (tile / NT) * 64, (tile % NT) * 64, N, smem);
  }
}

__device__ void phase_norm(const Params& p, int layer) {
  const int lane = threadIdx.x & 63, wid = threadIdx.x >> 6;
  const float* g = p.norm_g + layer * 1024;
  for (int row = blockIdx.x * 4 + wid; row < T_ALL; row += gridDim.x * 4) {
    const float* x = xptr(p, layer, row);
    const float* mod = p.modv + (layer * 5 + cond_of(row)) * 3072;
    float4 v[4];
    float ss = 0;
#pragma unroll
    for (int i = 0; i < 4; i++) {
      v[i] = *(const float4*)(x + i * 256 + lane * 4);
      ss += v[i].x * v[i].x + v[i].y * v[i].y + v[i].z * v[i].z + v[i].w * v[i].w;
    }
    ss = wave_sum(ss);
    float rstd = rsqrtf(ss * (1.f / 1024.f) + 1e-6f);
#pragma unroll
    for (int i = 0; i < 4; i++) {
      int k = i * 256 + lane * 4;
      float4 gg = *(const float4*)(g + k), sh = *(const float4*)(mod + k), sc = *(const float4*)(mod + 1024 + k);
      store_h4(p.hbuf + (size_t)row * 1024 + k, v[i].x * rstd * gg.x * (1.f + sc.x) + sh.x,
               v[i].y * rstd * gg.y * (1.f + sc.y) + sh.y, v[i].z * rstd * gg.z * (1.f + sc.z) + sh.z,
               v[i].w * rstd * gg.w * (1.f + sc.w) + sh.w);
    }
  }
}

__device__ void phase_final(const Params& p) {
  const int lane = threadIdx.x & 63, wid = threadIdx.x >> 6;
  const float* g = p.final_norm_g;
  for (int row = blockIdx.x * 4 + wid; row < T_ALL; row += gridDim.x * 4) {
    float* x = p.out + (size_t)row * 1024;
    float4 v[4];
    float ss = 0;
#pragma unroll
    for (int i = 0; i < 4; i++) {
      v[i] = *(const float4*)(x + i * 256 + lane * 4);
      ss += v[i].x * v[i].x + v[i].y * v[i].y + v[i].z * v[i].z + v[i].w * v[i].w;
    }
    ss = wave_sum(ss);
    float rstd = rsqrtf(ss * (1.f / 1024.f) + 1e-6f);
#pragma unroll
    for (int i = 0; i < 4; i++) {
      int k = i * 256 + lane * 4;
      float4 gg = *(const float4*)(g + k);
      *(float4*)(x + k) = make_float4(v[i].x * rstd * gg.x, v[i].y * rstd * gg.y, v[i].z * rstd * gg.z, v[i].w * rstd * gg.w);
    }
  }
}

__device__ void phase_g1(const Params& p, int layer, char* smem) {
  const int lane = threadIdx.x & 63, wid = threadIdx.x >> 6, wr = wid >> 1, wc = wid & 1, l15 = lane & 15, g = lane >> 4;
  const h16* Wt = p.wt_in + (size_t)layer * 3072 * 1024;
  for (int tile = blockIdx.x; tile < 128 * 24; tile += gridDim.x) {
    const int rt = tile / 24, ct = tile % 24;
    const int r0 = rt * 128, n0 = ct * 128;
    f32x4 acc[4][4];
    zero_acc(acc);
    gemm_acc<128, 128>(acc, p.hbuf + (size_t)r0 * 1024, 1024, Wt + (size_t)n0 * 1024, 1024, 1024, smem);
    const bool ctx = r0 < T_CTX;
#pragma unroll
    for (int ni = 0; ni < 4; ni++) {
      const int col = n0 + wc * 64 + ni * 16 + 4 * g;
      if (col >= ZLD) continue;
      const int fb = n0 + wc * 64 + ni * 16;
#pragma unroll
      for (int mi = 0; mi < 4; mi++) {
        const int tok = r0 + wr * 64 + mi * 16 + l15;
        f32x4 v = acc[mi][ni];
        store_h4(p.zbuf + (size_t)tok * ZLD + col, v[0], v[1], v[2], v[3]);
        int b, l, Ls;
        if (ctx) { b = tok >> 8; l = tok & 255; Ls = 256; } else { b = (tok - T_CTX) >> 11; l = (tok - T_CTX) & 2047; Ls = 2048; }
        if (fb >= 384 && fb < 512) {
          h16* vt = p.vt_a_ctx + (ctx ? 0 : 1048576);
          int cc = col - 384;
#pragma unroll
          for (int j = 0; j < 4; j++) vt[((size_t)(b * 2 + ((cc + j) >> 6)) * 64 + ((cc + j) & 63)) * Ls + l] = (h16)v[j];
        } else if (fb >= 2464 && fb < 2720) {
          h16* vt = p.vt_d_ctx + (ctx ? 0 : 2097152);
          int cc = col - 2464;
#pragma unroll
          for (int j = 0; j < 4; j++) vt[((size_t)(b * 4 + ((cc + j) >> 6)) * 64 + ((cc + j) & 63)) * Ls + l] = (h16)v[j];
        }
        if (ctx) {
          const size_t rowi = (size_t)(b * 2 + layer) * 256 + l;
          float4 fv = make_float4(v[0], v[1], v[2], v[3]);
          if (fb >= 256 && fb < 384) *(float4*)(p.out + O_AK + rowi * 128 + (col - 256)) = fv;
          else if (fb >= 384 && fb < 512) *(float4*)(p.out + O_AV + rowi * 128 + (col - 384)) = fv;
          else if (fb >= 1152 && fb < 1184) *(float4*)(p.out + O_KPE + rowi * 32 + (col - 1152)) = fv;
          else if (fb >= 2208 && fb < 2464) *(float4*)(p.out + O_NK + rowi * 256 + (col - 2208)) = fv;
          else if (fb >= 2464 && fb < 2720) *(float4*)(p.out + O_NV + rowi * 256 + (col - 2464)) = fv;
        }
      }
    }
  }
}

#define BUS 136
__device__ void s5_item(const Params& p, int layer, int mode, int b, int g, int chunk, char* smem) {
  const int tid = threadIdx.x, lane = tid & 63, wid = tid >> 6, l15 = lane & 15, gq = lane >> 4;
  h16* su = (h16*)smem;
  h16* sy = su + 256 * 16;
  h16* sbu = sy + 2 * 256 * 16;
  const int tok0 = (mode == 0) ? b * 256 : T_CTX + b * 2048 + chunk * 256;
  for (int i = tid; i < 512; i += 256) {
    int t = i >> 1, hf = i & 1;
    *(u32x4*)(su + t * 16 + hf * 8) = *(const u32x4*)(p.zbuf + (size_t)(tok0 + t) * ZLD + 1440 + g * 16 + hf * 8);
  }
  __syncthreads();
  if (wid < 2) {
    const int dir = wid;
    const int ldg = (layer * 2 + dir) * 16 + g;
    const float ar = p.s5_abar[(ldg * 64 + lane) * 2], ai = p.s5_abar[(ldg * 64 + lane) * 2 + 1];
    const float dt = p.s5_dt[ldg];
    float hr = 0.f, hi = 0.f;
    if (mode == 2) {
      const size_t sidx = ((((size_t)b * 2 + layer) * 2 + dir) * 16 + g) * 64 + lane;
      hr = p.state_re[sidx];
      hi = p.state_im[sidx];
      float lr = p.s5_lamdt[(ldg * 64 + lane) * 2] * 256.f, li = p.s5_lamdt[(ldg * 64 + lane) * 2 + 1] * 256.f;
      float er = expf(lr), sn, cs;
      sincosf(li, &sn, &cs);
      const float pr = er * cs, pi = er * sn;
      const float* e = p.s5_e + ((((size_t)b * 16 + g) * 2 + dir) * 8) * 128;
      if (dir == 0) {
        for (int c2 = 0; c2 < chunk; c2++) {
          float er_ = e[c2 * 128 + lane * 2], ei_ = e[c2 * 128 + lane * 2 + 1];
          float nr = pr * hr - pi * hi + er_, ni = pr * hi + pi * hr + ei_;
          hr = nr; hi = ni;
        }
      } else {
        for (int c2 = 7; c2 > chunk; c2--) {
          float er_ = e[c2 * 128 + lane * 2], ei_ = e[c2 * 128 + lane * 2 + 1];
          float nr = pr * hr - pi * hi + er_, ni = pr * hi + pi * hr + ei_;
          hr = nr; hi = ni;
        }
      }
    }
    h16x4 bfr[8];
    const h16* bmt = p.s5_bmt + (size_t)ldg * 128 * 16;
#pragma unroll
    for (int nf = 0; nf < 8; nf++) bfr[nf] = *(const h16x4*)(bmt + (nf * 16 + l15) * 16 + 4 * gq);
    h16x8 cfr[4];
    const h16* cmt = p.s5_cmt + (size_t)ldg * 16 * 128;
#pragma unroll
    for (int ks = 0; ks < 4; ks++) cfr[ks] = *(const h16x8*)(cmt + l15 * 128 + ks * 32 + 8 * gq);
    h16* bu = sbu + dir * 16 * BUS;
    h16* ydir = sy + dir * 256 * 16;
    for (int sub = 0; sub < 16; sub++) {
      const int sc = dir == 0 ? sub : 15 - sub;
      const int tt0 = sc * 16;
      h16x4 ua = *(const h16x4*)(su + (tt0 + l15) * 16 + 4 * gq);
#pragma unroll
      for (int nf = 0; nf < 8; nf++) {
        f32x4 r = __builtin_amdgcn_mfma_f32_16x16x16f16(bfr[nf], ua, f32x4{0.f, 0.f, 0.f, 0.f}, 0, 0, 0);
        store_h4(bu + l15 * BUS + nf * 16 + 4 * gq, r[0], r[1], r[2], r[3]);
      }
      __builtin_amdgcn_wave_barrier();
#pragma unroll 4
      for (int s = 0; s < 16; s++) {
        const int t = dir == 0 ? s : 15 - s;
        float bur = (float)bu[t * BUS + lane], bui = (float)bu[t * BUS + 64 + lane];
        float nr = ar * hr - ai * hi + dt * bur, ni = ar * hi + ai * hr + dt * bui;
        hr = nr; hi = ni;
        bu[t * BUS + lane] = (h16)hr;
        bu[t * BUS + 64 + lane] = (h16)hi;
      }
      __builtin_amdgcn_wave_barrier();
      if (mode != 1) {
        f32x4 y = {0.f, 0.f, 0.f, 0.f};
#pragma unroll
        for (int ks = 0; ks < 4; ks++) {
          h16x8 ha = *(const h16x8*)(bu + l15 * BUS + ks * 32 + 8 * gq);
          y = __builtin_amdgcn_mfma_f32_16x16x32_f16(cfr[ks], ha, y, 0, 0, 0);
        }
        store_h4(ydir + (tt0 + l15) * 16 + 4 * gq, y[0], y[1], y[2], y[3]);
      }
      __builtin_amdgcn_wave_barrier();
    }
    if (mode == 0) {
      const size_t oi = ((((size_t)b * 2 + layer) * 2 + dir) * 16 + g) * 64 + lane;
      p.out[O_SRE + oi] = hr;
      p.out[O_SIM + oi] = hi;
    } else if (mode == 1) {
      float* e = p.s5_e + (((((size_t)b * 16 + g) * 2 + dir) * 8) + chunk) * 128;
      e[lane * 2] = hr;
      e[lane * 2 + 1] = hi;
    }
  }
  __syncthreads();
  if (mode != 1) {
    for (int i = tid; i < 256 * 16; i += 256) {
      int t = i >> 4, c = i & 15;
      float u = (float)su[i];
      float v = (float)sy[i] + (float)sy[256 * 16 + i] + p.s5_d[layer * 256 + g * 16 + c] * u;
      p.zbuf[(size_t)(tok0 + t) * ZLD + 1440 + g * 16 + c] = (h16)geluf_(v);
    }
  }
  __syncthreads();
}


template <int NCOL>
__device__ __forceinline__ void row_rstd(const h16* __restrict__ base, float* rs) {
  const int tid = threadIdx.x, row = tid >> 1, hf = tid & 1;
  const h16* ptr = base + (size_t)row * ZLD + hf * (NCOL / 2);
  float s = 0.f;
#pragma unroll 2
  for (int i = 0; i < NCOL / 16; i++) {
    h16x8 v = *(const h16x8*)(ptr + i * 8);
#pragma unroll
    for (int j = 0; j < 8; j++) s += (float)v[j] * (float)v[j];
  }
  s += __shfl_xor(s, 1);
  if (hf == 0) rs[row] = rsqrtf(s * (1.f / NCOL) + 1e-6f);
}

__device__ void phase_g2(const Params& p, int layer, char* smem) {
  const int tid = threadIdx.x, lane = tid & 63, wid = tid >> 6, wr = wid >> 1, wc = wid & 1, l15 = lane & 15, g = lane >> 4;
  for (int it = blockIdx.x; it < 1024; it += gridDim.x) {
    int mode, b, gg, ch;
    if (it < 512) { mode = 0; b = it >> 4; gg = it & 15; ch = 0; }
    else { int i2 = it - 512; mode = 1; b = i2 >> 7; gg = (i2 >> 3) & 15; ch = i2 & 7; }
    s5_item(p, layer, mode, b, gg, ch, smem);
  }
  for (int it = blockIdx.x; it < 768; it += gridDim.x) {
    {
      const int rt = it / 6, ct = it % 6, r0 = rt * 128, n0 = ct * 64;
      float* rs = (float*)(smem + 49152);
      row_rstd<256>(p.zbuf + (size_t)r0 * ZLD + 768, rs);
      f32x4 acc[4][2];
      zero_acc(acc);
      gemm_acc<128, 64>(acc, p.zbuf + (size_t)r0 * ZLD + 768, ZLD, p.wt_qup + (size_t)layer * 384 * 256 + (size_t)n0 * 256, 256, 256, smem);
      __syncthreads();
      const bool lat = r0 >= T_CTX;
#pragma unroll
      for (int mi = 0; mi < 4; mi++) {
        const int row = wr * 64 + mi * 16 + l15, tok = r0 + row;
        const float rstd = rs[row];
#pragma unroll
        for (int ni = 0; ni < 2; ni++) {
          const int fb = n0 + wc * 32 + ni * 16;
          f32x4 v = acc[mi][ni] * rstd;
          store_h4(p.qm + (size_t)tok * 384 + fb + 4 * g, v[0], v[1], v[2], v[3]);
        }
      }
      __syncthreads();
      if (lat && ct != 0 && ct != 3) {
        const int rc0 = n0 + ((ct == 2 || ct == 5) ? 32 : 0);
        for (int i = tid; i < 128 * 16; i += 256) {
          const int row = i >> 4, e = i & 15, tok = r0 + row;
          const int i8 = e & 7, base = (e < 8) ? 0 : 16;
          const int lpos = (tok - T_CTX) & 2047;
          const int pos = (e < 8) ? (lpos >> 6) : (lpos & 63);
          h16* ptr = p.qm + (size_t)tok * 384 + rc0 + base + i8;
          const float x1 = (float)ptr[0], x2 = (float)ptr[8];
          const float cs = p.cs8[(pos * 8 + i8) * 2], sn = p.cs8[(pos * 8 + i8) * 2 + 1];
          ptr[0] = (h16)(x1 * cs - x2 * sn);
          ptr[8] = (h16)(x1 * sn + x2 * cs);
        }
      }
      __syncthreads();
    }
  }
  for (int it = blockIdx.x; it < 1024 + 128; it += gridDim.x) {
    const int N_KV = 1024;
    {
      const bool cached = it >= N_KV;
      int rt, ct;
      const h16 *A, *Bt;
      int lda;
      if (!cached) { rt = it >> 3; ct = it & 7; A = p.zbuf + (size_t)(rt * 128) * ZLD + 1024; lda = ZLD; Bt = p.wt_kvup + (size_t)layer * 512 * 128; }
      else { int i2 = it - N_KV; rt = i2 >> 3; ct = i2 & 7; int b = rt >> 2, k0 = (rt & 3) * 128; A = p.ckv_c + ((size_t)(b * 2 + layer) * 512 + k0) * 128; lda = 128; Bt = p.wt_kvraw + (size_t)layer * 512 * 128; }
      const int r0 = rt * 128, n0 = ct * 64;
      float* rs = (float*)(smem + 49152);
      if (!cached) {
        row_rstd<128>(p.zbuf + (size_t)r0 * ZLD + 1024, rs);
      } else {
        if (tid < 128) rs[tid] = 1.f;
      }
      f32x4 acc[4][2];
      zero_acc(acc);
      gemm_acc<128, 64>(acc, A, lda, Bt + (size_t)n0 * 128, 128, 128, smem);
      const int head = n0 >> 7;
      const bool vtype = (n0 & 64) != 0;
#pragma unroll
      for (int mi = 0; mi < 4; mi++) {
        const int row = wr * 64 + mi * 16 + l15, tok = r0 + row;
        const float rstd = rs[row];
#pragma unroll
        for (int ni = 0; ni < 2; ni++) {
          const int d0 = wc * 32 + ni * 16 + 4 * g;
          f32x4 v = acc[mi][ni] * rstd;
          if (!vtype) {
            h16* dst = p.kmla + (cached ? (size_t)T_ALL * 384 : (size_t)0);
            store_h4(dst + (size_t)tok * 384 + head * 96 + d0, v[0], v[1], v[2], v[3]);
          } else {
            h16* vt; int bb, l, Ls;
            int voff;
            if (cached) { voff = 4194304; bb = tok >> 9; l = tok & 511; Ls = 512; }
            else if (tok < T_CTX) { voff = 0; bb = tok >> 8; l = tok & 255; Ls = 256; }
            else { voff = 2097152; bb = (tok - T_CTX) >> 11; l = (tok - T_CTX) & 2047; Ls = 2048; }
            vt = p.vt_m_ctx + voff;
#pragma unroll
            for (int j = 0; j < 4; j++) vt[((size_t)(bb * 4 + head) * 64 + d0 + j) * Ls + l] = (h16)v[j];
          }
        }
      }
      if (ct == 0 && !cached && r0 < T_CTX) {
        const float* gk = p.mla_kv_norm + layer * 128;
        for (int i = tid; i < 128 * 128; i += 256) {
          int row = i >> 7, k = i & 127, tok = r0 + row;
          float v = (float)p.zbuf[(size_t)tok * ZLD + 1024 + k] * rs[row] * gk[k];
          p.out[O_CKV + ((size_t)((tok >> 8) * 2 + layer) * 256 + (tok & 255)) * 128 + k] = v;
        }
      }
      if (ct == 1) {
        for (int i = tid; i < 128 * 16; i += 256) {
          int row = i >> 4, e = i & 15, tok = r0 + row;
          float x1, x2;
          h16* dst;
          if (cached) {
            int bb = tok >> 9, key = tok & 511;
            const float* src = p.cache_mla_kpe + ((size_t)(bb * 2 + layer) * 512 + key) * 32;
            x1 = src[e]; x2 = src[16 + e];
            dst = p.kmla + (size_t)T_ALL * 384 + (size_t)tok * 384;
            for (int h = 0; h < 4; h++) { dst[h * 96 + 64 + e] = (h16)x1; dst[h * 96 + 80 + e] = (h16)x2; }
          } else {
            const h16* src = p.zbuf + (size_t)tok * ZLD + 1152;
            int i8 = e & 7, base = (e < 8) ? 0 : 16;
            x1 = (float)src[base + i8]; x2 = (float)src[base + 8 + i8];
            float o1 = x1, o2 = x2;
            if (tok >= T_CTX) {
              int lpos = (tok - T_CTX) & 2047;
              int pos = (e < 8) ? (lpos >> 6) : (lpos & 63);
              float cs = p.cs8[(pos * 8 + i8) * 2], sn = p.cs8[(pos * 8 + i8) * 2 + 1];
              o1 = x1 * cs - x2 * sn; o2 = x1 * sn + x2 * cs;
            }
            dst = p.kmla + (size_t)tok * 384;
            for (int h = 0; h < 4; h++) { dst[h * 96 + 64 + base + i8] = (h16)o1; dst[h * 96 + 64 + base + 8 + i8] = (h16)o2; }
          }
        }
      }
      __syncthreads();
    }
  }
  for (int it = blockIdx.x; it < 128; it += gridDim.x) {
    {
      const int t0 = T_CTX + it * 64;
      for (int i = tid; i < 64 * 192; i += 256) {
        int tl = i / 192, pr = i % 192;
        int tok = t0 + tl, lpos = (tok - T_CTX) & 2047;
        int head = pr >> 5, w = pr & 31;
        int i16 = w & 15, base = (w < 16) ? 0 : 32;
        int pos = (w < 16) ? (lpos >> 6) : (lpos & 63);
        h16* ptr = p.zbuf + (size_t)tok * ZLD + head * 64 + base + i16;
        float x1 = (float)ptr[0], x2 = (float)ptr[16];
        float cs = p.cs16[(pos * 16 + i16) * 2], sn = p.cs16[(pos * 16 + i16) * 2 + 1];
        ptr[0] = (h16)(x1 * cs - x2 * sn);
        ptr[16] = (h16)(x1 * sn + x2 * cs);
      }
    }
  }
}

struct Seg { const h16* K; const h16* Vt; int ldk, ldv, ntiles; };

template <int DQK, int MODE>
__device__ void attn_item(const h16* __restrict__ Q, int ldq, Seg s0, Seg s1, float scale_l2, bool has_sink, float sink_l2,
                          int qpos0, int kpos0, const float* __restrict__ rpb_h, int qrow, int krow0,
                          h16* __restrict__ outp, const h16* __restrict__ gate, char* smem) {
  constexpr int KCH = DQK / 8;
  constexpr int KROWB = DQK * 2;
  constexpr int KPT = 64 * KCH / 256;
  constexpr int KBYTES = 64 * KROWB;
  constexpr int STAGE = KBYTES + 8192;
  constexpr int NKS = DQK / 32;
  const int tid = threadIdx.x, lane = tid & 63, wid = tid >> 6, l15 = lane & 15, g = lane >> 4;
  h16x8 qf[NKS];
#pragma unroll
  for (int ks = 0; ks < NKS; ks++) qf[ks] = *(const h16x8*)(Q + (size_t)(wid * 16 + l15) * ldq + ks * 32 + 8 * g);
  float m = has_sink ? sink_l2 : -1e30f;
  float lsum = (has_sink && g == 0) ? 1.f : 0.f;
  f32x4 o[4];
#pragma unroll
  for (int i = 0; i < 4; i++) o[i] = f32x4{0.f, 0.f, 0.f, 0.f};
  const int ntot = s0.ntiles + s1.ntiles;
  u32x4 rk[KPT], rv[2];
#define TILE_PTRS(ti_) \
    const h16 *kp, *vp; int ldk, ldv; \
    if ((ti_) < s0.ntiles) { kp = s0.K + (size_t)(ti_) * 64 * s0.ldk; vp = s0.Vt + (ti_) * 64; ldk = s0.ldk; ldv = s0.ldv; } \
    else { int t2 = (ti_) - s0.ntiles; kp = s1.K + (size_t)t2 * 64 * s1.ldk; vp = s1.Vt + t2 * 64; ldk = s1.ldk; ldv = s1.ldv; }
  {
    TILE_PTRS(0)
#pragma unroll
    for (int i = 0; i < KPT; i++) { int c = tid + i * 256; int row = c / KCH, sl = c % KCH; rk[i] = *(const u32x4*)(kp + (size_t)row * ldk + sl * 8); }
#pragma unroll
    for (int i = 0; i < 2; i++) { int c = tid + i * 256; int row = c >> 3, sl = c & 7; rv[i] = *(const u32x4*)(vp + (size_t)row * ldv + sl * 8); }
    char* sk = smem; char* sv = smem + KBYTES;
#pragma unroll
    for (int i = 0; i < KPT; i++) { int c = tid + i * 256; int row = c / KCH, sl = c % KCH; int off = (DQK == 64) ? SWZ(row, sl) : (row * KROWB + sl * 16); *(u32x4*)(sk + off) = rk[i]; }
#pragma unroll
    for (int i = 0; i < 2; i++) { int c = tid + i * 256; int row = c >> 3, sl = c & 7; *(u32x4*)(sv + SWZ(row, sl)) = rv[i]; }
  }
  __syncthreads();
  for (int ti = 0; ti < ntot; ti++) {
    const bool more = ti + 1 < ntot;
    if (more) {
      TILE_PTRS(ti + 1)
#pragma unroll
      for (int i = 0; i < KPT; i++) { int c = tid + i * 256; int row = c / KCH, sl = c % KCH; rk[i] = *(const u32x4*)(kp + (size_t)row * ldk + sl * 8); }
#pragma unroll
      for (int i = 0; i < 2; i++) { int c = tid + i * 256; int row = c >> 3, sl = c & 7; rv[i] = *(const u32x4*)(vp + (size_t)row * ldv + sl * 8); }
    }
    const char* sk = smem + (ti & 1) * STAGE;
    const char* sv = sk + KBYTES;
    f32x4 s[4];
#pragma unroll
    for (int kf = 0; kf < 4; kf++) {
      s[kf] = f32x4{0.f, 0.f, 0.f, 0.f};
#pragma unroll
      for (int ks = 0; ks < NKS; ks++) {
        const int row = kf * 16 + l15, sl = ks * 4 + g;
        const int off = (DQK == 64) ? SWZ(row, sl) : (row * KROWB + sl * 16);
        h16x8 ka = *(const h16x8*)(sk + off);
        s[kf] = __builtin_amdgcn_mfma_f32_16x16x32_f16(ka, qf[ks], s[kf], 0, 0, 0);
      }
    }
    const bool masked = (MODE != 0) && (ti < s0.ntiles);
    float mx = -INFINITY;
#pragma unroll
    for (int kf = 0; kf < 4; kf++)
#pragma unroll
      for (int j = 0; j < 4; j++) {
        float x = s[kf][j] * scale_l2;
        if (MODE == 1 && masked) {
          int kpos = kpos0 + ti * 64 + kf * 16 + 4 * g + j, qpos = qpos0 + wid * 16 + l15;
          int d = qpos - kpos;
          if (d > 128 || d < -128) x = -INFINITY;
        }
        if (MODE == 2 && masked) {
          int ck = kf * 16 + 4 * g + j, cq = wid * 16 + l15;
          int cs = min(max(cq - 8, 0), 48);
          int rel = ck - cs;
          if (rel < 0 || rel >= 16) x = -INFINITY;
          else {
            int co = min(max(ck - cq, -15), 15) + 15;
            int ro = (krow0 + ti) - qrow + 7;
            x += rpb_h[ro * 31 + co] * LOG2E;
          }
        }
        s[kf][j] = x;
        mx = fmaxf(mx, x);
      }
    mx = fmaxf(mx, __shfl_xor(mx, 16));
    mx = fmaxf(mx, __shfl_xor(mx, 32));
    const float mnew = fmaxf(m, mx);
    const float alpha = exp2f(m - mnew);
    m = mnew;
    float ps = 0.f;
    h16x8 pb[2];
#pragma unroll
    for (int kf = 0; kf < 4; kf++)
#pragma unroll
      for (int j = 0; j < 4; j++) {
        float pv = exp2f(s[kf][j] - mnew);
        ps += pv;
        pb[kf >> 1][(kf & 1) * 4 + j] = (h16)pv;
      }
    lsum = lsum * alpha + ps;
#pragma unroll
    for (int df = 0; df < 4; df++) {
      o[df] = o[df] * alpha;
#pragma unroll
      for (int kk = 0; kk < 2; kk++) {
        const int row = df * 16 + l15;
        const int c0 = 8 * kk + g, c1 = 8 * kk + 4 + g;
        h16x4 v0 = *(const h16x4*)(sv + SWZ(row, c0 >> 1) + (c0 & 1) * 8);
        h16x4 v1 = *(const h16x4*)(sv + SWZ(row, c1 >> 1) + (c1 & 1) * 8);
        h16x8 va = {v0[0], v0[1], v0[2], v0[3], v1[0], v1[1], v1[2], v1[3]};
        o[df] = __builtin_amdgcn_mfma_f32_16x16x32_f16(va, pb[kk], o[df], 0, 0, 0);
      }
    }
    if (more) {
      char* wk = smem + ((ti + 1) & 1) * STAGE; char* wv = wk + KBYTES;
#pragma unroll
      for (int i = 0; i < KPT; i++) { int c = tid + i * 256; int row = c / KCH, sl = c % KCH; int off = (DQK == 64) ? SWZ(row, sl) : (row * KROWB + sl * 16); *(u32x4*)(wk + off) = rk[i]; }
#pragma unroll
      for (int i = 0; i < 2; i++) { int c = tid + i * 256; int row = c >> 3, sl = c & 7; *(u32x4*)(wv + SWZ(row, sl)) = rv[i]; }
    }
    __syncthreads();
  }
  lsum += __shfl_xor(lsum, 16);
  lsum += __shfl_xor(lsum, 32);
  const float inv = 1.f / lsum;
  const int qr = wid * 16 + l15;
#pragma unroll
  for (int df = 0; df < 4; df++) {
    const int d = df * 16 + 4 * g;
    h16x4 gv = *(const h16x4*)(gate + (size_t)qr * ZLD + d);
    store_h4(outp + (size_t)qr * 1024 + d, o[df][0] * inv * siluf_((float)gv[0]), o[df][1] * inv * siluf_((float)gv[1]),
             o[df][2] * inv * siluf_((float)gv[2]), o[df][3] * inv * siluf_((float)gv[3]));
  }
}

__device__ void phase_att(const Params& p, int layer, char* smem) {
  const float sc64 = 0.125f * LOG2E, sc96 = 0.10206207261596575f * LOG2E;
  Seg s0, s1;
  for (int idx = blockIdx.x; idx < 512; idx += gridDim.x) s5_item(p, layer, 2, idx >> 7, (idx >> 3) & 15, idx & 7, smem);
  for (int it = blockIdx.x; it < 1024; it += gridDim.x) {
    const bool lat = it < 512;
    const int idx = it & 511;
    int b, h, tokb, tok0;
    if (lat) { b = idx >> 7; h = (idx >> 5) & 3; tokb = T_CTX + b * 2048; tok0 = tokb + (idx & 31) * 64; }
    else { b = idx >> 4; h = (idx >> 2) & 3; tokb = b * 256; tok0 = tokb + (idx & 3) * 64; }
    s0.K = p.kmla + (size_t)tokb * 384 + h * 96; s0.ldk = 384;
    if (lat) {
      s0.Vt = p.vt_m_lat + (size_t)(b * 4 + h) * 64 * 2048; s0.ldv = 2048; s0.ntiles = 32;
      s1.K = p.kcx + (size_t)(b * 512) * 384 + h * 96; s1.ldk = 384; s1.Vt = p.vcx_t + (size_t)(b * 4 + h) * 64 * 512; s1.ldv = 512; s1.ntiles = 8;
    } else {
      s0.Vt = p.vt_m_ctx + (size_t)(b * 4 + h) * 64 * 256; s0.ldv = 256; s0.ntiles = 4;
      s1.K = s0.K; s1.Vt = s0.Vt; s1.ldk = 0; s1.ldv = 0; s1.ntiles = 0;
    }
    attn_item<96, 0>(p.qm + (size_t)tok0 * 384 + h * 96, 384, s0, s1, sc96, false, 0.f, 0, 0, nullptr, 0, 0,
                     p.br + (size_t)tok0 * 1024 + 256 + h * 64, p.zbuf + (size_t)tok0 * ZLD + 1184 + h * 64, smem);
  }
  for (int idx = blockIdx.x; idx < 512; idx += gridDim.x) {
    const int b = idx >> 7, h = (idx >> 5) & 3, qt = idx & 31;
    const int tokb = T_CTX + b * 2048, tok0 = tokb + qt * 64;
    const int r = qt, rs = min(max(r - 4, 0), 24);
    s0.K = p.zbuf + (size_t)(tokb + rs * 64) * ZLD + 2208 + h * 64; s0.ldk = ZLD; s0.Vt = p.vt_d_lat + (size_t)(b * 4 + h) * 64 * 2048 + rs * 64; s0.ldv = 2048; s0.ntiles = 8;
    s1.K = p.ck_n + (size_t)((b * 2 + layer) * 512) * 256 + h * 64; s1.ldk = 256; s1.Vt = p.cvt_n + (size_t)((b * 2 + layer) * 4 + h) * 64 * 512; s1.ldv = 512; s1.ntiles = 8;
    attn_item<64, 2>(p.zbuf + (size_t)tok0 * ZLD + 1952 + h * 64, ZLD, s0, s1, sc64, false, 0.f, 0, 0,
                     p.na_rpb + (size_t)(layer * 4 + h) * 15 * 31, r, rs,
                     p.br + (size_t)tok0 * 1024 + 768 + h * 64, p.zbuf + (size_t)tok0 * ZLD + 2720 + h * 64, smem);
  }
  for (int idx = blockIdx.x; idx < 512; idx += gridDim.x) {
    const int b = idx >> 7, h = (idx >> 5) & 3, qt = idx & 31;
    const int tokb = T_CTX + b * 2048, tok0 = tokb + qt * 64;
    const int hk = h >> 1, q0 = qt * 64;
    const int ks = max(0, q0 - 128), ke = min(2048, q0 + 192);
    s0.K = p.zbuf + (size_t)(tokb + ks) * ZLD + 256 + hk * 64; s0.ldk = ZLD; s0.Vt = p.vt_a_lat + (size_t)(b * 2 + hk) * 64 * 2048 + ks; s0.ldv = 2048; s0.ntiles = (ke - ks) >> 6;
    s1.K = p.ck_a + (size_t)((b * 2 + layer) * 512) * 128 + hk * 64; s1.ldk = 128; s1.Vt = p.cvt_a + (size_t)((b * 2 + layer) * 2 + hk) * 64 * 512; s1.ldv = 512; s1.ntiles = 8;
    attn_item<64, 1>(p.zbuf + (size_t)tok0 * ZLD + h * 64, ZLD, s0, s1, sc64, true, p.a_sink[layer * 4 + h] * LOG2E, q0, ks, nullptr, 0, 0,
                     p.br + (size_t)tok0 * 1024 + h * 64, p.zbuf + (size_t)tok0 * ZLD + 512 + h * 64, smem);
  }
  for (int it = blockIdx.x; it < 1024; it += gridDim.x) {
    const bool isA = it < 512;
    const int idx = it & 511;
    const int b = idx >> 4, h = (idx >> 2) & 3, qt = idx & 3;
    const int tokb = b * 256, tok0 = tokb + qt * 64;
    int qcol, kcol, gcol, bcol;
    if (isA) { const int hk = h >> 1; qcol = h * 64; kcol = 256 + hk * 64; gcol = 512 + h * 64; bcol = h * 64; s0.Vt = p.vt_a_ctx + (size_t)(b * 2 + hk) * 64 * 256; }
    else { qcol = 1952 + h * 64; kcol = 2208 + h * 64; gcol = 2720 + h * 64; bcol = 768 + h * 64; s0.Vt = p.vt_d_ctx + (size_t)(b * 4 + h) * 64 * 256; }
    s0.K = p.zbuf + (size_t)tokb * ZLD + kcol; s0.ldk = ZLD; s0.ldv = 256; s0.ntiles = 4;
    s1.K = s0.K; s1.Vt = s0.Vt; s1.ldk = 0; s1.ldv = 0; s1.ntiles = 0;
    const float sink = isA ? p.a_sink[layer * 4 + h] * LOG2E : 0.f;
    attn_item<64, 0>(p.zbuf + (size_t)tok0 * ZLD + qcol, ZLD, s0, s1, sc64, isA, sink, 0, 0, nullptr, 0, 0,
                     p.br + (size_t)tok0 * 1024 + bcol, p.zbuf + (size_t)tok0 * ZLD + gcol, smem);
  }
}

__device__ void phase_glu(const Params& p, int layer, char* smem) {
  const int lane = threadIdx.x & 63, wid = threadIdx.x >> 6, wr = wid >> 1, wc = wid & 1, l15 = lane & 15, g = lane >> 4;
  for (int tile = blockIdx.x; tile < 128 * 8; tile += gridDim.x) {
    const int rt = tile >> 3, ct = tile & 7, r0 = rt * 128, n0 = ct * 64;
    f32x4 acc[4][2];
    zero_acc(acc);
    gemm_acc<128, 64>(acc, p.zbuf + (size_t)r0 * ZLD + 1440, ZLD, p.wt_glu + (size_t)layer * 512 * 256 + (size_t)n0 * 256, 256, 256, smem);
#pragma unroll
    for (int mi = 0; mi < 4; mi++) {
      const int tok = r0 + wr * 64 + mi * 16 + l15;
#pragma unroll
      for (int np = 0; np < 1; np++) {
        const int pn = n0 + wc * 32 + np * 32;
        const int col = (pn >> 5) * 16 + 4 * g;
        f32x4 val = acc[mi][np * 2], gt = acc[mi][np * 2 + 1];
        h16x4 cg_ = *(const h16x4*)(p.zbuf + (size_t)tok * ZLD + 1696 + col);
        store_h4(p.br + (size_t)tok * 1024 + 512 + col, val[0] * sigmoidf_(gt[0]) * siluf_((float)cg_[0]),
                 val[1] * sigmoidf_(gt[1]) * siluf_((float)cg_[1]), val[2] * sigmoidf_(gt[2]) * siluf_((float)cg_[2]),
                 val[3] * sigmoidf_(gt[3]) * siluf_((float)cg_[3]));
      }
    }
  }
}

__device__ void phase_g3(const Params& p, int layer, char* smem) {
  const int lane = threadIdx.x & 63, wid = threadIdx.x >> 6, wr = wid >> 1, wc = wid & 1, l15 = lane & 15, g = lane >> 4;
  const h16* Wm = p.wt_merge + (size_t)layer * 4096 * 1024;
  const h16* Wb = p.wt_branch + (size_t)layer * 4 * 1024 * 256;
  h16* mbuf = p.zbuf;
  for (int tile = blockIdx.x; tile < 128 * 16; tile += gridDim.x) {
    const int rt = tile >> 4, ct = tile & 15, r0 = rt * 128, d0 = ct * 64;
    f32x4 macc[4][2];
    zero_acc(macc);
    for (int k = 0; k < 4; k++) {
      f32x4 a1[4][2], a2[4][2];
      zero_acc(a1);
      zero_acc(a2);
      gemm_acc<128, 64>(a1, p.hbuf + (size_t)r0 * 1024, 1024, Wm + (size_t)(k * 1024 + d0) * 1024, 1024, 1024, smem);
      gemm_acc<128, 64>(a2, p.br + (size_t)r0 * 1024 + k * 256, 1024, Wb + (size_t)(k * 1024 + d0) * 256, 256, 256, smem);
#pragma unroll
      for (int mi = 0; mi < 4; mi++)
#pragma unroll
        for (int ni = 0; ni < 2; ni++)
#pragma unroll
          for (int j = 0; j < 4; j++) macc[mi][ni][j] += sigmoidf_(a1[mi][ni][j]) * a2[mi][ni][j];
    }
#pragma unroll
    for (int mi = 0; mi < 4; mi++)
#pragma unroll
      for (int ni = 0; ni < 2; ni++) {
        const int tok = r0 + wr * 64 + mi * 16 + l15, col = d0 + wc * 32 + ni * 16 + 4 * g;
        f32x4 v = macc[mi][ni];
        store_h4(mbuf + (size_t)tok * 1024 + col, v[0], v[1], v[2], v[3]);
      }
  }
}

__device__ void phase_g4(const Params& p, int layer, char* smem) {
  const int lane = threadIdx.x & 63, wid = threadIdx.x >> 6, wr = wid >> 1, wc = wid & 1, l15 = lane & 15, g = lane >> 4;
  const h16* Wo = p.wt_out + (size_t)layer * 1048576;
  const h16* mbuf = p.zbuf;
  for (int tile = blockIdx.x; tile < 128 * 8; tile += gridDim.x) {
    const int rt = tile >> 3, ct = tile & 7, r0 = rt * 128, n0 = ct * 128;
    f32x4 acc[4][4];
    zero_acc(acc);
    gemm_acc<128, 128>(acc, mbuf + (size_t)r0 * 1024, 1024, Wo + (size_t)n0 * 1024, 1024, 1024, smem);
#pragma unroll
    for (int mi = 0; mi < 4; mi++) {
      const int tok = r0 + wr * 64 + mi * 16 + l15;
      const float* xo = xptr(p, layer, tok);
      const float* gt = p.modv + (layer * 5 + cond_of(tok)) * 3072 + 2048;
#pragma unroll
      for (int ni = 0; ni < 4; ni++) {
        const int col = n0 + wc * 64 + ni * 16 + 4 * g;
        float4 xv = *(const float4*)(xo + col), gv = *(const float4*)(gt + col);
        f32x4 v = acc[mi][ni];
        *(float4*)(p.out + (size_t)tok * 1024 + col) = make_float4(xv.x + gv.x * v[0], xv.y + gv.y * v[1], xv.z + gv.z * v[2], xv.w + gv.w * v[3]);
      }
    }
  }
}

#define N_PHASES 16
template <int PH>
__device__ __forceinline__ void run_phase(const Params& p, char* smem) {
  if constexpr (PH == 0) phase_prep(p, smem);
  else if constexpr (PH == 15) phase_final(p);
  else {
    constexpr int layer = (PH - 1) / 7, s = (PH - 1) % 7;
    if constexpr (s == 0) phase_norm(p, layer);
    else if constexpr (s == 1) phase_g1(p, layer, smem);
    else if constexpr (s == 2) phase_g2(p, layer, smem);
    else if constexpr (s == 3) phase_att(p, layer, smem);
    else if constexpr (s == 4) phase_glu(p, layer, smem);
    else if constexpr (s == 5) phase_g3(p, layer, smem);
    else phase_g4(p, layer, smem);
  }
}

template <int PH>
__global__ void __launch_bounds__(256, 2) phase_kernel(Params p) {
  __shared__ __attribute__((aligned(16))) char smem[65536];
  run_phase<PH>(p, smem);
}

#ifndef MULTI_LAUNCH
template <int PH>
__device__ __forceinline__ void run_from(const Params& p, char* smem) {
  run_phase<PH>(p, smem);
  if constexpr (PH + 1 < N_PHASES) {
    cg::this_grid().sync();
    run_from<PH + 1>(p, smem);
  }
}

__global__ void __launch_bounds__(256, 2) mega(Params p) {
  __shared__ __attribute__((aligned(16))) char smem[65536];
  run_from<0>(p, smem);
}
#endif

template <int PH>
static void launch_phases(const Params& p, int grid, hipStream_t stream) {
  hipLaunchKernelGGL(phase_kernel<PH>, dim3(grid), dim3(256), 0, stream, p);
  if constexpr (PH + 1 < N_PHASES) launch_phases<PH + 1>(p, grid, stream);
}

static inline size_t al256(size_t x) { return (x + 255) & ~(size_t)255; }

extern "C" void kernel_launch(void* const* d_in, const int* in_sizes, int n_in, void* d_out, int out_size, void* d_ws,
                              size_t ws_size, hipStream_t stream) {
  Params p{};
  const float** ip = (const float**)&p;
  for (int i = 0; i < 35; i++) ip[i] = (const float*)d_in[i];
  p.out = (float*)d_out;
  char* w = (char*)d_ws;
  size_t off = 0;
  auto take = [&](size_t bytes) { char* r = w + off; off = al256(off + bytes); return r; };
  p.wt_in = (h16*)take((size_t)2 * 3072 * 1024 * 2);
  p.wt_merge = (h16*)take((size_t)2 * 4096 * 1024 * 2);
  p.wt_branch = (h16*)take((size_t)2 * 4 * 1024 * 256 * 2);
  p.wt_out = (h16*)take((size_t)2 * 1024 * 1024 * 2);
  p.wt_qup = (h16*)take((size_t)2 * 384 * 256 * 2);
  p.wt_kvup = (h16*)take((size_t)2 * 512 * 128 * 2);
  p.wt_kvraw = (h16*)take((size_t)2 * 512 * 128 * 2);
  p.wt_glu = (h16*)take((size_t)2 * 512 * 256 * 2);
  p.hbuf = (h16*)take((size_t)T_ALL * 1024 * 2);
  p.zbuf = (h16*)take((size_t)T_ALL * ZLD * 2);
  p.br = (h16*)take((size_t)T_ALL * 1024 * 2);
  p.qm = (h16*)take((size_t)T_ALL * 384 * 2);
  p.kmla = (h16*)take((size_t)T_ALL * 384 * 2);
  p.kcx = (h16*)take((size_t)2048 * 384 * 2);
  p.vt_a_ctx = (h16*)take((size_t)32 * 2 * 64 * 256 * 2);
  p.vt_a_lat = (h16*)take((size_t)4 * 2 * 64 * 2048 * 2);
  p.vt_d_ctx = (h16*)take((size_t)32 * 4 * 64 * 256 * 2);
  p.vt_d_lat = (h16*)take((size_t)4 * 4 * 64 * 2048 * 2);
  p.vt_m_ctx = (h16*)take((size_t)32 * 4 * 64 * 256 * 2);
  p.vt_m_lat = (h16*)take((size_t)4 * 4 * 64 * 2048 * 2);
  p.vcx_t = (h16*)take((size_t)4 * 4 * 64 * 512 * 2);
  p.ck_a = (h16*)take((size_t)524288 * 2);
  p.cvt_a = (h16*)take((size_t)524288 * 2);
  p.ck_n = (h16*)take((size_t)1048576 * 2);
  p.cvt_n = (h16*)take((size_t)1048576 * 2);
  p.ckv_c = (h16*)take((size_t)524288 * 2);
  p.s5_bmt = (h16*)take((size_t)64 * 128 * 16 * 2);
  p.s5_cmt = (h16*)take((size_t)64 * 16 * 128 * 2);
  p.s5_abar = (float*)take(4096 * 2 * 4);
  p.s5_lamdt = (float*)take(4096 * 2 * 4);
  p.s5_dt = (float*)take(64 * 4);
  p.s5_e = (float*)take((size_t)4 * 16 * 2 * 8 * 128 * 4);
  p.modv = (float*)take(2 * 5 * 3072 * 4);
  p.cs16 = (float*)take(64 * 16 * 2 * 4);
  p.cs8 = (float*)take(64 * 8 * 2 * 4);
  if (off > ws_size) { fprintf(stderr, "workspace too small: need %zu have %zu\n", off, ws_size); return; }

  static int grid_blocks = 0;
  if (!grid_blocks) {
    int dev = 0, cus = 0, per_cu = 0;
    (void)hipGetDevice(&dev);
    (void)hipDeviceGetAttribute(&cus, hipDeviceAttributeMultiprocessorCount, dev);
    #ifdef MULTI_LAUNCH
    (void)hipOccupancyMaxActiveBlocksPerMultiprocessor(&per_cu, phase_kernel<3>, 256, 0);
#else
    (void)hipOccupancyMaxActiveBlocksPerMultiprocessor(&per_cu, mega, 256, 0);
#endif
    if (per_cu > 2) per_cu = 2;
    if (per_cu < 1) per_cu = 1;
    grid_blocks = cus * per_cu;
  }
#ifdef MULTI_LAUNCH
  launch_phases<0>(p, grid_blocks, stream);
#else
  void* args[] = {&p};
  hipError_t e = hipLaunchCooperativeKernel((void*)mega, dim3(grid_blocks), dim3(256), args, 0, stream);
  if (e != hipSuccess) fprintf(stderr, "cooperative launch failed: %s (grid %d)\n", hipGetErrorString(e), grid_blocks);
#endif
}
```

```cpp
#include <hip/hip_runtime.h>
#include <hip/hip_cooperative_groups.h>
#include <cstdio>
#include <cstdint>
namespace cg = cooperative_groups;

typedef _Float16 h16;
typedef __attribute__((ext_vector_type(8))) _Float16 h16x8;
typedef __attribute__((ext_vector_type(4))) _Float16 h16x4;
typedef __attribute__((ext_vector_type(4))) float f32x4;
typedef __attribute__((ext_vector_type(4))) unsigned int u32x4;

#define T_ALL 16384
#define T_CTX 8192
#define ZLD 2976
#define LOG2E 1.4426950408889634f

#define O_AK   16777216
#define O_AV   18874368
#define O_CKV  20971520
#define O_KPE  23068672
#define O_NK   23592960
#define O_NV   27787264
#define O_SRE  31981568
#define O_SIM  32112640

struct Params {
  const float *x_prompt, *x_sample, *cache_a_k, *cache_a_v, *cache_mla_ckv, *cache_mla_kpe, *cache_na_k, *cache_na_v,
      *state_re, *state_im, *c, *c_ctx, *w_mod, *b_mod, *norm_g, *w_in, *w_merge, *a_sink, *mla_q_norm, *mla_w_q_up,
      *mla_kv_norm, *mla_w_kv_up, *s5_lam_re, *s5_lam_im, *s5_log_dt, *s5_b_re, *s5_b_im, *s5_c_re, *s5_c_im, *s5_d,
      *s5_w_glu, *na_rpb, *w_branch, *w_out, *final_norm_g;
  float* out;
  h16 *wt_in, *wt_merge, *wt_branch, *wt_out, *wt_qup, *wt_kvup, *wt_kvraw, *wt_glu;
  h16 *hbuf, *zbuf, *br, *qm, *kmla, *kcx, *vt_a_ctx, *vt_a_lat, *vt_d_ctx, *vt_d_lat, *vt_m_ctx, *vt_m_lat, *vcx_t,
      *ck_a, *cvt_a, *ck_n, *cvt_n, *ckv_c, *s5_bmt, *s5_cmt;
  float *s5_abar, *s5_lamdt, *s5_dt, *s5_e, *modv, *cs16, *cs8;
  unsigned* bar;
};

__device__ __forceinline__ float sigmoidf_(float x) { return 1.f / (1.f + __expf(-x)); }
__device__ __forceinline__ float siluf_(float x) { return x * sigmoidf_(x); }
__device__ __forceinline__ float geluf_(float x) {
  float u = 0.7978845608028654f * (x + 0.044715f * x * x * x);
  return 0.5f * x * (1.f + tanhf(u));
}
__device__ __forceinline__ float wave_sum(float v) {
#pragma unroll
  for (int o = 32; o > 0; o >>= 1) v += __shfl_xor(v, o);
  return v;
}
__device__ __forceinline__ const float* xptr(const Params p, int layer, int tok) {
  if (layer == 0) return tok < T_CTX ? p.x_prompt + (size_t)tok * 1024 : p.x_sample + (size_t)(tok - T_CTX) * 1024;
  return p.out + (size_t)tok * 1024;
}
__device__ __forceinline__ int cond_of(int tok) { return tok < T_CTX ? 0 : 1 + ((tok - T_CTX) >> 11); }

#define SWZ(row, slot) (((row) << 7) + ((((slot) ^ (((row) >> 1) & 7))) << 4))

template <int BM, int BN>
__device__ __forceinline__ void gemm_acc(f32x4 (&acc)[BM / 32][BN / 32], const h16* __restrict__ A, int lda,
                                         const h16* __restrict__ Bt, int ldb, int K, char* smem) {
  constexpr int MREP = BM / 32, NREP = BN / 32;
  constexpr int ACH = BM * 8 / 256, BCH = BN * 8 / 256;
  constexpr int ABYTES = BM * 128, STAGE = (BM + BN) * 128;
  const int tid = threadIdx.x, lane = tid & 63, wid = tid >> 6;
  const int wr = wid >> 1, wc = wid & 1;
  const int l15 = lane & 15, g = lane >> 4;
  u32x4 ra[ACH], rb[BCH];
  const int nk = K >> 6;
  const h16* Ap = A + (size_t)(tid >> 3) * lda + (tid & 7) * 8;
  const h16* Bp = Bt + (size_t)(tid >> 3) * ldb + (tid & 7) * 8;
#pragma unroll
  for (int i = 0; i < ACH; i++) ra[i] = *(const u32x4*)(Ap + (size_t)(i * 32) * lda);
#pragma unroll
  for (int i = 0; i < BCH; i++) rb[i] = *(const u32x4*)(Bp + (size_t)(i * 32) * ldb);
  {
    char* sa = smem;
    char* sb = smem + ABYTES;
#pragma unroll
    for (int i = 0; i < ACH; i++) *(u32x4*)(sa + SWZ((tid >> 3) + i * 32, tid & 7)) = ra[i];
#pragma unroll
    for (int i = 0; i < BCH; i++) *(u32x4*)(sb + SWZ((tid >> 3) + i * 32, tid & 7)) = rb[i];
  }
  __syncthreads();
  for (int kt = 0; kt < nk; kt++) {
    const bool more = (kt + 1 < nk);
    if (more) {
#pragma unroll
      for (int i = 0; i < ACH; i++) ra[i] = *(const u32x4*)(Ap + (size_t)(i * 32) * lda + (kt + 1) * 64);
#pragma unroll
      for (int i = 0; i < BCH; i++) rb[i] = *(const u32x4*)(Bp + (size_t)(i * 32) * ldb + (kt + 1) * 64);
    }
    const char* sa = smem + (kt & 1) * STAGE;
    const char* sb = sa + ABYTES;
#pragma unroll
    for (int ks = 0; ks < 2; ks++) {
      h16x8 af[MREP], bf[NREP];
#pragma unroll
      for (int mi = 0; mi < MREP; mi++) af[mi] = *(const h16x8*)(sa + SWZ(wr * (BM / 2) + mi * 16 + l15, ks * 4 + g));
#pragma unroll
      for (int ni = 0; ni < NREP; ni++) bf[ni] = *(const h16x8*)(sb + SWZ(wc * (BN / 2) + ni * 16 + l15, ks * 4 + g));
#pragma unroll
      for (int mi = 0; mi < MREP; mi++)
#pragma unroll
        for (int ni = 0; ni < NREP; ni++)
          acc[mi][ni] = __builtin_amdgcn_mfma_f32_16x16x32_f16(bf[ni], af[mi], acc[mi][ni], 0, 0, 0);
    }
    if (more) {
      char* wa = smem + ((kt + 1) & 1) * STAGE;
      char* wb = wa + ABYTES;
#pragma unroll
      for (int i = 0; i < ACH; i++) *(u32x4*)(wa + SWZ((tid >> 3) + i * 32, tid & 7)) = ra[i];
#pragma unroll
      for (int i = 0; i < BCH; i++) *(u32x4*)(wb + SWZ((tid >> 3) + i * 32, tid & 7)) = rb[i];
    }
    __syncthreads();
  }
}

template <int M, int N>
__device__ __forceinline__ void zero_acc(f32x4 (&a)[M][N]) {
#pragma unroll
  for (int i = 0; i < M; i++)
#pragma unroll
    for (int j = 0; j < N; j++) a[i][j] = f32x4{0.f, 0.f, 0.f, 0.f};
}

__device__ __forceinline__ void store_h4(h16* dst, float a, float b, float c, float d) {
  h16x4 v = {(h16)a, (h16)b, (h16)c, (h16)d};
  *(h16x4*)dst = v;
}

__device__ void tr_tile(const float* __restrict__ src, int lds_, h16* __restrict__ dst, int ldd, int k0, int n0, int N,
                        char* smem) {
  float* tile = (float*)smem;
  const int tid = threadIdx.x;
  const int r = tid >> 4, c4 = tid & 15;
#pragma unroll
  for (int rr = 0; rr < 4; rr++) {
    int kl = r + rr * 16;
    int n = n0 + c4 * 4;
    float4 v = make_float4(0.f, 0.f, 0.f, 0.f);
    if (n < N) v = *(const float4*)(src + (size_t)(k0 + kl) * lds_ + n);
    tile[kl * 65 + c4 * 4 + 0] = v.x;
    tile[kl * 65 + c4 * 4 + 1] = v.y;
    tile[kl * 65 + c4 * 4 + 2] = v.z;
    tile[kl * 65 + c4 * 4 + 3] = v.w;
  }
  __syncthreads();
  const int nl = tid >> 2, kq = tid & 3;
  h16x8 o0, o1;
#pragma unroll
  for (int i = 0; i < 8; i++) {
    o0[i] = (h16)tile[(kq * 16 + i) * 65 + nl];
    o1[i] = (h16)tile[(kq * 16 + 8 + i) * 65 + nl];
  }
  h16* d = dst + (size_t)(n0 + nl) * ldd + k0 + kq * 16;
  *(h16x8*)d = o0;
  *(h16x8*)(d + 8) = o1;
  __syncthreads();
}

__device__ void phase_prep(const Params p, char* smem) {
  const int tid = threadIdx.x;
  const size_t gtid = (size_t)blockIdx.x * 256 + tid, gsz = (size_t)gridDim.x * 256;
  for (size_t i = gtid; i < 2 * 384 * 256; i += gsz) {
    int l = i / (384 * 256), r = i % (384 * 256), n = r / 256, k = r % 256;
    p.wt_qup[i] = (h16)(p.mla_q_norm[l * 256 + k] * p.mla_w_q_up[(size_t)l * 256 * 384 + k * 384 + n]);
  }
  for (size_t i = gtid; i < 2 * 512 * 128; i += gsz) {
    int l = i / (512 * 128), r = i % (512 * 128), n = r / 128, k = r % 128;
    float w = p.mla_w_kv_up[(size_t)l * 128 * 512 + k * 512 + n];
    p.wt_kvraw[i] = (h16)w;
    p.wt_kvup[i] = (h16)(w * p.mla_kv_norm[l * 128 + k]);
  }
  for (size_t i = gtid; i < 2 * 512 * 256; i += gsz) {
    int l = i / (512 * 256), r = i % (512 * 256), n = r / 256, k = r % 256;
    int q = n >> 5, w = n & 31;
    int orig = (w < 16) ? (q * 16 + w) : (256 + q * 16 + (w - 16));
    p.wt_glu[i] = (h16)p.s5_w_glu[(size_t)l * 256 * 512 + k * 512 + orig];
  }
  for (size_t i = gtid; i < 524288; i += gsz) {
    p.ck_a[i] = (h16)p.cache_a_k[i];
    p.ckv_c[i] = (h16)p.cache_mla_ckv[i];
  }
  for (size_t i = gtid; i < 1048576; i += gsz) p.ck_n[i] = (h16)p.cache_na_k[i];
  for (size_t i = gtid; i < 4096; i += gsz) {
    int ldg = i >> 6;
    float lr = fminf(p.s5_lam_re[i], -1e-4f), li = p.s5_lam_im[i];
    float dt = __expf(p.s5_log_dt[ldg]);
    float er = expf(lr * dt), sn, cs;
    sincosf(li * dt, &sn, &cs);
    float ar = er * cs, ai = er * sn;
    p.s5_abar[i * 2] = ar;
    p.s5_abar[i * 2 + 1] = ai;
    p.s5_lamdt[i * 2] = lr * dt;
    p.s5_lamdt[i * 2 + 1] = li * dt;
    if ((i & 63) == 0) p.s5_dt[ldg] = dt;
    float nr = ar - 1.f, ni = ai, den = lr * lr + li * li;
    float cr = (nr * lr + ni * li) / den / dt, ci = (ni * lr - nr * li) / den / dt;
    int pp = i & 63;
    for (int c = 0; c < 16; c++) {
      float br_ = p.s5_b_re[i * 16 + c], bi_ = p.s5_b_im[i * 16 + c];
      p.s5_bmt[((size_t)ldg * 128 + pp) * 16 + c] = (h16)(cr * br_ - ci * bi_);
      p.s5_bmt[((size_t)ldg * 128 + 64 + pp) * 16 + c] = (h16)(cr * bi_ + ci * br_);
      p.s5_cmt[((size_t)ldg * 16 + c) * 128 + pp] = (h16)p.s5_c_re[((size_t)ldg * 16 + c) * 64 + pp];
      p.s5_cmt[((size_t)ldg * 16 + c) * 128 + 64 + pp] = (h16)(-p.s5_c_im[((size_t)ldg * 16 + c) * 64 + pp]);
    }
  }
  for (size_t i = gtid; i < 64 * 16; i += gsz) {
    int pos = i >> 4, k = i & 15;
    float inv = powf(10000.f, -(float)k / 16.f), sn, cs;
    sincosf((float)pos * inv, &sn, &cs);
    p.cs16[i * 2] = cs;
    p.cs16[i * 2 + 1] = sn;
  }
  for (size_t i = gtid; i < 64 * 8; i += gsz) {
    int pos = i >> 3, k = i & 7;
    float inv = powf(10000.f, -(float)k / 8.f), sn, cs;
    sincosf((float)pos * inv, &sn, &cs);
    p.cs8[i * 2] = cs;
    p.cs8[i * 2 + 1] = sn;
  }
  for (int it = blockIdx.x; it < 384; it += gridDim.x) {
    float* sc = (float*)smem;
    float* red = sc + 5 * 1024;
    const int layer = it / 192, col0 = (it % 192) * 16;
    for (int i = tid; i < 5120; i += 256) {
      int c = i >> 10, k = i & 1023;
      float v = (c == 0) ? p.c_ctx[k] : p.c[(c - 1) * 1024 + k];
      sc[i] = siluf_(v);
    }
    __syncthreads();
    const int cl = tid & 15, kg = tid >> 4;
    float a0 = 0, a1 = 0, a2 = 0, a3 = 0, a4 = 0;
    const float* w = p.w_mod + (size_t)layer * 1024 * 3072 + col0 + cl;
#pragma unroll 8
    for (int kk = 0; kk < 64; kk++) {
      int k = kg * 64 + kk;
      float wv = w[(size_t)k * 3072];
      a0 += sc[k] * wv;
      a1 += sc[1024 + k] * wv;
      a2 += sc[2048 + k] * wv;
      a3 += sc[3072 + k] * wv;
      a4 += sc[4096 + k] * wv;
    }
    red[(kg * 5 + 0) * 16 + cl] = a0;
    red[(kg * 5 + 1) * 16 + cl] = a1;
    red[(kg * 5 + 2) * 16 + cl] = a2;
    red[(kg * 5 + 3) * 16 + cl] = a3;
    red[(kg * 5 + 4) * 16 + cl] = a4;
    __syncthreads();
    if (tid < 80) {
      int c = tid >> 4, cc = tid & 15;
      float s = 0;
      for (int q = 0; q < 16; q++) s += red[(q * 5 + c) * 16 + cc];
      p.modv[(layer * 5 + c) * 3072 + col0 + cc] = s + p.b_mod[layer * 3072 + col0 + cc];
    }
    __syncthreads();
  }
  for (int it = blockIdx.x; it < 4992; it += gridDim.x) {
    const float* src; h16* dst; int lds_, ldd, N, NT, tile;
    if (it < 4608) {
      int l = it / 2304, r = it % 2304;
      if (r < 768) { src = p.w_in + (size_t)l * 1024 * 2976; lds_ = 2976; dst = p.wt_in + (size_t)l * 3072 * 1024; ldd = 1024; N = 2976; NT = 48; tile = r; }
      else if (r < 1792) { src = p.w_merge + (size_t)l * 1024 * 4096; lds_ = 4096; dst = p.wt_merge + (size_t)l * 4096 * 1024; ldd = 1024; N = 4096; NT = 64; tile = r - 768; }
      else if (r < 2048) { int k = (r - 1792) >> 6; src = p.w_branch + (size_t)(l * 4 + k) * 256 * 1024; lds_ = 1024; dst = p.wt_branch + (size_t)(l * 4 + k) * 1024 * 256; ldd = 256; N = 1024; NT = 16; tile = (r - 1792) & 63; }
      else { src = p.w_out + (size_t)l * 1048576; lds_ = 1024; dst = p.wt_out + (size_t)l * 1048576; ldd = 1024; N = 1024; NT = 16; tile = r - 2048; }
    } else {
      int r = it - 4608;
      if (r < 128) { int m = r >> 4; src = p.cache_a_v + (size_t)m * 512 * 128; lds_ = 128; dst = p.cvt_a + (size_t)m * 128 * 512; ldd = 512; N = 128; NT = 2; tile = r & 15; }
      else { r -= 128; int m = r >> 5; src = p.cache_na_v + (size_t)m * 512 * 256; lds_ = 256; dst = p.cvt_n + (size_t)m * 256 * 512; ldd = 512; N = 256; NT = 4; tile = r & 31; }
    }
    tr_tile(src, lds_, dst, ldd, (tile / NT) * 64, (tile % NT) * 64, N, smem);
  }
}

__device__ void phase_norm(const Params p, int layer) {
  const int lane = threadIdx.x & 63, wid = threadIdx.x >> 6;
  const float* g = p.norm_g + layer * 1024;
  for (int row = blockIdx.x * 4 + wid; row < T_ALL; row += gridDim.x * 4) {
    const float* x = xptr(p, layer, row);
    const float* mod = p.modv + (layer * 5 + cond_of(row)) * 3072;
    float4 v[4];
    float ss = 0;
#pragma unroll
    for (int i = 0; i < 4; i++) {
      v[i] = *(const float4*)(x + i * 256 + lane * 4);
      ss += v[i].x * v[i].x + v[i].y * v[i].y + v[i].z * v[i].z + v[i].w * v[i].w;
    }
    ss = wave_sum(ss);
    float rstd = rsqrtf(ss * (1.f / 1024.f) + 1e-6f);
#pragma unroll
    for (int i = 0; i < 4; i++) {
      int k = i * 256 + lane * 4;
      float4 gg = *(const float4*)(g + k), sh = *(const float4*)(mod + k), sc = *(const float4*)(mod + 1024 + k);
      store_h4(p.hbuf + (size_t)row * 1024 + k, v[i].x * rstd * gg.x * (1.f + sc.x) + sh.x,
               v[i].y * rstd * gg.y * (1.f + sc.y) + sh.y, v[i].z * rstd * gg.z * (1.f + sc.z) + sh.z,
               v[i].w * rstd * gg.w * (1.f + sc.w) + sh.w);
    }
  }
}

__device__ void phase_final(const Params p) {
  const int lane = threadIdx.x & 63, wid = threadIdx.x >> 6;
  const float* g = p.final_norm_g;
  for (int row = blockIdx.x * 4 + wid; row < T_ALL; row += gridDim.x * 4) {
    float* x = p.out + (size_t)row * 1024;
    float4 v[4];
    float ss = 0;
#pragma unroll
    for (int i = 0; i < 4; i++) {
      v[i] = *(const float4*)(x + i * 256 + lane * 4);
      ss += v[i].x * v[i].x + v[i].y * v[i].y + v[i].z * v[i].z + v[i].w * v[i].w;
    }
    ss = wave_sum(ss);
    float rstd = rsqrtf(ss * (1.f / 1024.f) + 1e-6f);
#pragma unroll
    for (int i = 0; i < 4; i++) {
      int k = i * 256 + lane * 4;
      float4 gg = *(const float4*)(g + k);
      *(float4*)(x + k) = make_float4(v[i].x * rstd * gg.x, v[i].y * rstd * gg.y, v[i].z * rstd * gg.z, v[i].w * rstd * gg.w);
    }
  }
}

__device__ void phase_g1(const Params p, int layer, char* smem) {
  const int lane = threadIdx.x & 63, wid = threadIdx.x >> 6, wr = wid >> 1, wc = wid & 1, l15 = lane & 15, g = lane >> 4;
  const h16* Wt = p.wt_in + (size_t)layer * 3072 * 1024;
  for (int tile = blockIdx.x; tile < 128 * 24; tile += gridDim.x) {
    const int rt = tile / 24, ct = tile % 24;
    const int r0 = rt * 128, n0 = ct * 128;
    f32x4 acc[4][4];
    zero_acc(acc);
    gemm_acc<128, 128>(acc, p.hbuf + (size_t)r0 * 1024, 1024, Wt + (size_t)n0 * 1024, 1024, 1024, smem);
    const bool ctx = r0 < T_CTX;
#pragma unroll
    for (int ni = 0; ni < 4; ni++) {
      const int col = n0 + wc * 64 + ni * 16 + 4 * g;
      if (col >= ZLD) continue;
      const int fb = n0 + wc * 64 + ni * 16;
#pragma unroll
      for (int mi = 0; mi < 4; mi++) {
        const int tok = r0 + wr * 64 + mi * 16 + l15;
        f32x4 v = acc[mi][ni];
        store_h4(p.zbuf + (size_t)tok * ZLD + col, v[0], v[1], v[2], v[3]);
        int b, l, Ls;
        if (ctx) { b = tok >> 8; l = tok & 255; Ls = 256; } else { b = (tok - T_CTX) >> 11; l = (tok - T_CTX) & 2047; Ls = 2048; }
        if (fb >= 384 && fb < 512) {
          h16* vt = p.vt_a_ctx + (ctx ? 0 : 1048576);
          int cc = col - 384;
#pragma unroll
          for (int j = 0; j < 4; j++) vt[((size_t)(b * 2 + ((cc + j) >> 6)) * 64 + ((cc + j) & 63)) * Ls + l] = (h16)v[j];
        } else if (fb >= 2464 && fb < 2720) {
          h16* vt = p.vt_d_ctx + (ctx ? 0 : 2097152);
          int cc = col - 2464;
#pragma unroll
          for (int j = 0; j < 4; j++) vt[((size_t)(b * 4 + ((cc + j) >> 6)) * 64 + ((cc + j) & 63)) * Ls + l] = (h16)v[j];
        }
        if (ctx) {
          const size_t rowi = (size_t)(b * 2 + layer) * 256 + l;
          float4 fv = make_float4(v[0], v[1], v[2], v[3]);
          if (fb >= 256 && fb < 384) *(float4*)(p.out + O_AK + rowi * 128 + (col - 256)) = fv;
          else if (fb >= 384 && fb < 512) *(float4*)(p.out + O_AV + rowi * 128 + (col - 384)) = fv;
          else if (fb >= 1152 && fb < 1184) *(float4*)(p.out + O_KPE + rowi * 32 + (col - 1152)) = fv;
          else if (fb >= 2208 && fb < 2464) *(float4*)(p.out + O_NK + rowi * 256 + (col - 2208)) = fv;
          else if (fb >= 2464 && fb < 2720) *(float4*)(p.out + O_NV + rowi * 256 + (col - 2464)) = fv;
        }
      }
    }
  }
}

#define BUS 136
__device__ void s5_item(const Params p, int layer, int mode, int b, int g, int chunk, char* smem) {
  const int tid = threadIdx.x, lane = tid & 63, wid = tid >> 6, l15 = lane & 15, gq = lane >> 4;
  h16* su = (h16*)smem;
  h16* sy = su + 256 * 16;
  h16* sbu = sy + 2 * 256 * 16;
  const int tok0 = (mode == 0) ? b * 256 : T_CTX + b * 2048 + chunk * 256;
  for (int i = tid; i < 512; i += 256) {
    int t = i >> 1, hf = i & 1;
    *(u32x4*)(su + t * 16 + hf * 8) = *(const u32x4*)(p.zbuf + (size_t)(tok0 + t) * ZLD + 1440 + g * 16 + hf * 8);
  }
  __syncthreads();
  if (wid < 2) {
    const int dir = wid;
    const int ldg = (layer * 2 + dir) * 16 + g;
    const float ar = p.s5_abar[(ldg * 64 + lane) * 2], ai = p.s5_abar[(ldg * 64 + lane) * 2 + 1];
    const float dt = p.s5_dt[ldg];
    float hr = 0.f, hi = 0.f;
    if (mode == 2) {
      const size_t sidx = ((((size_t)b * 2 + layer) * 2 + dir) * 16 + g) * 64 + lane;
      hr = p.state_re[sidx];
      hi = p.state_im[sidx];
      float lr = p.s5_lamdt[(ldg * 64 + lane) * 2] * 256.f, li = p.s5_lamdt[(ldg * 64 + lane) * 2 + 1] * 256.f;
      float er = expf(lr), sn, cs;
      sincosf(li, &sn, &cs);
      const float pr = er * cs, pi = er * sn;
      const float* e = p.s5_e + ((((size_t)b * 16 + g) * 2 + dir) * 8) * 128;
      if (dir == 0) {
        for (int c2 = 0; c2 < chunk; c2++) {
          float er_ = e[c2 * 128 + lane * 2], ei_ = e[c2 * 128 + lane * 2 + 1];
          float nr = pr * hr - pi * hi + er_, ni = pr * hi + pi * hr + ei_;
          hr = nr; hi = ni;
        }
      } else {
        for (int c2 = 7; c2 > chunk; c2--) {
          float er_ = e[c2 * 128 + lane * 2], ei_ = e[c2 * 128 + lane * 2 + 1];
          float nr = pr * hr - pi * hi + er_, ni = pr * hi + pi * hr + ei_;
          hr = nr; hi = ni;
        }
      }
    }
    h16x4 bfr[8];
    const h16* bmt = p.s5_bmt + (size_t)ldg * 128 * 16;
#pragma unroll
    for (int nf = 0; nf < 8; nf++) bfr[nf] = *(const h16x4*)(bmt + (nf * 16 + l15) * 16 + 4 * gq);
    h16x8 cfr[4];
    const h16* cmt = p.s5_cmt + (size_t)ldg * 16 * 128;
#pragma unroll
    for (int ks = 0; ks < 4; ks++) cfr[ks] = *(const h16x8*)(cmt + l15 * 128 + ks * 32 + 8 * gq);
    h16* bu = sbu + dir * 16 * BUS;
    h16* ydir = sy + dir * 256 * 16;
    for (int sub = 0; sub < 16; sub++) {
      const int sc = dir == 0 ? sub : 15 - sub;
      const int tt0 = sc * 16;
      h16x4 ua = *(const h16x4*)(su + (tt0 + l15) * 16 + 4 * gq);
#pragma unroll
      for (int nf = 0; nf < 8; nf++) {
        f32x4 r = __builtin_amdgcn_mfma_f32_16x16x16f16(bfr[nf], ua, f32x4{0.f, 0.f, 0.f, 0.f}, 0, 0, 0);
        store_h4(bu + l15 * BUS + nf * 16 + 4 * gq, r[0], r[1], r[2], r[3]);
      }
      __builtin_amdgcn_wave_barrier();
#pragma unroll 4
      for (int s = 0; s < 16; s++) {
        const int t = dir == 0 ? s : 15 - s;
        float bur = (float)bu[t * BUS + lane], bui = (float)bu[t * BUS + 64 + lane];
        float nr = ar * hr - ai * hi + dt * bur, ni = ar * hi + ai * hr + dt * bui;
        hr = nr; hi = ni;
        bu[t * BUS + lane] = (h16)hr;
        bu[t * BUS + 64 + lane] = (h16)hi;
      }
      __builtin_amdgcn_wave_barrier();
      if (mode != 1) {
        f32x4 y = {0.f, 0.f, 0.f, 0.f};
#pragma unroll
        for (int ks = 0; ks < 4; ks++) {
          h16x8 ha = *(const h16x8*)(bu + l15 * BUS + ks * 32 + 8 * gq);
          y = __builtin_amdgcn_mfma_f32_16x16x32_f16(cfr[ks], ha, y, 0, 0, 0);
        }
        store_h4(ydir + (tt0 + l15) * 16 + 4 * gq, y[0], y[1], y[2], y[3]);
      }
      __builtin_amdgcn_wave_barrier();
    }
    if (mode == 0) {
      const size_t oi = ((((size_t)b * 2 + layer) * 2 + dir) * 16 + g) * 64 + lane;
      p.out[O_SRE + oi] = hr;
      p.out[O_SIM + oi] = hi;
    } else if (mode == 1) {
      float* e = p.s5_e + (((((size_t)b * 16 + g) * 2 + dir) * 8) + chunk) * 128;
      e[lane * 2] = hr;
      e[lane * 2 + 1] = hi;
    }
  }
  __syncthreads();
  if (mode != 1) {
    for (int i = tid; i < 256 * 16; i += 256) {
      int t = i >> 4, c = i & 15;
      float u = (float)su[i];
      float v = (float)sy[i] + (float)sy[256 * 16 + i] + p.s5_d[layer * 256 + g * 16 + c] * u;
      p.zbuf[(size_t)(tok0 + t) * ZLD + 1440 + g * 16 + c] = (h16)geluf_(v);
    }
  }
  __syncthreads();
}


template <int NCOL>
__device__ __forceinline__ void row_rstd(const h16* __restrict__ base, float* rs) {
  const int tid = threadIdx.x, row = tid >> 1, hf = tid & 1;
  const h16* ptr = base + (size_t)row * ZLD + hf * (NCOL / 2);
  float s = 0.f;
#pragma unroll 2
  for (int i = 0; i < NCOL / 16; i++) {
    h16x8 v = *(const h16x8*)(ptr + i * 8);
#pragma unroll
    for (int j = 0; j < 8; j++) s += (float)v[j] * (float)v[j];
  }
  s += __shfl_xor(s, 1);
  if (hf == 0) rs[row] = rsqrtf(s * (1.f / NCOL) + 1e-6f);
}

__device__ void phase_g2(const Params p, int layer, char* smem) {
  const int tid = threadIdx.x, lane = tid & 63, wid = tid >> 6, wr = wid >> 1, wc = wid & 1, l15 = lane & 15, g = lane >> 4;
  for (int it = blockIdx.x; it < 1024; it += gridDim.x) {
    int mode, b, gg, ch;
    if (it < 512) { mode = 0; b = it >> 4; gg = it & 15; ch = 0; }
    else { int i2 = it - 512; mode = 1; b = i2 >> 7; gg = (i2 >> 3) & 15; ch = i2 & 7; }
    s5_item(p, layer, mode, b, gg, ch, smem);
  }
  for (int it = blockIdx.x; it < 768; it += gridDim.x) {
    {
      const int rt = it / 6, ct = it % 6, r0 = rt * 128, n0 = ct * 64;
      float* rs = (float*)(smem + 49152);
      row_rstd<256>(p.zbuf + (size_t)r0 * ZLD + 768, rs);
      f32x4 acc[4][2];
      zero_acc(acc);
      gemm_acc<128, 64>(acc, p.zbuf + (size_t)r0 * ZLD + 768, ZLD, p.wt_qup + (size_t)layer * 384 * 256 + (size_t)n0 * 256, 256, 256, smem);
      __syncthreads();
      const bool lat = r0 >= T_CTX;
#pragma unroll
      for (int mi = 0; mi < 4; mi++) {
        const int row = wr * 64 + mi * 16 + l15, tok = r0 + row;
        const float rstd = rs[row];
#pragma unroll
        for (int ni = 0; ni < 2; ni++) {
          const int fb = n0 + wc * 32 + ni * 16;
          f32x4 v = acc[mi][ni] * rstd;
          store_h4(p.qm + (size_t)tok * 384 + fb + 4 * g, v[0], v[1], v[2], v[3]);
        }
      }
      __syncthreads();
      if (lat && ct != 0 && ct != 3) {
        const int rc0 = n0 + ((ct == 2 || ct == 5) ? 32 : 0);
        for (int i = tid; i < 128 * 16; i += 256) {
          const int row = i >> 4, e = i & 15, tok = r0 + row;
          const int i8 = e & 7, base = (e < 8) ? 0 : 16;
          const int lpos = (tok - T_CTX) & 2047;
          const int pos = (e < 8) ? (lpos >> 6) : (lpos & 63);
          h16* ptr = p.qm + (size_t)tok * 384 + rc0 + base + i8;
          const float x1 = (float)ptr[0], x2 = (float)ptr[8];
          const float cs = p.cs8[(pos * 8 + i8) * 2], sn = p.cs8[(pos * 8 + i8) * 2 + 1];
          ptr[0] = (h16)(x1 * cs - x2 * sn);
          ptr[8] = (h16)(x1 * sn + x2 * cs);
        }
      }
      __syncthreads();
    }
  }
  for (int it = blockIdx.x; it < 1024 + 128; it += gridDim.x) {
    const int N_KV = 1024;
    {
      const bool cached = it >= N_KV;
      int rt, ct;
      const h16 *A, *Bt;
      int lda;
      if (!cached) { rt = it >> 3; ct = it & 7; A = p.zbuf + (size_t)(rt * 128) * ZLD + 1024; lda = ZLD; Bt = p.wt_kvup + (size_t)layer * 512 * 128; }
      else { int i2 = it - N_KV; rt = i2 >> 3; ct = i2 & 7; int b = rt >> 2, k0 = (rt & 3) * 128; A = p.ckv_c + ((size_t)(b * 2 + layer) * 512 + k0) * 128; lda = 128; Bt = p.wt_kvraw + (size_t)layer * 512 * 128; }
      const int r0 = rt * 128, n0 = ct * 64;
      float* rs = (float*)(smem + 49152);
      if (!cached) {
        row_rstd<128>(p.zbuf + (size_t)r0 * ZLD + 1024, rs);
      } else {
        if (tid < 128) rs[tid] = 1.f;
      }
      f32x4 acc[4][2];
      zero_acc(acc);
      gemm_acc<128, 64>(acc, A, lda, Bt + (size_t)n0 * 128, 128, 128, smem);
      const int head = n0 >> 7;
      const bool vtype = (n0 & 64) != 0;
#pragma unroll
      for (int mi = 0; mi < 4; mi++) {
        const int row = wr * 64 + mi * 16 + l15, tok = r0 + row;
        const float rstd = rs[row];
#pragma unroll
        for (int ni = 0; ni < 2; ni++) {
          const int d0 = wc * 32 + ni * 16 + 4 * g;
          f32x4 v = acc[mi][ni] * rstd;
          if (!vtype) {
            h16* dst = p.kmla + (cached ? (size_t)T_ALL * 384 : (size_t)0);
            store_h4(dst + (size_t)tok * 384 + head * 96 + d0, v[0], v[1], v[2], v[3]);
          } else {
            h16* vt; int bb, l, Ls;
            int voff;
            if (cached) { voff = 4194304; bb = tok >> 9; l = tok & 511; Ls = 512; }
            else if (tok < T_CTX) { voff = 0; bb = tok >> 8; l = tok & 255; Ls = 256; }
            else { voff = 2097152; bb = (tok - T_CTX) >> 11; l = (tok - T_CTX) & 2047; Ls = 2048; }
            vt = p.vt_m_ctx + voff;
#pragma unroll
            for (int j = 0; j < 4; j++) vt[((size_t)(bb * 4 + head) * 64 + d0 + j) * Ls + l] = (h16)v[j];
          }
        }
      }
      if (ct == 0 && !cached && r0 < T_CTX) {
        const float* gk = p.mla_kv_norm + layer * 128;
        for (int i = tid; i < 128 * 128; i += 256) {
          int row = i >> 7, k = i & 127, tok = r0 + row;
          float v = (float)p.zbuf[(size_t)tok * ZLD + 1024 + k] * rs[row] * gk[k];
          p.out[O_CKV + ((size_t)((tok >> 8) * 2 + layer) * 256 + (tok & 255)) * 128 + k] = v;
        }
      }
      if (ct == 1) {
        for (int i = tid; i < 128 * 16; i += 256) {
          int row = i >> 4, e = i & 15, tok = r0 + row;
          float x1, x2;
          h16* dst;
          if (cached) {
            int bb = tok >> 9, key = tok & 511;
            const float* src = p.cache_mla_kpe + ((size_t)(bb * 2 + layer) * 512 + key) * 32;
            x1 = src[e]; x2 = src[16 + e];
            dst = p.kmla + (size_t)T_ALL * 384 + (size_t)tok * 384;
            for (int h = 0; h < 4; h++) { dst[h * 96 + 64 + e] = (h16)x1; dst[h * 96 + 80 + e] = (h16)x2; }
          } else {
            const h16* src = p.zbuf + (size_t)tok * ZLD + 1152;
            int i8 = e & 7, base = (e < 8) ? 0 : 16;
            x1 = (float)src[base + i8]; x2 = (float)src[base + 8 + i8];
            float o1 = x1, o2 = x2;
            if (tok >= T_CTX) {
              int lpos = (tok - T_CTX) & 2047;
              int pos = (e < 8) ? (lpos >> 6) : (lpos & 63);
              float cs = p.cs8[(pos * 8 + i8) * 2], sn = p.cs8[(pos * 8 + i8) * 2 + 1];
              o1 = x1 * cs - x2 * sn; o2 = x1 * sn + x2 * cs;
            }
            dst = p.kmla + (size_t)tok * 384;
            for (int h = 0; h < 4; h++) { dst[h * 96 + 64 + base + i8] = (h16)o1; dst[h * 96 + 64 + base + 8 + i8] = (h16)o2; }
          }
        }
      }
      __syncthreads();
    }
  }
  for (int it = blockIdx.x; it < 128; it += gridDim.x) {
    {
      const int t0 = T_CTX + it * 64;
      for (int i = tid; i < 64 * 192; i += 256) {
        int tl = i / 192, pr = i % 192;
        int tok = t0 + tl, lpos = (tok - T_CTX) & 2047;
        int head = pr >> 5, w = pr & 31;
        int i16 = w & 15, base = (w < 16) ? 0 : 32;
        int pos = (w < 16) ? (lpos >> 6) : (lpos & 63);
        h16* ptr = p.zbuf + (size_t)tok * ZLD + head * 64 + base + i16;
        float x1 = (float)ptr[0], x2 = (float)ptr[16];
        float cs = p.cs16[(pos * 16 + i16) * 2], sn = p.cs16[(pos * 16 + i16) * 2 + 1];
        ptr[0] = (h16)(x1 * cs - x2 * sn);
        ptr[16] = (h16)(x1 * sn + x2 * cs);
      }
    }
  }
}

struct Seg { const h16* K; const h16* Vt; int ldk, ldv, ntiles; };

template <int DQK, int MODE>
__device__ void attn_item(const h16* __restrict__ Q, int ldq, Seg s0, Seg s1, float scale_l2, bool has_sink, float sink_l2,
                          int qpos0, int kpos0, const float* __restrict__ rpb_h, int qrow, int krow0,
                          h16* __restrict__ outp, const h16* __restrict__ gate, char* smem) {
  constexpr int KCH = DQK / 8;
  constexpr int KROWB = DQK * 2;
  constexpr int KPT = 64 * KCH / 256;
  constexpr int KBYTES = 64 * KROWB;
  constexpr int STAGE = KBYTES + 8192;
  constexpr int NKS = DQK / 32;
  const int tid = threadIdx.x, lane = tid & 63, wid = tid >> 6, l15 = lane & 15, g = lane >> 4;
  h16x8 qf[NKS];
#pragma unroll
  for (int ks = 0; ks < NKS; ks++) qf[ks] = *(const h16x8*)(Q + (size_t)(wid * 16 + l15) * ldq + ks * 32 + 8 * g);
  float m = has_sink ? sink_l2 : -1e30f;
  float lsum = (has_sink && g == 0) ? 1.f : 0.f;
  f32x4 o[4];
#pragma unroll
  for (int i = 0; i < 4; i++) o[i] = f32x4{0.f, 0.f, 0.f, 0.f};
  const int ntot = s0.ntiles + s1.ntiles;
  u32x4 rk[KPT], rv[2];
#define TILE_PTRS(ti_) \
    const h16 *kp, *vp; int ldk, ldv; \
    if ((ti_) < s0.ntiles) { kp = s0.K + (size_t)(ti_) * 64 * s0.ldk; vp = s0.Vt + (ti_) * 64; ldk = s0.ldk; ldv = s0.ldv; } \
    else { int t2 = (ti_) - s0.ntiles; kp = s1.K + (size_t)t2 * 64 * s1.ldk; vp = s1.Vt + t2 * 64; ldk = s1.ldk; ldv = s1.ldv; }
  {
    TILE_PTRS(0)
#pragma unroll
    for (int i = 0; i < KPT; i++) { int c = tid + i * 256; int row = c / KCH, sl = c % KCH; rk[i] = *(const u32x4*)(kp + (size_t)row * ldk + sl * 8); }
#pragma unroll
    for (int i = 0; i < 2; i++) { int c = tid + i * 256; int row = c >> 3, sl = c & 7; rv[i] = *(const u32x4*)(vp + (size_t)row * ldv + sl * 8); }
    char* sk = smem; char* sv = smem + KBYTES;
#pragma unroll
    for (int i = 0; i < KPT; i++) { int c = tid + i * 256; int row = c / KCH, sl = c % KCH; int off = (DQK == 64) ? SWZ(row, sl) : (row * KROWB + sl * 16); *(u32x4*)(sk + off) = rk[i]; }
#pragma unroll
    for (int i = 0; i < 2; i++) { int c = tid + i * 256; int row = c >> 3, sl = c & 7; *(u32x4*)(sv + SWZ(row, sl)) = rv[i]; }
  }
  __syncthreads();
  for (int ti = 0; ti < ntot; ti++) {
    const bool more = ti + 1 < ntot;
    if (more) {
      TILE_PTRS(ti + 1)
#pragma unroll
      for (int i = 0; i < KPT; i++) { int c = tid + i * 256; int row = c / KCH, sl = c % KCH; rk[i] = *(const u32x4*)(kp + (size_t)row * ldk + sl * 8); }
#pragma unroll
      for (int i = 0; i < 2; i++) { int c = tid + i * 256; int row = c >> 3, sl = c & 7; rv[i] = *(const u32x4*)(vp + (size_t)row * ldv + sl * 8); }
    }
    const char* sk = smem + (ti & 1) * STAGE;
    const char* sv = sk + KBYTES;
    f32x4 s[4];
#pragma unroll
    for (int kf = 0; kf < 4; kf++) {
      s[kf] = f32x4{0.f, 0.f, 0.f, 0.f};
#pragma unroll
      for (int ks = 0; ks < NKS; ks++) {
        const int row = kf * 16 + l15, sl = ks * 4 + g;
        const int off = (DQK == 64) ? SWZ(row, sl) : (row * KROWB + sl * 16);
        h16x8 ka = *(const h16x8*)(sk + off);
        s[kf] = __builtin_amdgcn_mfma_f32_16x16x32_f16(ka, qf[ks], s[kf], 0, 0, 0);
      }
    }
    const bool masked = (MODE != 0) && (ti < s0.ntiles);
    float mx = -INFINITY;
#pragma unroll
    for (int kf = 0; kf < 4; kf++)
#pragma unroll
      for (int j = 0; j < 4; j++) {
        float x = s[kf][j] * scale_l2;
        if (MODE == 1 && masked) {
          int kpos = kpos0 + ti * 64 + kf * 16 + 4 * g + j, qpos = qpos0 + wid * 16 + l15;
          int d = qpos - kpos;
          if (d > 128 || d < -128) x = -INFINITY;
        }
        if (MODE == 2 && masked) {
          int ck = kf * 16 + 4 * g + j, cq = wid * 16 + l15;
          int cs = min(max(cq - 8, 0), 48);
          int rel = ck - cs;
          if (rel < 0 || rel >= 16) x = -INFINITY;
          else {
            int co = min(max(ck - cq, -15), 15) + 15;
            int ro = (krow0 + ti) - qrow + 7;
            x += rpb_h[ro * 31 + co] * LOG2E;
          }
        }
        s[kf][j] = x;
        mx = fmaxf(mx, x);
      }
    mx = fmaxf(mx, __shfl_xor(mx, 16));
    mx = fmaxf(mx, __shfl_xor(mx, 32));
    const float mnew = fmaxf(m, mx);
    const float alpha = exp2f(m - mnew);
    m = mnew;
    float ps = 0.f;
    h16x8 pb[2];
#pragma unroll
    for (int kf = 0; kf < 4; kf++)
#pragma unroll
      for (int j = 0; j < 4; j++) {
        float pv = exp2f(s[kf][j] - mnew);
        ps += pv;
        pb[kf >> 1][(kf & 1) * 4 + j] = (h16)pv;
      }
    lsum = lsum * alpha + ps;
#pragma unroll
    for (int df = 0; df < 4; df++) {
      o[df] = o[df] * alpha;
#pragma unroll
      for (int kk = 0; kk < 2; kk++) {
        const int row = df * 16 + l15;
        const int c0 = 8 * kk + g, c1 = 8 * kk + 4 + g;
        h16x4 v0 = *(const h16x4*)(sv + SWZ(row, c0 >> 1) + (c0 & 1) * 8);
        h16x4 v1 = *(const h16x4*)(sv + SWZ(row, c1 >> 1) + (c1 & 1) * 8);
        h16x8 va = {v0[0], v0[1], v0[2], v0[3], v1[0], v1[1], v1[2], v1[3]};
        o[df] = __builtin_amdgcn_mfma_f32_16x16x32_f16(va, pb[kk], o[df], 0, 0, 0);
      }
    }
    if (more) {
      char* wk = smem + ((ti + 1) & 1) * STAGE; char* wv = wk + KBYTES;
#pragma unroll
      for (int i = 0; i < KPT; i++) { int c = tid + i * 256; int row = c / KCH, sl = c % KCH; int off = (DQK == 64) ? SWZ(row, sl) : (row * KROWB + sl * 16); *(u32x4*)(wk + off) = rk[i]; }
#pragma unroll
      for (int i = 0; i < 2; i++) { int c = tid + i * 256; int row = c >> 3, sl = c & 7; *(u32x4*)(wv + SWZ(row, sl)) = rv[i]; }
    }
    __syncthreads();
  }
  lsum += __shfl_xor(lsum, 16);
  lsum += __shfl_xor(lsum, 32);
  const float inv = 1.f / lsum;
  const int qr = wid * 16 + l15;
#pragma unroll
  for (int df = 0; df < 4; df++) {
    const int d = df * 16 + 4 * g;
    h16x4 gv = *(const h16x4*)(gate + (size_t)qr * ZLD + d);
    store_h4(outp + (size_t)qr * 1024 + d, o[df][0] * inv * siluf_((float)gv[0]), o[df][1] * inv * siluf_((float)gv[1]),
             o[df][2] * inv * siluf_((float)gv[2]), o[df][3] * inv * siluf_((float)gv[3]));
  }
}

__device__ void phase_att(const Params p, int layer, char* smem) {
  const float sc64 = 0.125f * LOG2E, sc96 = 0.10206207261596575f * LOG2E;
  Seg s0, s1;
  for (int idx = blockIdx.x; idx < 512; idx += gridDim.x) s5_item(p, layer, 2, idx >> 7, (idx >> 3) & 15, idx & 7, smem);
  for (int it = blockIdx.x; it < 1024; it += gridDim.x) {
    const bool lat = it < 512;
    const int idx = it & 511;
    int b, h, tokb, tok0;
    if (lat) { b = idx >> 7; h = (idx >> 5) & 3; tokb = T_CTX + b * 2048; tok0 = tokb + (idx & 31) * 64; }
    else { b = idx >> 4; h = (idx >> 2) & 3; tokb = b * 256; tok0 = tokb + (idx & 3) * 64; }
    s0.K = p.kmla + (size_t)tokb * 384 + h * 96; s0.ldk = 384;
    if (lat) {
      s0.Vt = p.vt_m_lat + (size_t)(b * 4 + h) * 64 * 2048; s0.ldv = 2048; s0.ntiles = 32;
      s1.K = p.kcx + (size_t)(b * 512) * 384 + h * 96; s1.ldk = 384; s1.Vt = p.vcx_t + (size_t)(b * 4 + h) * 64 * 512; s1.ldv = 512; s1.ntiles = 8;
    } else {
      s0.Vt = p.vt_m_ctx + (size_t)(b * 4 + h) * 64 * 256; s0.ldv = 256; s0.ntiles = 4;
      s1.K = s0.K; s1.Vt = s0.Vt; s1.ldk = 0; s1.ldv = 0; s1.ntiles = 0;
    }
    attn_item<96, 0>(p.qm + (size_t)tok0 * 384 + h * 96, 384, s0, s1, sc96, false, 0.f, 0, 0, nullptr, 0, 0,
                     p.br + (size_t)tok0 * 1024 + 256 + h * 64, p.zbuf + (size_t)tok0 * ZLD + 1184 + h * 64, smem);
  }
  for (int idx = blockIdx.x; idx < 512; idx += gridDim.x) {
    const int b = idx >> 7, h = (idx >> 5) & 3, qt = idx & 31;
    const int tokb = T_CTX + b * 2048, tok0 = tokb + qt * 64;
    const int r = qt, rs = min(max(r - 4, 0), 24);
    s0.K = p.zbuf + (size_t)(tokb + rs * 64) * ZLD + 2208 + h * 64; s0.ldk = ZLD; s0.Vt = p.vt_d_lat + (size_t)(b * 4 + h) * 64 * 2048 + rs * 64; s0.ldv = 2048; s0.ntiles = 8;
    s1.K = p.ck_n + (size_t)((b * 2 + layer) * 512) * 256 + h * 64; s1.ldk = 256; s1.Vt = p.cvt_n + (size_t)((b * 2 + layer) * 4 + h) * 64 * 512; s1.ldv = 512; s1.ntiles = 8;
    attn_item<64, 2>(p.zbuf + (size_t)tok0 * ZLD + 1952 + h * 64, ZLD, s0, s1, sc64, false, 0.f, 0, 0,
                     p.na_rpb + (size_t)(layer * 4 + h) * 15 * 31, r, rs,
                     p.br + (size_t)tok0 * 1024 + 768 + h * 64, p.zbuf + (size_t)tok0 * ZLD + 2720 + h * 64, smem);
  }
  for (int idx = blockIdx.x; idx < 512; idx += gridDim.x) {
    const int b = idx >> 7, h = (idx >> 5) & 3, qt = idx & 31;
    const int tokb = T_CTX + b * 2048, tok0 = tokb + qt * 64;
    const int hk = h >> 1, q0 = qt * 64;
    const int ks = max(0, q0 - 128), ke = min(2048, q0 + 192);
    s0.K = p.zbuf + (size_t)(tokb + ks) * ZLD + 256 + hk * 64; s0.ldk = ZLD; s0.Vt = p.vt_a_lat + (size_t)(b * 2 + hk) * 64 * 2048 + ks; s0.ldv = 2048; s0.ntiles = (ke - ks) >> 6;
    s1.K = p.ck_a + (size_t)((b * 2 + layer) * 512) * 128 + hk * 64; s1.ldk = 128; s1.Vt = p.cvt_a + (size_t)((b * 2 + layer) * 2 + hk) * 64 * 512; s1.ldv = 512; s1.ntiles = 8;
    attn_item<64, 1>(p.zbuf + (size_t)tok0 * ZLD + h * 64, ZLD, s0, s1, sc64, true, p.a_sink[layer * 4 + h] * LOG2E, q0, ks, nullptr, 0, 0,
                     p.br + (size_t)tok0 * 1024 + h * 64, p.zbuf + (size_t)tok0 * ZLD + 512 + h * 64, smem);
  }
  for (int it = blockIdx.x; it < 1024; it += gridDim.x) {
    const bool isA = it < 512;
    const int idx = it & 511;
    const int b = idx >> 4, h = (idx >> 2) & 3, qt = idx & 3;
    const int tokb = b * 256, tok0 = tokb + qt * 64;
    int qcol, kcol, gcol, bcol;
    if (isA) { const int hk = h >> 1; qcol = h * 64; kcol = 256 + hk * 64; gcol = 512 + h * 64; bcol = h * 64; s0.Vt = p.vt_a_ctx + (size_t)(b * 2 + hk) * 64 * 256; }
    else { qcol = 1952 + h * 64; kcol = 2208 + h * 64; gcol = 2720 + h * 64; bcol = 768 + h * 64; s0.Vt = p.vt_d_ctx + (size_t)(b * 4 + h) * 64 * 256; }
    s0.K = p.zbuf + (size_t)tokb * ZLD + kcol; s0.ldk = ZLD; s0.ldv = 256; s0.ntiles = 4;
    s1.K = s0.K; s1.Vt = s0.Vt; s1.ldk = 0; s1.ldv = 0; s1.ntiles = 0;
    const float sink = isA ? p.a_sink[layer * 4 + h] * LOG2E : 0.f;
    attn_item<64, 0>(p.zbuf + (size_t)tok0 * ZLD + qcol, ZLD, s0, s1, sc64, isA, sink, 0, 0, nullptr, 0, 0,
                     p.br + (size_t)tok0 * 1024 + bcol, p.zbuf + (size_t)tok0 * ZLD + gcol, smem);
  }
}

__device__ void phase_glu(const Params p, int layer, char* smem) {
  const int lane = threadIdx.x & 63, wid = threadIdx.x >> 6, wr = wid >> 1, wc = wid & 1, l15 = lane & 15, g = lane >> 4;
  for (int tile = blockIdx.x; tile < 128 * 8; tile += gridDim.x) {
    const int rt = tile >> 3, ct = tile & 7, r0 = rt * 128, n0 = ct * 64;
    f32x4 acc[4][2];
    zero_acc(acc);
    gemm_acc<128, 64>(acc, p.zbuf + (size_t)r0 * ZLD + 1440, ZLD, p.wt_glu + (size_t)layer * 512 * 256 + (size_t)n0 * 256, 256, 256, smem);
#pragma unroll
    for (int mi = 0; mi < 4; mi++) {
      const int tok = r0 + wr * 64 + mi * 16 + l15;
#pragma unroll
      for (int np = 0; np < 1; np++) {
        const int pn = n0 + wc * 32 + np * 32;
        const int col = (pn >> 5) * 16 + 4 * g;
        f32x4 val = acc[mi][np * 2], gt = acc[mi][np * 2 + 1];
        h16x4 cg_ = *(const h16x4*)(p.zbuf + (size_t)tok * ZLD + 1696 + col);
        store_h4(p.br + (size_t)tok * 1024 + 512 + col, val[0] * sigmoidf_(gt[0]) * siluf_((float)cg_[0]),
                 val[1] * sigmoidf_(gt[1]) * siluf_((float)cg_[1]), val[2] * sigmoidf_(gt[2]) * siluf_((float)cg_[2]),
                 val[3] * sigmoidf_(gt[3]) * siluf_((float)cg_[3]));
      }
    }
  }
}

__device__ void phase_g3(const Params p, int layer, char* smem) {
  const int lane = threadIdx.x & 63, wid = threadIdx.x >> 6, wr = wid >> 1, wc = wid & 1, l15 = lane & 15, g = lane >> 4;
  const h16* Wm = p.wt_merge + (size_t)layer * 4096 * 1024;
  const h16* Wb = p.wt_branch + (size_t)layer * 4 * 1024 * 256;
  h16* mbuf = p.zbuf;
  for (int tile = blockIdx.x; tile < 128 * 16; tile += gridDim.x) {
    const int rt = tile >> 4, ct = tile & 15, r0 = rt * 128, d0 = ct * 64;
    f32x4 macc[4][2];
    zero_acc(macc);
    for (int k = 0; k < 4; k++) {
      f32x4 a1[4][2], a2[4][2];
      zero_acc(a1);
      zero_acc(a2);
      gemm_acc<128, 64>(a1, p.hbuf + (size_t)r0 * 1024, 1024, Wm + (size_t)(k * 1024 + d0) * 1024, 1024, 1024, smem);
      gemm_acc<128, 64>(a2, p.br + (size_t)r0 * 1024 + k * 256, 1024, Wb + (size_t)(k * 1024 + d0) * 256, 256, 256, smem);
#pragma unroll
      for (int mi = 0; mi < 4; mi++)
#pragma unroll
        for (int ni = 0; ni < 2; ni++)
#pragma unroll
          for (int j = 0; j < 4; j++) macc[mi][ni][j] += sigmoidf_(a1[mi][ni][j]) * a2[mi][ni][j];
    }
#pragma unroll
    for (int mi = 0; mi < 4; mi++)
#pragma unroll
      for (int ni = 0; ni < 2; ni++) {
        const int tok = r0 + wr * 64 + mi * 16 + l15, col = d0 + wc * 32 + ni * 16 + 4 * g;
        f32x4 v = macc[mi][ni];
        store_h4(mbuf + (size_t)tok * 1024 + col, v[0], v[1], v[2], v[3]);
      }
  }
}

__device__ void phase_g4(const Params p, int layer, char* smem) {
  const int lane = threadIdx.x & 63, wid = threadIdx.x >> 6, wr = wid >> 1, wc = wid & 1, l15 = lane & 15, g = lane >> 4;
  const h16* Wo = p.wt_out + (size_t)layer * 1048576;
  const h16* mbuf = p.zbuf;
  for (int tile = blockIdx.x; tile < 128 * 8; tile += gridDim.x) {
    const int rt = tile >> 3, ct = tile & 7, r0 = rt * 128, n0 = ct * 128;
    f32x4 acc[4][4];
    zero_acc(acc);
    gemm_acc<128, 128>(acc, mbuf + (size_t)r0 * 1024, 1024, Wo + (size_t)n0 * 1024, 1024, 1024, smem);
#pragma unroll
    for (int mi = 0; mi < 4; mi++) {
      const int tok = r0 + wr * 64 + mi * 16 + l15;
      const float* xo = xptr(p, layer, tok);
      const float* gt = p.modv + (layer * 5 + cond_of(tok)) * 3072 + 2048;
#pragma unroll
      for (int ni = 0; ni < 4; ni++) {
        const int col = n0 + wc * 64 + ni * 16 + 4 * g;
        float4 xv = *(const float4*)(xo + col), gv = *(const float4*)(gt + col);
        f32x4 v = acc[mi][ni];
        *(float4*)(p.out + (size_t)tok * 1024 + col) = make_float4(xv.x + gv.x * v[0], xv.y + gv.y * v[1], xv.z + gv.z * v[2], xv.w + gv.w * v[3]);
      }
    }
  }
}


#define XB_TMO      128
#define XB_XCNT(j)  (256  + 64 * (j))
#define XB_XSUB(j)  (1280 + 64 * (j))
#define XB_XGEN(j)  (2304 + 64 * (j))
#define XB_TOP      3328
#define XB_TOPGEN   3392
#define XCD_BAR_WORDS 3456
#define XB_SPIN_CAP (1u << 20)
__device__ __forceinline__ unsigned xb_ld(unsigned* p) { return __hip_atomic_load(p, __ATOMIC_RELAXED, __HIP_MEMORY_SCOPE_AGENT); }
__device__ __forceinline__ unsigned xb_add(unsigned* p, unsigned v) { return __hip_atomic_fetch_add(p, v, __ATOMIC_RELAXED, __HIP_MEMORY_SCOPE_AGENT); }
__device__ __forceinline__ unsigned xb_xcc_id() { return (unsigned)__builtin_amdgcn_s_getreg((3 << 11) | 20) & 0xFu; }
#define XB_SPIN(cond, bar) do { unsigned _sp = 0; while (cond) { __builtin_amdgcn_s_sleep(1); \
    if ((++_sp & 255u) == 0u) { if (xb_ld(&(bar)[XB_TMO])) break; if (_sp > XB_SPIN_CAP) { atomicAdd(&(bar)[XB_TMO], 1u); break; } } } } while (0)
struct XB { unsigned* bar; unsigned x, nloc, nx; };
__device__ __forceinline__ void xb_post(XB& b, unsigned* bar) {
  b.bar = bar; b.x = xb_xcc_id(); b.nloc = 0u; b.nx = 0u;
  if (threadIdx.x == 0) (void)xb_add(&bar[XB_XCNT(b.x)], 1u);
}
__device__ __forceinline__ void xb_complete(unsigned* bar, unsigned x, unsigned& nloc, unsigned& nx) {
  const unsigned G = gridDim.x;
  unsigned sum, cnt, mine, sp = 0u;
  for (;;) {
    sum = 0u; cnt = 0u; mine = 0u;
#pragma unroll
    for (unsigned j = 0; j < 16; ++j) { const unsigned c = xb_ld(&bar[XB_XCNT(j)]); sum += c; cnt += (c > 0u) ? 1u : 0u; mine = (j == x) ? c : mine; }
    if (sum == G) break;
    __builtin_amdgcn_s_sleep(1);
    if ((++sp & 255u) == 0u) { if (xb_ld(&bar[XB_TMO])) break; if (sp > XB_SPIN_CAP) { atomicAdd(&bar[XB_TMO], 1u); break; } }
  }
  nloc = mine > 0u ? mine : 1u; nx = cnt > 0u ? cnt : 1u;
}
__device__ __forceinline__ void xb_sync(XB& b) {
  asm volatile("s_waitcnt vmcnt(0)" ::: "memory");
  __syncthreads();
  if (threadIdx.x == 0) {
    unsigned* bar = b.bar;
    __builtin_amdgcn_s_waitcnt(0);
    if (b.nloc == 0u) xb_complete(bar, b.x, b.nloc, b.nx);
    const unsigned nloc = b.nloc, nx = b.nx;
    const unsigned old = xb_add(&bar[XB_XSUB(b.x)], 1u);
    const unsigned gen = old / nloc;
    if (old + 1u == (gen + 1u) * nloc) {
      __builtin_amdgcn_fence(__ATOMIC_RELEASE, "agent");
      asm volatile("s_waitcnt vmcnt(0)" ::: "memory");
      const unsigned og = xb_add(&bar[XB_TOP], 1u);
      const unsigned tg = og / nx;
      if (og + 1u == (tg + 1u) * nx) xb_add(&bar[XB_TOPGEN], 1u);
      else XB_SPIN(xb_ld(&bar[XB_TOPGEN]) == tg, bar);
      __builtin_amdgcn_fence(__ATOMIC_ACQUIRE, "agent");
      xb_add(&bar[XB_XGEN(b.x)], 1u);
      asm volatile("s_waitcnt vmcnt(0)" ::: "memory");
    } else {
      XB_SPIN(xb_ld(&bar[XB_XGEN(b.x)]) == gen, bar);
      __builtin_amdgcn_fence(__ATOMIC_ACQUIRE, "agent");
      asm volatile("s_waitcnt vmcnt(0)" ::: "memory");
    }
  }
  __syncthreads();
}

#define N_PHASES 16
template <int PH>
__device__ __forceinline__ void run_phase(const Params p, char* smem) {
  if constexpr (PH == 0) phase_prep(p, smem);
  else if constexpr (PH == 15) phase_final(p);
  else {
    constexpr int layer = (PH - 1) / 7, s = (PH - 1) % 7;
    if constexpr (s == 0) phase_norm(p, layer);
    else if constexpr (s == 1) phase_g1(p, layer, smem);
    else if constexpr (s == 2) phase_g2(p, layer, smem);
    else if constexpr (s == 3) phase_att(p, layer, smem);
    else if constexpr (s == 4) phase_glu(p, layer, smem);
    else if constexpr (s == 5) phase_g3(p, layer, smem);
    else phase_g4(p, layer, smem);
  }
}

template <int PH>
__global__ void __launch_bounds__(256, 2) phase_kernel(Params p) {
  __shared__ __attribute__((aligned(16))) char smem[65536];
  run_phase<PH>(p, smem);
}

#ifndef MULTI_LAUNCH
template <int PH>
__device__ __forceinline__ void run_from(const Params p, char* smem, XB& xb) {
  run_phase<PH>(p, smem);
  if constexpr (PH + 1 < N_PHASES) {
    if constexpr (PH == 0) cg::this_grid().sync();
    else xb_sync(xb);
    run_from<PH + 1>(p, smem, xb);
  }
}

__global__ void __launch_bounds__(256, 2) mega(Params p) {
  __shared__ __attribute__((aligned(16))) char smem[65536];
  XB xb;
  xb_post(xb, p.bar);
  run_from<0>(p, smem, xb);
}
#endif

template <int PH>
static void launch_phases(const Params p, int grid, hipStream_t stream) {
  hipLaunchKernelGGL(phase_kernel<PH>, dim3(grid), dim3(256), 0, stream, p);
  if constexpr (PH + 1 < N_PHASES) launch_phases<PH + 1>(p, grid, stream);
}

static inline size_t al256(size_t x) { return (x + 255) & ~(size_t)255; }

extern "C" void kernel_launch(void* const* d_in, const int* in_sizes, int n_in, void* d_out, int out_size, void* d_ws,
                              size_t ws_size, hipStream_t stream) {
  Params p{};
  const float** ip = (const float**)&p;
  for (int i = 0; i < 35; i++) ip[i] = (const float*)d_in[i];
  p.out = (float*)d_out;
  char* w = (char*)d_ws;
  size_t off = 0;
  auto take = [&](size_t bytes) { char* r = w + off; off = al256(off + bytes); return r; };
  p.wt_in = (h16*)take((size_t)2 * 3072 * 1024 * 2);
  p.wt_merge = (h16*)take((size_t)2 * 4096 * 1024 * 2);
  p.wt_branch = (h16*)take((size_t)2 * 4 * 1024 * 256 * 2);
  p.wt_out = (h16*)take((size_t)2 * 1024 * 1024 * 2);
  p.wt_qup = (h16*)take((size_t)2 * 384 * 256 * 2);
  p.wt_kvup = (h16*)take((size_t)2 * 512 * 128 * 2);
  p.wt_kvraw = (h16*)take((size_t)2 * 512 * 128 * 2);
  p.wt_glu = (h16*)take((size_t)2 * 512 * 256 * 2);
  p.hbuf = (h16*)take((size_t)T_ALL * 1024 * 2);
  p.zbuf = (h16*)take((size_t)T_ALL * ZLD * 2);
  p.br = (h16*)take((size_t)T_ALL * 1024 * 2);
  p.qm = (h16*)take((size_t)T_ALL * 384 * 2);
  p.kmla = (h16*)take((size_t)T_ALL * 384 * 2);
  p.kcx = (h16*)take((size_t)2048 * 384 * 2);
  p.vt_a_ctx = (h16*)take((size_t)32 * 2 * 64 * 256 * 2);
  p.vt_a_lat = (h16*)take((size_t)4 * 2 * 64 * 2048 * 2);
  p.vt_d_ctx = (h16*)take((size_t)32 * 4 * 64 * 256 * 2);
  p.vt_d_lat = (h16*)take((size_t)4 * 4 * 64 * 2048 * 2);
  p.vt_m_ctx = (h16*)take((size_t)32 * 4 * 64 * 256 * 2);
  p.vt_m_lat = (h16*)take((size_t)4 * 4 * 64 * 2048 * 2);
  p.vcx_t = (h16*)take((size_t)4 * 4 * 64 * 512 * 2);
  p.ck_a = (h16*)take((size_t)524288 * 2);
  p.cvt_a = (h16*)take((size_t)524288 * 2);
  p.ck_n = (h16*)take((size_t)1048576 * 2);
  p.cvt_n = (h16*)take((size_t)1048576 * 2);
  p.ckv_c = (h16*)take((size_t)524288 * 2);
  p.s5_bmt = (h16*)take((size_t)64 * 128 * 16 * 2);
  p.s5_cmt = (h16*)take((size_t)64 * 16 * 128 * 2);
  p.s5_abar = (float*)take(4096 * 2 * 4);
  p.s5_lamdt = (float*)take(4096 * 2 * 4);
  p.s5_dt = (float*)take(64 * 4);
  p.s5_e = (float*)take((size_t)4 * 16 * 2 * 8 * 128 * 4);
  p.modv = (float*)take(2 * 5 * 3072 * 4);
  p.cs16 = (float*)take(64 * 16 * 2 * 4);
  p.cs8 = (float*)take(64 * 8 * 2 * 4);
  p.bar = (unsigned*)take(XCD_BAR_WORDS * 4);
  if (off > ws_size) { fprintf(stderr, "workspace too small: need %zu have %zu\n", off, ws_size); return; }

  static int grid_blocks = 0;
  if (!grid_blocks) {
    int dev = 0, cus = 0, per_cu = 0;
    (void)hipGetDevice(&dev);
    (void)hipDeviceGetAttribute(&cus, hipDeviceAttributeMultiprocessorCount, dev);
    #ifdef MULTI_LAUNCH
    (void)hipOccupancyMaxActiveBlocksPerMultiprocessor(&per_cu, phase_kernel<3>, 256, 0);
#else
    (void)hipOccupancyMaxActiveBlocksPerMultiprocessor(&per_cu, mega, 256, 0);
#endif
    if (per_cu > 2) per_cu = 2;
    if (per_cu < 1) per_cu = 1;
    grid_blocks = cus * per_cu;
  }
#ifdef MULTI_LAUNCH
  launch_phases<0>(p, grid_blocks, stream);
#else
  (void)hipMemsetAsync(p.bar, 0, XCD_BAR_WORDS * 4, stream);
  void* args[] = {&p};
  hipError_t e = hipLaunchCooperativeKernel((void*)mega, dim3(grid_blocks), dim3(256), args, 0, stream);
  if (e != hipSuccess) fprintf(stderr, "cooperative launch failed: %s (grid %d)\n", hipGetErrorString(e), grid_blocks);
#endif
}
```

```cpp
#include <hip/hip_runtime.h>
#include <hip/hip_cooperative_groups.h>
#include <cstdio>
#include <cstdint>
namespace cg = cooperative_groups;

typedef _Float16 h16;
typedef __attribute__((ext_vector_type(8))) _Float16 h16x8;
typedef __attribute__((ext_vector_type(4))) _Float16 h16x4;
typedef __attribute__((ext_vector_type(4))) float f32x4;
typedef __attribute__((ext_vector_type(4))) unsigned int u32x4;

#define T_ALL 16384
#define T_CTX 8192
#define ZLD 2976
#define LOG2E 1.4426950408889634f

#define O_AK   16777216
#define O_AV   18874368
#define O_CKV  20971520
#define O_KPE  23068672
#define O_NK   23592960
#define O_NV   27787264
#define O_SRE  31981568
#define O_SIM  32112640

struct Params {
  const float *x_prompt, *x_sample, *cache_a_k, *cache_a_v, *cache_mla_ckv, *cache_mla_kpe, *cache_na_k, *cache_na_v,
      *state_re, *state_im, *c, *c_ctx, *w_mod, *b_mod, *norm_g, *w_in, *w_merge, *a_sink, *mla_q_norm, *mla_w_q_up,
      *mla_kv_norm, *mla_w_kv_up, *s5_lam_re, *s5_lam_im, *s5_log_dt, *s5_b_re, *s5_b_im, *s5_c_re, *s5_c_im, *s5_d,
      *s5_w_glu, *na_rpb, *w_branch, *w_out, *final_norm_g;
  float* out;
  h16 *wt_in, *wt_merge, *wt_branch, *wt_out, *wt_qup, *wt_kvup, *wt_kvraw, *wt_glu;
  h16 *hbuf, *zbuf, *br, *qm, *kmla, *kcx, *vt_a_ctx, *vt_a_lat, *vt_d_ctx, *vt_d_lat, *vt_m_ctx, *vt_m_lat, *vcx_t,
      *ck_a, *cvt_a, *ck_n, *cvt_n, *ckv_c, *s5_bmt, *s5_cmt;
  float *s5_abar, *s5_lamdt, *s5_dt, *s5_e, *modv, *cs16, *cs8;
  unsigned* bar;
};

__device__ __forceinline__ float sigmoidf_(float x) { return 1.f / (1.f + __expf(-x)); }
__device__ __forceinline__ float siluf_(float x) { return x * sigmoidf_(x); }
__device__ __forceinline__ float geluf_(float x) {
  float u = 0.7978845608028654f * (x + 0.044715f * x * x * x);
  return 0.5f * x * (1.f + tanhf(u));
}
__device__ __forceinline__ float wave_sum(float v) {
#pragma unroll
  for (int o = 32; o > 0; o >>= 1) v += __shfl_xor(v, o);
  return v;
}
__device__ __forceinline__ const float* xptr(const Params p, int layer, int tok) {
  if (layer == 0) return tok < T_CTX ? p.x_prompt + (size_t)tok * 1024 : p.x_sample + (size_t)(tok - T_CTX) * 1024;
  return p.out + (size_t)tok * 1024;
}
__device__ __forceinline__ int cond_of(int tok) { return tok < T_CTX ? 0 : 1 + ((tok - T_CTX) >> 11); }

#define SWZ(row, slot) (((row) << 7) + ((((slot) ^ (((row) >> 1) & 7))) << 4))

template <int BM, int BN>
__device__ __forceinline__ void gemm_acc(f32x4 (&acc)[BM / 32][BN / 32], const h16* __restrict__ A, int lda,
                                         const h16* __restrict__ Bt, int ldb, int K, char* smem) {
  constexpr int MREP = BM / 32, NREP = BN / 32;
  constexpr int ACH = BM * 8 / 256, BCH = BN * 8 / 256;
  constexpr int ABYTES = BM * 128, STAGE = (BM + BN) * 128;
  const int tid = threadIdx.x, lane = tid & 63, wid = tid >> 6;
  const int wr = wid >> 1, wc = wid & 1;
  const int l15 = lane & 15, g = lane >> 4;
  const int nk = K >> 6;
  const int ls = (tid & 7) ^ ((tid >> 4) & 7);
  const h16* Ap = A + (size_t)(tid >> 3) * lda + ls * 8;
  const h16* Bp = Bt + (size_t)(tid >> 3) * ldb + ls * 8;
  char* dstA = smem + tid * 16;
  char* dstB = smem + ABYTES + tid * 16;
#pragma unroll
  for (int i = 0; i < ACH; i++)
    __builtin_amdgcn_global_load_lds((const unsigned*)(Ap + (size_t)(i * 32) * lda), (__attribute__((address_space(3))) unsigned*)(dstA + i * 4096), 16, 0, 0);
#pragma unroll
  for (int i = 0; i < BCH; i++)
    __builtin_amdgcn_global_load_lds((const unsigned*)(Bp + (size_t)(i * 32) * ldb), (__attribute__((address_space(3))) unsigned*)(dstB + i * 4096), 16, 0, 0);
  for (int kt = 0; kt < nk; kt++) {
    asm volatile("s_waitcnt vmcnt(0)" ::: "memory");
    __syncthreads();
    if (kt + 1 < nk) {
      const int nb = ((kt + 1) & 1) * STAGE;
#pragma unroll
      for (int i = 0; i < ACH; i++)
        __builtin_amdgcn_global_load_lds((const unsigned*)(Ap + (size_t)(i * 32) * lda + (kt + 1) * 64), (__attribute__((address_space(3))) unsigned*)(dstA + nb + i * 4096), 16, 0, 0);
#pragma unroll
      for (int i = 0; i < BCH; i++)
        __builtin_amdgcn_global_load_lds((const unsigned*)(Bp + (size_t)(i * 32) * ldb + (kt + 1) * 64), (__attribute__((address_space(3))) unsigned*)(dstB + nb + i * 4096), 16, 0, 0);
    }
    const char* sa = smem + (kt & 1) * STAGE;
    const char* sb = sa + ABYTES;
#pragma unroll
    for (int ks = 0; ks < 2; ks++) {
      h16x8 af[MREP], bf[NREP];
#pragma unroll
      for (int mi = 0; mi < MREP; mi++) af[mi] = *(const h16x8*)(sa + SWZ(wr * (BM / 2) + mi * 16 + l15, ks * 4 + g));
#pragma unroll
      for (int ni = 0; ni < NREP; ni++) bf[ni] = *(const h16x8*)(sb + SWZ(wc * (BN / 2) + ni * 16 + l15, ks * 4 + g));
#pragma unroll
      for (int mi = 0; mi < MREP; mi++)
#pragma unroll
        for (int ni = 0; ni < NREP; ni++)
          acc[mi][ni] = __builtin_amdgcn_mfma_f32_16x16x32_f16(bf[ni], af[mi], acc[mi][ni], 0, 0, 0);
    }
  }
  __syncthreads();
}

template <int M, int N>
__device__ __forceinline__ void zero_acc(f32x4 (&a)[M][N]) {
#pragma unroll
  for (int i = 0; i < M; i++)
#pragma unroll
    for (int j = 0; j < N; j++) a[i][j] = f32x4{0.f, 0.f, 0.f, 0.f};
}

__device__ __forceinline__ void store_h4(h16* dst, float a, float b, float c, float d) {
  h16x4 v = {(h16)a, (h16)b, (h16)c, (h16)d};
  *(h16x4*)dst = v;
}

__device__ void tr_tile(const float* __restrict__ src, int lds_, h16* __restrict__ dst, int ldd, int k0, int n0, int N,
                        char* smem) {
  float* tile = (float*)smem;
  const int tid = threadIdx.x;
  const int r = tid >> 4, c4 = tid & 15;
#pragma unroll
  for (int rr = 0; rr < 4; rr++) {
    int kl = r + rr * 16;
    int n = n0 + c4 * 4;
    float4 v = make_float4(0.f, 0.f, 0.f, 0.f);
    if (n < N) v = *(const float4*)(src + (size_t)(k0 + kl) * lds_ + n);
    tile[kl * 65 + c4 * 4 + 0] = v.x;
    tile[kl * 65 + c4 * 4 + 1] = v.y;
    tile[kl * 65 + c4 * 4 + 2] = v.z;
    tile[kl * 65 + c4 * 4 + 3] = v.w;
  }
  __syncthreads();
  const int nl = tid >> 2, kq = tid & 3;
  h16x8 o0, o1;
#pragma unroll
  for (int i = 0; i < 8; i++) {
    o0[i] = (h16)tile[(kq * 16 + i) * 65 + nl];
    o1[i] = (h16)tile[(kq * 16 + 8 + i) * 65 + nl];
  }
  h16* d = dst + (size_t)(n0 + nl) * ldd + k0 + kq * 16;
  *(h16x8*)d = o0;
  *(h16x8*)(d + 8) = o1;
  __syncthreads();
}

__device__ void phase_prep(const Params p, char* smem) {
  const int tid = threadIdx.x;
  const size_t gtid = (size_t)blockIdx.x * 256 + tid, gsz = (size_t)gridDim.x * 256;
  for (size_t i = gtid; i < 2 * 384 * 256; i += gsz) {
    int l = i / (384 * 256), r = i % (384 * 256), n = r / 256, k = r % 256;
    p.wt_qup[i] = (h16)(p.mla_q_norm[l * 256 + k] * p.mla_w_q_up[(size_t)l * 256 * 384 + k * 384 + n]);
  }
  for (size_t i = gtid; i < 2 * 512 * 128; i += gsz) {
    int l = i / (512 * 128), r = i % (512 * 128), n = r / 128, k = r % 128;
    float w = p.mla_w_kv_up[(size_t)l * 128 * 512 + k * 512 + n];
    p.wt_kvraw[i] = (h16)w;
    p.wt_kvup[i] = (h16)(w * p.mla_kv_norm[l * 128 + k]);
  }
  for (size_t i = gtid; i < 2 * 512 * 256; i += gsz) {
    int l = i / (512 * 256), r = i % (512 * 256), n = r / 256, k = r % 256;
    int q = n >> 5, w = n & 31;
    int orig = (w < 16) ? (q * 16 + w) : (256 + q * 16 + (w - 16));
    p.wt_glu[i] = (h16)p.s5_w_glu[(size_t)l * 256 * 512 + k * 512 + orig];
  }
  for (size_t i = gtid; i < 524288; i += gsz) {
    p.ck_a[i] = (h16)p.cache_a_k[i];
    p.ckv_c[i] = (h16)p.cache_mla_ckv[i];
  }
  for (size_t i = gtid; i < 1048576; i += gsz) p.ck_n[i] = (h16)p.cache_na_k[i];
  for (size_t i = gtid; i < 4096; i += gsz) {
    int ldg = i >> 6;
    float lr = fminf(p.s5_lam_re[i], -1e-4f), li = p.s5_lam_im[i];
    float dt = __expf(p.s5_log_dt[ldg]);
    float er = expf(lr * dt), sn, cs;
    sincosf(li * dt, &sn, &cs);
    float ar = er * cs, ai = er * sn;
    p.s5_abar[i * 2] = ar;
    p.s5_abar[i * 2 + 1] = ai;
    p.s5_lamdt[i * 2] = lr * dt;
    p.s5_lamdt[i * 2 + 1] = li * dt;
    if ((i & 63) == 0) p.s5_dt[ldg] = dt;
    float nr = ar - 1.f, ni = ai, den = lr * lr + li * li;
    float cr = (nr * lr + ni * li) / den / dt, ci = (ni * lr - nr * li) / den / dt;
    int pp = i & 63;
    for (int c = 0; c < 16; c++) {
      float br_ = p.s5_b_re[i * 16 + c], bi_ = p.s5_b_im[i * 16 + c];
      p.s5_bmt[((size_t)ldg * 128 + pp) * 16 + c] = (h16)(cr * br_ - ci * bi_);
      p.s5_bmt[((size_t)ldg * 128 + 64 + pp) * 16 + c] = (h16)(cr * bi_ + ci * br_);
      p.s5_cmt[((size_t)ldg * 16 + c) * 128 + pp] = (h16)p.s5_c_re[((size_t)ldg * 16 + c) * 64 + pp];
      p.s5_cmt[((size_t)ldg * 16 + c) * 128 + 64 + pp] = (h16)(-p.s5_c_im[((size_t)ldg * 16 + c) * 64 + pp]);
    }
  }
  for (size_t i = gtid; i < 64 * 16; i += gsz) {
    int pos = i >> 4, k = i & 15;
    float inv = powf(10000.f, -(float)k / 16.f), sn, cs;
    sincosf((float)pos * inv, &sn, &cs);
    p.cs16[i * 2] = cs;
    p.cs16[i * 2 + 1] = sn;
  }
  for (size_t i = gtid; i < 64 * 8; i += gsz) {
    int pos = i >> 3, k = i & 7;
    float inv = powf(10000.f, -(float)k / 8.f), sn, cs;
    sincosf((float)pos * inv, &sn, &cs);
    p.cs8[i * 2] = cs;
    p.cs8[i * 2 + 1] = sn;
  }
  for (int it = blockIdx.x; it < 384; it += gridDim.x) {
    float* sc = (float*)smem;
    float* red = sc + 5 * 1024;
    const int layer = it / 192, col0 = (it % 192) * 16;
    for (int i = tid; i < 5120; i += 256) {
      int c = i >> 10, k = i & 1023;
      float v = (c == 0) ? p.c_ctx[k] : p.c[(c - 1) * 1024 + k];
      sc[i] = siluf_(v);
    }
    __syncthreads();
    const int cl = tid & 15, kg = tid >> 4;
    float a0 = 0, a1 = 0, a2 = 0, a3 = 0, a4 = 0;
    const float* w = p.w_mod + (size_t)layer * 1024 * 3072 + col0 + cl;
#pragma unroll 8
    for (int kk = 0; kk < 64; kk++) {
      int k = kg * 64 + kk;
      float wv = w[(size_t)k * 3072];
      a0 += sc[k] * wv;
      a1 += sc[1024 + k] * wv;
      a2 += sc[2048 + k] * wv;
      a3 += sc[3072 + k] * wv;
      a4 += sc[4096 + k] * wv;
    }
    red[(kg * 5 + 0) * 16 + cl] = a0;
    red[(kg * 5 + 1) * 16 + cl] = a1;
    red[(kg * 5 + 2) * 16 + cl] = a2;
    red[(kg * 5 + 3) * 16 + cl] = a3;
    red[(kg * 5 + 4) * 16 + cl] = a4;
    __syncthreads();
    if (tid < 80) {
      int c = tid >> 4, cc = tid & 15;
      float s = 0;
      for (int q = 0; q < 16; q++) s += red[(q * 5 + c) * 16 + cc];
      p.modv[(layer * 5 + c) * 3072 + col0 + cc] = s + p.b_mod[layer * 3072 + col0 + cc];
    }
    __syncthreads();
  }
  for (int it = blockIdx.x; it < 4992; it += gridDim.x) {
    const float* src; h16* dst; int lds_, ldd, N, NT, tile;
    if (it < 4608) {
      int l = it / 2304, r = it % 2304;
      if (r < 768) { src = p.w_in + (size_t)l * 1024 * 2976; lds_ = 2976; dst = p.wt_in + (size_t)l * 3072 * 1024; ldd = 1024; N = 2976; NT = 48; tile = r; }
      else if (r < 1792) { src = p.w_merge + (size_t)l * 1024 * 4096; lds_ = 4096; dst = p.wt_merge + (size_t)l * 4096 * 1024; ldd = 1024; N = 4096; NT = 64; tile = r - 768; }
      else if (r < 2048) { int k = (r - 1792) >> 6; src = p.w_branch + (size_t)(l * 4 + k) * 256 * 1024; lds_ = 1024; dst = p.wt_branch + (size_t)(l * 4 + k) * 1024 * 256; ldd = 256; N = 1024; NT = 16; tile = (r - 1792) & 63; }
      else { src = p.w_out + (size_t)l * 1048576; lds_ = 1024; dst = p.wt_out + (size_t)l * 1048576; ldd = 1024; N = 1024; NT = 16; tile = r - 2048; }
    } else {
      int r = it - 4608;
      if (r < 128) { int m = r >> 4; src = p.cache_a_v + (size_t)m * 512 * 128; lds_ = 128; dst = p.cvt_a + (size_t)m * 128 * 512; ldd = 512; N = 128; NT = 2; tile = r & 15; }
      else { r -= 128; int m = r >> 5; src = p.cache_na_v + (size_t)m * 512 * 256; lds_ = 256; dst = p.cvt_n + (size_t)m * 256 * 512; ldd = 512; N = 256; NT = 4; tile = r & 31; }
    }
    tr_tile(src, lds_, dst, ldd, (tile / NT) * 64, (tile % NT) * 64, N, smem);
  }
}

__device__ void phase_norm(const Params p, int layer) {
  const int lane = threadIdx.x & 63, wid = threadIdx.x >> 6;
  const float* g = p.norm_g + layer * 1024;
  for (int row = blockIdx.x * 4 + wid; row < T_ALL; row += gridDim.x * 4) {
    const float* x = xptr(p, layer, row);
    const float* mod = p.modv + (layer * 5 + cond_of(row)) * 3072;
    float4 v[4];
    float ss = 0;
#pragma unroll
    for (int i = 0; i < 4; i++) {
      v[i] = *(const float4*)(x + i * 256 + lane * 4);
      ss += v[i].x * v[i].x + v[i].y * v[i].y + v[i].z * v[i].z + v[i].w * v[i].w;
    }
    ss = wave_sum(ss);
    float rstd = rsqrtf(ss * (1.f / 1024.f) + 1e-6f);
#pragma unroll
    for (int i = 0; i < 4; i++) {
      int k = i * 256 + lane * 4;
      float4 gg = *(const float4*)(g + k), sh = *(const float4*)(mod + k), sc = *(const float4*)(mod + 1024 + k);
      store_h4(p.hbuf + (size_t)row * 1024 + k, v[i].x * rstd * gg.x * (1.f + sc.x) + sh.x,
               v[i].y * rstd * gg.y * (1.f + sc.y) + sh.y, v[i].z * rstd * gg.z * (1.f + sc.z) + sh.z,
               v[i].w * rstd * gg.w * (1.f + sc.w) + sh.w);
    }
  }
}

__device__ void phase_final(const Params p) {
  const int lane = threadIdx.x & 63, wid = threadIdx.x >> 6;
  const float* g = p.final_norm_g;
  for (int row = blockIdx.x * 4 + wid; row < T_ALL; row += gridDim.x * 4) {
    float* x = p.out + (size_t)row * 1024;
    float4 v[4];
    float ss = 0;
#pragma unroll
    for (int i = 0; i < 4; i++) {
      v[i] = *(const float4*)(x + i * 256 + lane * 4);
      ss += v[i].x * v[i].x + v[i].y * v[i].y + v[i].z * v[i].z + v[i].w * v[i].w;
    }
    ss = wave_sum(ss);
    float rstd = rsqrtf(ss * (1.f / 1024.f) + 1e-6f);
#pragma unroll
    for (int i = 0; i < 4; i++) {
      int k = i * 256 + lane * 4;
      float4 gg = *(const float4*)(g + k);
      *(float4*)(x + k) = make_float4(v[i].x * rstd * gg.x, v[i].y * rstd * gg.y, v[i].z * rstd * gg.z, v[i].w * rstd * gg.w);
    }
  }
}

__device__ void phase_g1(const Params p, int layer, char* smem) {
  const int lane = threadIdx.x & 63, wid = threadIdx.x >> 6, wr = wid >> 1, wc = wid & 1, l15 = lane & 15, g = lane >> 4;
  const h16* Wt = p.wt_in + (size_t)layer * 3072 * 1024;
  for (int tile = blockIdx.x; tile < 128 * 24; tile += gridDim.x) {
    const int rt = tile / 24, ct = tile % 24;
    const int r0 = rt * 128, n0 = ct * 128;
    f32x4 acc[4][4];
    zero_acc(acc);
    gemm_acc<128, 128>(acc, p.hbuf + (size_t)r0 * 1024, 1024, Wt + (size_t)n0 * 1024, 1024, 1024, smem);
    const bool ctx = r0 < T_CTX;
#pragma unroll
    for (int ni = 0; ni < 4; ni++) {
      const int col = n0 + wc * 64 + ni * 16 + 4 * g;
      if (col >= ZLD) continue;
      const int fb = n0 + wc * 64 + ni * 16;
#pragma unroll
      for (int mi = 0; mi < 4; mi++) {
        const int tok = r0 + wr * 64 + mi * 16 + l15;
        f32x4 v = acc[mi][ni];
        store_h4(p.zbuf + (size_t)tok * ZLD + col, v[0], v[1], v[2], v[3]);
        int b, l, Ls;
        if (ctx) { b = tok >> 8; l = tok & 255; Ls = 256; } else { b = (tok - T_CTX) >> 11; l = (tok - T_CTX) & 2047; Ls = 2048; }
        if (fb >= 384 && fb < 512) {
          h16* vt = p.vt_a_ctx + (ctx ? 0 : 1048576);
          int cc = col - 384;
#pragma unroll
          for (int j = 0; j < 4; j++) vt[((size_t)(b * 2 + ((cc + j) >> 6)) * 64 + ((cc + j) & 63)) * Ls + l] = (h16)v[j];
        } else if (fb >= 2464 && fb < 2720) {
          h16* vt = p.vt_d_ctx + (ctx ? 0 : 2097152);
          int cc = col - 2464;
#pragma unroll
          for (int j = 0; j < 4; j++) vt[((size_t)(b * 4 + ((cc + j) >> 6)) * 64 + ((cc + j) & 63)) * Ls + l] = (h16)v[j];
        }
        if (ctx) {
          const size_t rowi = (size_t)(b * 2 + layer) * 256 + l;
          float4 fv = make_float4(v[0], v[1], v[2], v[3]);
          if (fb >= 256 && fb < 384) *(float4*)(p.out + O_AK + rowi * 128 + (col - 256)) = fv;
          else if (fb >= 384 && fb < 512) *(float4*)(p.out + O_AV + rowi * 128 + (col - 384)) = fv;
          else if (fb >= 1152 && fb < 1184) *(float4*)(p.out + O_KPE + rowi * 32 + (col - 1152)) = fv;
          else if (fb >= 2208 && fb < 2464) *(float4*)(p.out + O_NK + rowi * 256 + (col - 2208)) = fv;
          else if (fb >= 2464 && fb < 2720) *(float4*)(p.out + O_NV + rowi * 256 + (col - 2464)) = fv;
        }
      }
    }
  }
}

#define BUS 136
__device__ void s5_item(const Params p, int layer, int mode, int b, int g, int chunk, char* smem) {
  const int tid = threadIdx.x, lane = tid & 63, wid = tid >> 6, l15 = lane & 15, gq = lane >> 4;
  h16* su = (h16*)smem;
  h16* sy = su + 256 * 16;
  h16* sbu = sy + 2 * 256 * 16;
  const int tok0 = (mode == 0) ? b * 256 : T_CTX + b * 2048 + chunk * 256;
  for (int i = tid; i < 512; i += 256) {
    int t = i >> 1, hf = i & 1;
    *(u32x4*)(su + t * 16 + hf * 8) = *(const u32x4*)(p.zbuf + (size_t)(tok0 + t) * ZLD + 1440 + g * 16 + hf * 8);
  }
  __syncthreads();
  if (wid < 2) {
    const int dir = wid;
    const int ldg = (layer * 2 + dir) * 16 + g;
    const float ar = p.s5_abar[(ldg * 64 + lane) * 2], ai = p.s5_abar[(ldg * 64 + lane) * 2 + 1];
    const float dt = p.s5_dt[ldg];
    float hr = 0.f, hi = 0.f;
    if (mode == 2) {
      const size_t sidx = ((((size_t)b * 2 + layer) * 2 + dir) * 16 + g) * 64 + lane;
      hr = p.state_re[sidx];
      hi = p.state_im[sidx];
      float lr = p.s5_lamdt[(ldg * 64 + lane) * 2] * 256.f, li = p.s5_lamdt[(ldg * 64 + lane) * 2 + 1] * 256.f;
      float er = expf(lr), sn, cs;
      sincosf(li, &sn, &cs);
      const float pr = er * cs, pi = er * sn;
      const float* e = p.s5_e + ((((size_t)b * 16 + g) * 2 + dir) * 8) * 128;
      if (dir == 0) {
        for (int c2 = 0; c2 < chunk; c2++) {
          float er_ = e[c2 * 128 + lane * 2], ei_ = e[c2 * 128 + lane * 2 + 1];
          float nr = pr * hr - pi * hi + er_, ni = pr * hi + pi * hr + ei_;
          hr = nr; hi = ni;
        }
      } else {
        for (int c2 = 7; c2 > chunk; c2--) {
          float er_ = e[c2 * 128 + lane * 2], ei_ = e[c2 * 128 + lane * 2 + 1];
          float nr = pr * hr - pi * hi + er_, ni = pr * hi + pi * hr + ei_;
          hr = nr; hi = ni;
        }
      }
    }
    h16x4 bfr[8];
    const h16* bmt = p.s5_bmt + (size_t)ldg * 128 * 16;
#pragma unroll
    for (int nf = 0; nf < 8; nf++) bfr[nf] = *(const h16x4*)(bmt + (nf * 16 + l15) * 16 + 4 * gq);
    h16x8 cfr[4];
    const h16* cmt = p.s5_cmt + (size_t)ldg * 16 * 128;
#pragma unroll
    for (int ks = 0; ks < 4; ks++) cfr[ks] = *(const h16x8*)(cmt + l15 * 128 + ks * 32 + 8 * gq);
    h16* bu = sbu + dir * 16 * BUS;
    h16* ydir = sy + dir * 256 * 16;
    for (int sub = 0; sub < 16; sub++) {
      const int sc = dir == 0 ? sub : 15 - sub;
      const int tt0 = sc * 16;
      h16x4 ua = *(const h16x4*)(su + (tt0 + l15) * 16 + 4 * gq);
#pragma unroll
      for (int nf = 0; nf < 8; nf++) {
        f32x4 r = __builtin_amdgcn_mfma_f32_16x16x16f16(bfr[nf], ua, f32x4{0.f, 0.f, 0.f, 0.f}, 0, 0, 0);
        store_h4(bu + l15 * BUS + nf * 16 + 4 * gq, r[0], r[1], r[2], r[3]);
      }
      __builtin_amdgcn_wave_barrier();
#pragma unroll 4
      for (int s = 0; s < 16; s++) {
        const int t = dir == 0 ? s : 15 - s;
        float bur = (float)bu[t * BUS + lane], bui = (float)bu[t * BUS + 64 + lane];
        float nr = ar * hr - ai * hi + dt * bur, ni = ar * hi + ai * hr + dt * bui;
        hr = nr; hi = ni;
        bu[t * BUS + lane] = (h16)hr;
        bu[t * BUS + 64 + lane] = (h16)hi;
      }
      __builtin_amdgcn_wave_barrier();
      if (mode != 1) {
        f32x4 y = {0.f, 0.f, 0.f, 0.f};
#pragma unroll
        for (int ks = 0; ks < 4; ks++) {
          h16x8 ha = *(const h16x8*)(bu + l15 * BUS + ks * 32 + 8 * gq);
          y = __builtin_amdgcn_mfma_f32_16x16x32_f16(cfr[ks], ha, y, 0, 0, 0);
        }
        store_h4(ydir + (tt0 + l15) * 16 + 4 * gq, y[0], y[1], y[2], y[3]);
      }
      __builtin_amdgcn_wave_barrier();
    }
    if (mode == 0) {
      const size_t oi = ((((size_t)b * 2 + layer) * 2 + dir) * 16 + g) * 64 + lane;
      p.out[O_SRE + oi] = hr;
      p.out[O_SIM + oi] = hi;
    } else if (mode == 1) {
      float* e = p.s5_e + (((((size_t)b * 16 + g) * 2 + dir) * 8) + chunk) * 128;
      e[lane * 2] = hr;
      e[lane * 2 + 1] = hi;
    }
  }
  __syncthreads();
  if (mode != 1) {
    for (int i = tid; i < 256 * 16; i += 256) {
      int t = i >> 4, c = i & 15;
      float u = (float)su[i];
      float v = (float)sy[i] + (float)sy[256 * 16 + i] + p.s5_d[layer * 256 + g * 16 + c] * u;
      p.zbuf[(size_t)(tok0 + t) * ZLD + 1440 + g * 16 + c] = (h16)geluf_(v);
    }
  }
  __syncthreads();
}


template <int NCOL>
__device__ __forceinline__ void row_rstd(const h16* __restrict__ base, float* rs) {
  const int tid = threadIdx.x, row = tid >> 1, hf = tid & 1;
  const h16* ptr = base + (size_t)row * ZLD + hf * (NCOL / 2);
  float s = 0.f;
#pragma unroll 2
  for (int i = 0; i < NCOL / 16; i++) {
    h16x8 v = *(const h16x8*)(ptr + i * 8);
#pragma unroll
    for (int j = 0; j < 8; j++) s += (float)v[j] * (float)v[j];
  }
  s += __shfl_xor(s, 1);
  if (hf == 0) rs[row] = rsqrtf(s * (1.f / NCOL) + 1e-6f);
}

__device__ void phase_g2(const Params p, int layer, char* smem) {
  const int tid = threadIdx.x, lane = tid & 63, wid = tid >> 6, wr = wid >> 1, wc = wid & 1, l15 = lane & 15, g = lane >> 4;
  for (int it = blockIdx.x; it < 1024; it += gridDim.x) {
    int mode, b, gg, ch;
    if (it < 512) { mode = 0; b = it >> 4; gg = it & 15; ch = 0; }
    else { int i2 = it - 512; mode = 1; b = i2 >> 7; gg = (i2 >> 3) & 15; ch = i2 & 7; }
    s5_item(p, layer, mode, b, gg, ch, smem);
  }
  for (int it = blockIdx.x; it < 768; it += gridDim.x) {
    {
      const int rt = it / 6, ct = it % 6, r0 = rt * 128, n0 = ct * 64;
      float* rs = (float*)(smem + 49152);
      row_rstd<256>(p.zbuf + (size_t)r0 * ZLD + 768, rs);
      f32x4 acc[4][2];
      zero_acc(acc);
      gemm_acc<128, 64>(acc, p.zbuf + (size_t)r0 * ZLD + 768, ZLD, p.wt_qup + (size_t)layer * 384 * 256 + (size_t)n0 * 256, 256, 256, smem);
      __syncthreads();
      const bool lat = r0 >= T_CTX;
#pragma unroll
      for (int mi = 0; mi < 4; mi++) {
        const int row = wr * 64 + mi * 16 + l15, tok = r0 + row;
        const float rstd = rs[row];
#pragma unroll
        for (int ni = 0; ni < 2; ni++) {
          const int fb = n0 + wc * 32 + ni * 16;
          f32x4 v = acc[mi][ni] * rstd;
          store_h4(p.qm + (size_t)tok * 384 + fb + 4 * g, v[0], v[1], v[2], v[3]);
        }
      }
      __syncthreads();
      if (lat && ct != 0 && ct != 3) {
        const int rc0 = n0 + ((ct == 2 || ct == 5) ? 32 : 0);
        for (int i = tid; i < 128 * 16; i += 256) {
          const int row = i >> 4, e = i & 15, tok = r0 + row;
          const int i8 = e & 7, base = (e < 8) ? 0 : 16;
          const int lpos = (tok - T_CTX) & 2047;
          const int pos = (e < 8) ? (lpos >> 6) : (lpos & 63);
          h16* ptr = p.qm + (size_t)tok * 384 + rc0 + base + i8;
          const float x1 = (float)ptr[0], x2 = (float)ptr[8];
          const float cs = p.cs8[(pos * 8 + i8) * 2], sn = p.cs8[(pos * 8 + i8) * 2 + 1];
          ptr[0] = (h16)(x1 * cs - x2 * sn);
          ptr[8] = (h16)(x1 * sn + x2 * cs);
        }
      }
      __syncthreads();
    }
  }
  for (int it = blockIdx.x; it < 1024 + 128; it += gridDim.x) {
    const int N_KV = 1024;
    {
      const bool cached = it >= N_KV;
      int rt, ct;
      const h16 *A, *Bt;
      int lda;
      if (!cached) { rt = it >> 3; ct = it & 7; A = p.zbuf + (size_t)(rt * 128) * ZLD + 1024; lda = ZLD; Bt = p.wt_kvup + (size_t)layer * 512 * 128; }
      else { int i2 = it - N_KV; rt = i2 >> 3; ct = i2 & 7; int b = rt >> 2, k0 = (rt & 3) * 128; A = p.ckv_c + ((size_t)(b * 2 + layer) * 512 + k0) * 128; lda = 128; Bt = p.wt_kvraw + (size_t)layer * 512 * 128; }
      const int r0 = rt * 128, n0 = ct * 64;
      float* rs = (float*)(smem + 49152);
      if (!cached) {
        row_rstd<128>(p.zbuf + (size_t)r0 * ZLD + 1024, rs);
      } else {
        if (tid < 128) rs[tid] = 1.f;
      }
      f32x4 acc[4][2];
      zero_acc(acc);
      gemm_acc<128, 64>(acc, A, lda, Bt + (size_t)n0 * 128, 128, 128, smem);
      const int head = n0 >> 7;
      const bool vtype = (n0 & 64) != 0;
#pragma unroll
      for (int mi = 0; mi < 4; mi++) {
        const int row = wr * 64 + mi * 16 + l15, tok = r0 + row;
        const float rstd = rs[row];
#pragma unroll
        for (int ni = 0; ni < 2; ni++) {
          const int d0 = wc * 32 + ni * 16 + 4 * g;
          f32x4 v = acc[mi][ni] * rstd;
          if (!vtype) {
            h16* dst = p.kmla + (cached ? (size_t)T_ALL * 384 : (size_t)0);
            store_h4(dst + (size_t)tok * 384 + head * 96 + d0, v[0], v[1], v[2], v[3]);
          } else {
            h16* vt; int bb, l, Ls;
            int voff;
            if (cached) { voff = 4194304; bb = tok >> 9; l = tok & 511; Ls = 512; }
            else if (tok < T_CTX) { voff = 0; bb = tok >> 8; l = tok & 255; Ls = 256; }
            else { voff = 2097152; bb = (tok - T_CTX) >> 11; l = (tok - T_CTX) & 2047; Ls = 2048; }
            vt = p.vt_m_ctx + voff;
#pragma unroll
            for (int j = 0; j < 4; j++) vt[((size_t)(bb * 4 + head) * 64 + d0 + j) * Ls + l] = (h16)v[j];
          }
        }
      }
      if (ct == 0 && !cached && r0 < T_CTX) {
        const float* gk = p.mla_kv_norm + layer * 128;
        for (int i = tid; i < 128 * 128; i += 256) {
          int row = i >> 7, k = i & 127, tok = r0 + row;
          float v = (float)p.zbuf[(size_t)tok * ZLD + 1024 + k] * rs[row] * gk[k];
          p.out[O_CKV + ((size_t)((tok >> 8) * 2 + layer) * 256 + (tok & 255)) * 128 + k] = v;
        }
      }
      if (ct == 1) {
        for (int i = tid; i < 128 * 16; i += 256) {
          int row = i >> 4, e = i & 15, tok = r0 + row;
          float x1, x2;
          h16* dst;
          if (cached) {
            int bb = tok >> 9, key = tok & 511;
            const float* src = p.cache_mla_kpe + ((size_t)(bb * 2 + layer) * 512 + key) * 32;
            x1 = src[e]; x2 = src[16 + e];
            dst = p.kmla + (size_t)T_ALL * 384 + (size_t)tok * 384;
            for (int h = 0; h < 4; h++) { dst[h * 96 + 64 + e] = (h16)x1; dst[h * 96 + 80 + e] = (h16)x2; }
          } else {
            const h16* src = p.zbuf + (size_t)tok * ZLD + 1152;
            int i8 = e & 7, base = (e < 8) ? 0 : 16;
            x1 = (float)src[base + i8]; x2 = (float)src[base + 8 + i8];
            float o1 = x1, o2 = x2;
            if (tok >= T_CTX) {
              int lpos = (tok - T_CTX) & 2047;
              int pos = (e < 8) ? (lpos >> 6) : (lpos & 63);
              float cs = p.cs8[(pos * 8 + i8) * 2], sn = p.cs8[(pos * 8 + i8) * 2 + 1];
              o1 = x1 * cs - x2 * sn; o2 = x1 * sn + x2 * cs;
            }
            dst = p.kmla + (size_t)tok * 384;
            for (int h = 0; h < 4; h++) { dst[h * 96 + 64 + base + i8] = (h16)o1; dst[h * 96 + 64 + base + 8 + i8] = (h16)o2; }
          }
        }
      }
      __syncthreads();
    }
  }
  for (int it = blockIdx.x; it < 128; it += gridDim.x) {
    {
      const int t0 = T_CTX + it * 64;
      for (int i = tid; i < 64 * 192; i += 256) {
        int tl = i / 192, pr = i % 192;
        int tok = t0 + tl, lpos = (tok - T_CTX) & 2047;
        int head = pr >> 5, w = pr & 31;
        int i16 = w & 15, base = (w < 16) ? 0 : 32;
        int pos = (w < 16) ? (lpos >> 6) : (lpos & 63);
        h16* ptr = p.zbuf + (size_t)tok * ZLD + head * 64 + base + i16;
        float x1 = (float)ptr[0], x2 = (float)ptr[16];
        float cs = p.cs16[(pos * 16 + i16) * 2], sn = p.cs16[(pos * 16 + i16) * 2 + 1];
        ptr[0] = (h16)(x1 * cs - x2 * sn);
        ptr[16] = (h16)(x1 * sn + x2 * cs);
      }
    }
  }
}

struct Seg { const h16* K; const h16* Vt; int ldk, ldv, ntiles; };

template <int DQK, int MODE>
__device__ void attn_item(const h16* __restrict__ Q, int ldq, Seg s0, Seg s1, float scale_l2, bool has_sink, float sink_l2,
                          int qpos0, int kpos0, const float* __restrict__ rpb_h, int qrow, int krow0,
                          h16* __restrict__ outp, const h16* __restrict__ gate, char* smem) {
  constexpr int KCH = DQK / 8;
  constexpr int KROWB = DQK * 2;
  constexpr int KPT = 64 * KCH / 256;
  constexpr int KBYTES = 64 * KROWB;
  constexpr int STAGE = KBYTES + 8192;
  constexpr int NKS = DQK / 32;
  const int tid = threadIdx.x, lane = tid & 63, wid = tid >> 6, l15 = lane & 15, g = lane >> 4;
  h16x8 qf[NKS];
#pragma unroll
  for (int ks = 0; ks < NKS; ks++) qf[ks] = *(const h16x8*)(Q + (size_t)(wid * 16 + l15) * ldq + ks * 32 + 8 * g);
  float m = has_sink ? sink_l2 : -1e30f;
  float lsum = (has_sink && g == 0) ? 1.f : 0.f;
  f32x4 o[4];
#pragma unroll
  for (int i = 0; i < 4; i++) o[i] = f32x4{0.f, 0.f, 0.f, 0.f};
  const int ntot = s0.ntiles + s1.ntiles;
  u32x4 rk[KPT], rv[2];
#define TILE_PTRS(ti_) \
    const h16 *kp, *vp; int ldk, ldv; \
    if ((ti_) < s0.ntiles) { kp = s0.K + (size_t)(ti_) * 64 * s0.ldk; vp = s0.Vt + (ti_) * 64; ldk = s0.ldk; ldv = s0.ldv; } \
    else { int t2 = (ti_) - s0.ntiles; kp = s1.K + (size_t)t2 * 64 * s1.ldk; vp = s1.Vt + t2 * 64; ldk = s1.ldk; ldv = s1.ldv; }
  {
    TILE_PTRS(0)
#pragma unroll
    for (int i = 0; i < KPT; i++) { int c = tid + i * 256; int row = c / KCH, sl = c % KCH; rk[i] = *(const u32x4*)(kp + (size_t)row * ldk + sl * 8); }
#pragma unroll
    for (int i = 0; i < 2; i++) { int c = tid + i * 256; int row = c >> 3, sl = c & 7; rv[i] = *(const u32x4*)(vp + (size_t)row * ldv + sl * 8); }
    char* sk = smem; char* sv = smem + KBYTES;
#pragma unroll
    for (int i = 0; i < KPT; i++) { int c = tid + i * 256; int row = c / KCH, sl = c % KCH; int off = (DQK == 64) ? SWZ(row, sl) : (row * KROWB + sl * 16); *(u32x4*)(sk + off) = rk[i]; }
#pragma unroll
    for (int i = 0; i < 2; i++) { int c = tid + i * 256; int row = c >> 3, sl = c & 7; *(u32x4*)(sv + SWZ(row, sl)) = rv[i]; }
  }
  __syncthreads();
  for (int ti = 0; ti < ntot; ti++) {
    const bool more = ti + 1 < ntot;
    if (more) {
      TILE_PTRS(ti + 1)
#pragma unroll
      for (int i = 0; i < KPT; i++) { int c = tid + i * 256; int row = c / KCH, sl = c % KCH; rk[i] = *(const u32x4*)(kp + (size_t)row * ldk + sl * 8); }
#pragma unroll
      for (int i = 0; i < 2; i++) { int c = tid + i * 256; int row = c >> 3, sl = c & 7; rv[i] = *(const u32x4*)(vp + (size_t)row * ldv + sl * 8); }
    }
    const char* sk = smem + (ti & 1) * STAGE;
    const char* sv = sk + KBYTES;
    f32x4 s[4];
#pragma unroll
    for (int kf = 0; kf < 4; kf++) {
      s[kf] = f32x4{0.f, 0.f, 0.f, 0.f};
#pragma unroll
      for (int ks = 0; ks < NKS; ks++) {
        const int row = kf * 16 + l15, sl = ks * 4 + g;
        const int off = (DQK == 64) ? SWZ(row, sl) : (row * KROWB + sl * 16);
        h16x8 ka = *(const h16x8*)(sk + off);
        s[kf] = __builtin_amdgcn_mfma_f32_16x16x32_f16(ka, qf[ks], s[kf], 0, 0, 0);
      }
    }
    const bool masked = (MODE != 0) && (ti < s0.ntiles);
    float mx = -INFINITY;
#pragma unroll
    for (int kf = 0; kf < 4; kf++)
#pragma unroll
      for (int j = 0; j < 4; j++) {
        float x = s[kf][j] * scale_l2;
        if (MODE == 1 && masked) {
          int kpos = kpos0 + ti * 64 + kf * 16 + 4 * g + j, qpos = qpos0 + wid * 16 + l15;
          int d = qpos - kpos;
          if (d > 128 || d < -128) x = -INFINITY;
        }
        if (MODE == 2 && masked) {
          int ck = kf * 16 + 4 * g + j, cq = wid * 16 + l15;
          int cs = min(max(cq - 8, 0), 48);
          int rel = ck - cs;
          if (rel < 0 || rel >= 16) x = -INFINITY;
          else {
            int co = min(max(ck - cq, -15), 15) + 15;
            int ro = (krow0 + ti) - qrow + 7;
            x += rpb_h[ro * 31 + co] * LOG2E;
          }
        }
        s[kf][j] = x;
        mx = fmaxf(mx, x);
      }
    mx = fmaxf(mx, __shfl_xor(mx, 16));
    mx = fmaxf(mx, __shfl_xor(mx, 32));
    const float mnew = fmaxf(m, mx);
    const float alpha = exp2f(m - mnew);
    m = mnew;
    float ps = 0.f;
    h16x8 pb[2];
#pragma unroll
    for (int kf = 0; kf < 4; kf++)
#pragma unroll
      for (int j = 0; j < 4; j++) {
        float pv = exp2f(s[kf][j] - mnew);
        ps += pv;
        pb[kf >> 1][(kf & 1) * 4 + j] = (h16)pv;
      }
    lsum = lsum * alpha + ps;
#pragma unroll
    for (int df = 0; df < 4; df++) {
      o[df] = o[df] * alpha;
#pragma unroll
      for (int kk = 0; kk < 2; kk++) {
        const int row = df * 16 + l15;
        const int c0 = 8 * kk + g, c1 = 8 * kk + 4 + g;
        h16x4 v0 = *(const h16x4*)(sv + SWZ(row, c0 >> 1) + (c0 & 1) * 8);
        h16x4 v1 = *(const h16x4*)(sv + SWZ(row, c1 >> 1) + (c1 & 1) * 8);
        h16x8 va = {v0[0], v0[1], v0[2], v0[3], v1[0], v1[1], v1[2], v1[3]};
        o[df] = __builtin_amdgcn_mfma_f32_16x16x32_f16(va, pb[kk], o[df], 0, 0, 0);
      }
    }
    if (more) {
      char* wk = smem + ((ti + 1) & 1) * STAGE; char* wv = wk + KBYTES;
#pragma unroll
      for (int i = 0; i < KPT; i++) { int c = tid + i * 256; int row = c / KCH, sl = c % KCH; int off = (DQK == 64) ? SWZ(row, sl) : (row * KROWB + sl * 16); *(u32x4*)(wk + off) = rk[i]; }
#pragma unroll
      for (int i = 0; i < 2; i++) { int c = tid + i * 256; int row = c >> 3, sl = c & 7; *(u32x4*)(wv + SWZ(row, sl)) = rv[i]; }
    }
    __syncthreads();
  }
  lsum += __shfl_xor(lsum, 16);
  lsum += __shfl_xor(lsum, 32);
  const float inv = 1.f / lsum;
  const int qr = wid * 16 + l15;
#pragma unroll
  for (int df = 0; df < 4; df++) {
    const int d = df * 16 + 4 * g;
    h16x4 gv = *(const h16x4*)(gate + (size_t)qr * ZLD + d);
    store_h4(outp + (size_t)qr * 1024 + d, o[df][0] * inv * siluf_((float)gv[0]), o[df][1] * inv * siluf_((float)gv[1]),
             o[df][2] * inv * siluf_((float)gv[2]), o[df][3] * inv * siluf_((float)gv[3]));
  }
}

__device__ void phase_att(const Params p, int layer, char* smem) {
  const float sc64 = 0.125f * LOG2E, sc96 = 0.10206207261596575f * LOG2E;
  Seg s0, s1;
  for (int idx = blockIdx.x; idx < 512; idx += gridDim.x) s5_item(p, layer, 2, idx >> 7, (idx >> 3) & 15, idx & 7, smem);
  for (int it = blockIdx.x; it < 1024; it += gridDim.x) {
    const bool lat = it < 512;
    const int idx = it & 511;
    int b, h, tokb, tok0;
    if (lat) { b = idx >> 7; h = (idx >> 5) & 3; tokb = T_CTX + b * 2048; tok0 = tokb + (idx & 31) * 64; }
    else { b = idx >> 4; h = (idx >> 2) & 3; tokb = b * 256; tok0 = tokb + (idx & 3) * 64; }
    s0.K = p.kmla + (size_t)tokb * 384 + h * 96; s0.ldk = 384;
    if (lat) {
      s0.Vt = p.vt_m_lat + (size_t)(b * 4 + h) * 64 * 2048; s0.ldv = 2048; s0.ntiles = 32;
      s1.K = p.kcx + (size_t)(b * 512) * 384 + h * 96; s1.ldk = 384; s1.Vt = p.vcx_t + (size_t)(b * 4 + h) * 64 * 512; s1.ldv = 512; s1.ntiles = 8;
    } else {
      s0.Vt = p.vt_m_ctx + (size_t)(b * 4 + h) * 64 * 256; s0.ldv = 256; s0.ntiles = 4;
      s1.K = s0.K; s1.Vt = s0.Vt; s1.ldk = 0; s1.ldv = 0; s1.ntiles = 0;
    }
    attn_item<96, 0>(p.qm + (size_t)tok0 * 384 + h * 96, 384, s0, s1, sc96, false, 0.f, 0, 0, nullptr, 0, 0,
                     p.br + (size_t)tok0 * 1024 + 256 + h * 64, p.zbuf + (size_t)tok0 * ZLD + 1184 + h * 64, smem);
  }
  for (int idx = blockIdx.x; idx < 512; idx += gridDim.x) {
    const int b = idx >> 7, h = (idx >> 5) & 3, qt = idx & 31;
    const int tokb = T_CTX + b * 2048, tok0 = tokb + qt * 64;
    const int r = qt, rs = min(max(r - 4, 0), 24);
    s0.K = p.zbuf + (size_t)(tokb + rs * 64) * ZLD + 2208 + h * 64; s0.ldk = ZLD; s0.Vt = p.vt_d_lat + (size_t)(b * 4 + h) * 64 * 2048 + rs * 64; s0.ldv = 2048; s0.ntiles = 8;
    s1.K = p.ck_n + (size_t)((b * 2 + layer) * 512) * 256 + h * 64; s1.ldk = 256; s1.Vt = p.cvt_n + (size_t)((b * 2 + layer) * 4 + h) * 64 * 512; s1.ldv = 512; s1.ntiles = 8;
    attn_item<64, 2>(p.zbuf + (size_t)tok0 * ZLD + 1952 + h * 64, ZLD, s0, s1, sc64, false, 0.f, 0, 0,
                     p.na_rpb + (size_t)(layer * 4 + h) * 15 * 31, r, rs,
                     p.br + (size_t)tok0 * 1024 + 768 + h * 64, p.zbuf + (size_t)tok0 * ZLD + 2720 + h * 64, smem);
  }
  for (int idx = blockIdx.x; idx < 512; idx += gridDim.x) {
    const int b = idx >> 7, h = (idx >> 5) & 3, qt = idx & 31;
    const int tokb = T_CTX + b * 2048, tok0 = tokb + qt * 64;
    const int hk = h >> 1, q0 = qt * 64;
    const int ks = max(0, q0 - 128), ke = min(2048, q0 + 192);
    s0.K = p.zbuf + (size_t)(tokb + ks) * ZLD + 256 + hk * 64; s0.ldk = ZLD; s0.Vt = p.vt_a_lat + (size_t)(b * 2 + hk) * 64 * 2048 + ks; s0.ldv = 2048; s0.ntiles = (ke - ks) >> 6;
    s1.K = p.ck_a + (size_t)((b * 2 + layer) * 512) * 128 + hk * 64; s1.ldk = 128; s1.Vt = p.cvt_a + (size_t)((b * 2 + layer) * 2 + hk) * 64 * 512; s1.ldv = 512; s1.ntiles = 8;
    attn_item<64, 1>(p.zbuf + (size_t)tok0 * ZLD + h * 64, ZLD, s0, s1, sc64, true, p.a_sink[layer * 4 + h] * LOG2E, q0, ks, nullptr, 0, 0,
                     p.br + (size_t)tok0 * 1024 + h * 64, p.zbuf + (size_t)tok0 * ZLD + 512 + h * 64, smem);
  }
  for (int it = blockIdx.x; it < 1024; it += gridDim.x) {
    const bool isA = it < 512;
    const int idx = it & 511;
    const int b = idx >> 4, h = (idx >> 2) & 3, qt = idx & 3;
    const int tokb = b * 256, tok0 = tokb + qt * 64;
    int qcol, kcol, gcol, bcol;
    if (isA) { const int hk = h >> 1; qcol = h * 64; kcol = 256 + hk * 64; gcol = 512 + h * 64; bcol = h * 64; s0.Vt = p.vt_a_ctx + (size_t)(b * 2 + hk) * 64 * 256; }
    else { qcol = 1952 + h * 64; kcol = 2208 + h * 64; gcol = 2720 + h * 64; bcol = 768 + h * 64; s0.Vt = p.vt_d_ctx + (size_t)(b * 4 + h) * 64 * 256; }
    s0.K = p.zbuf + (size_t)tokb * ZLD + kcol; s0.ldk = ZLD; s0.ldv = 256; s0.ntiles = 4;
    s1.K = s0.K; s1.Vt = s0.Vt; s1.ldk = 0; s1.ldv = 0; s1.ntiles = 0;
    const float sink = isA ? p.a_sink[layer * 4 + h] * LOG2E : 0.f;
    attn_item<64, 0>(p.zbuf + (size_t)tok0 * ZLD + qcol, ZLD, s0, s1, sc64, isA, sink, 0, 0, nullptr, 0, 0,
                     p.br + (size_t)tok0 * 1024 + bcol, p.zbuf + (size_t)tok0 * ZLD + gcol, smem);
  }
}

__device__ void phase_glu(const Params p, int layer, char* smem) {
  const int lane = threadIdx.x & 63, wid = threadIdx.x >> 6, wr = wid >> 1, wc = wid & 1, l15 = lane & 15, g = lane >> 4;
  for (int tile = blockIdx.x; tile < 128 * 8; tile += gridDim.x) {
    const int rt = tile >> 3, ct = tile & 7, r0 = rt * 128, n0 = ct * 64;
    f32x4 acc[4][2];
    zero_acc(acc);
    gemm_acc<128, 64>(acc, p.zbuf + (size_t)r0 * ZLD + 1440, ZLD, p.wt_glu + (size_t)layer * 512 * 256 + (size_t)n0 * 256, 256, 256, smem);
#pragma unroll
    for (int mi = 0; mi < 4; mi++) {
      const int tok = r0 + wr * 64 + mi * 16 + l15;
#pragma unroll
      for (int np = 0; np < 1; np++) {
        const int pn = n0 + wc * 32 + np * 32;
        const int col = (pn >> 5) * 16 + 4 * g;
        f32x4 val = acc[mi][np * 2], gt = acc[mi][np * 2 + 1];
        h16x4 cg_ = *(const h16x4*)(p.zbuf + (size_t)tok * ZLD + 1696 + col);
        store_h4(p.br + (size_t)tok * 1024 + 512 + col, val[0] * sigmoidf_(gt[0]) * siluf_((float)cg_[0]),
                 val[1] * sigmoidf_(gt[1]) * siluf_((float)cg_[1]), val[2] * sigmoidf_(gt[2]) * siluf_((float)cg_[2]),
                 val[3] * sigmoidf_(gt[3]) * siluf_((float)cg_[3]));
      }
    }
  }
}

__device__ void phase_g3(const Params p, int layer, char* smem) {
  const int lane = threadIdx.x & 63, wid = threadIdx.x >> 6, wr = wid >> 1, wc = wid & 1, l15 = lane & 15, g = lane >> 4;
  const h16* Wm = p.wt_merge + (size_t)layer * 4096 * 1024;
  const h16* Wb = p.wt_branch + (size_t)layer * 4 * 1024 * 256;
  h16* mbuf = p.zbuf;
  for (int tile = blockIdx.x; tile < 128 * 16; tile += gridDim.x) {
    const int rt = tile >> 4, ct = tile & 15, r0 = rt * 128, d0 = ct * 64;
    f32x4 macc[4][2];
    zero_acc(macc);
    for (int k = 0; k < 4; k++) {
      f32x4 a1[4][2], a2[4][2];
      zero_acc(a1);
      zero_acc(a2);
      gemm_acc<128, 64>(a1, p.hbuf + (size_t)r0 * 1024, 1024, Wm + (size_t)(k * 1024 + d0) * 1024, 1024, 1024, smem);
      gemm_acc<128, 64>(a2, p.br + (size_t)r0 * 1024 + k * 256, 1024, Wb + (size_t)(k * 1024 + d0) * 256, 256, 256, smem);
#pragma unroll
      for (int mi = 0; mi < 4; mi++)
#pragma unroll
        for (int ni = 0; ni < 2; ni++)
#pragma unroll
          for (int j = 0; j < 4; j++) macc[mi][ni][j] += sigmoidf_(a1[mi][ni][j]) * a2[mi][ni][j];
    }
#pragma unroll
    for (int mi = 0; mi < 4; mi++)
#pragma unroll
      for (int ni = 0; ni < 2; ni++) {
        const int tok = r0 + wr * 64 + mi * 16 + l15, col = d0 + wc * 32 + ni * 16 + 4 * g;
        f32x4 v = macc[mi][ni];
        store_h4(mbuf + (size_t)tok * 1024 + col, v[0], v[1], v[2], v[3]);
      }
  }
}

__device__ void phase_g4(const Params p, int layer, char* smem) {
  const int lane = threadIdx.x & 63, wid = threadIdx.x >> 6, wr = wid >> 1, wc = wid & 1, l15 = lane & 15, g = lane >> 4;
  const h16* Wo = p.wt_out + (size_t)layer * 1048576;
  const h16* mbuf = p.zbuf;
  for (int tile = blockIdx.x; tile < 128 * 8; tile += gridDim.x) {
    const int rt = tile >> 3, ct = tile & 7, r0 = rt * 128, n0 = ct * 128;
    f32x4 acc[4][4];
    zero_acc(acc);
    gemm_acc<128, 128>(acc, mbuf + (size_t)r0 * 1024, 1024, Wo + (size_t)n0 * 1024, 1024, 1024, smem);
#pragma unroll
    for (int mi = 0; mi < 4; mi++) {
      const int tok = r0 + wr * 64 + mi * 16 + l15;
      const float* xo = xptr(p, layer, tok);
      const float* gt = p.modv + (layer * 5 + cond_of(tok)) * 3072 + 2048;
#pragma unroll
      for (int ni = 0; ni < 4; ni++) {
        const int col = n0 + wc * 64 + ni * 16 + 4 * g;
        float4 xv = *(const float4*)(xo + col), gv = *(const float4*)(gt + col);
        f32x4 v = acc[mi][ni];
        *(float4*)(p.out + (size_t)tok * 1024 + col) = make_float4(xv.x + gv.x * v[0], xv.y + gv.y * v[1], xv.z + gv.z * v[2], xv.w + gv.w * v[3]);
      }
    }
  }
}


#define XB_TMO      128
#define XB_XCNT(j)  (256  + 64 * (j))
#define XB_XSUB(j)  (1280 + 64 * (j))
#define XB_XGEN(j)  (2304 + 64 * (j))
#define XB_TOP      3328
#define XB_TOPGEN   3392
#define XCD_BAR_WORDS 3456
#define XB_SPIN_CAP (1u << 20)
__device__ __forceinline__ unsigned xb_ld(unsigned* p) { return __hip_atomic_load(p, __ATOMIC_RELAXED, __HIP_MEMORY_SCOPE_AGENT); }
__device__ __forceinline__ unsigned xb_add(unsigned* p, unsigned v) { return __hip_atomic_fetch_add(p, v, __ATOMIC_RELAXED, __HIP_MEMORY_SCOPE_AGENT); }
__device__ __forceinline__ unsigned xb_xcc_id() { return (unsigned)__builtin_amdgcn_s_getreg((3 << 11) | 20) & 0xFu; }
#define XB_SPIN(cond, bar) do { unsigned _sp = 0; while (cond) { __builtin_amdgcn_s_sleep(1); \
    if ((++_sp & 255u) == 0u) { if (xb_ld(&(bar)[XB_TMO])) break; if (_sp > XB_SPIN_CAP) { atomicAdd(&(bar)[XB_TMO], 1u); break; } } } } while (0)
struct XB { unsigned* bar; unsigned x, nloc, nx; };
__device__ __forceinline__ void xb_post(XB& b, unsigned* bar) {
  b.bar = bar; b.x = xb_xcc_id(); b.nloc = 0u; b.nx = 0u;
  if (threadIdx.x == 0) (void)xb_add(&bar[XB_XCNT(b.x)], 1u);
}
__device__ __forceinline__ void xb_complete(unsigned* bar, unsigned x, unsigned& nloc, unsigned& nx) {
  const unsigned G = gridDim.x;
  unsigned sum, cnt, mine, sp = 0u;
  for (;;) {
    sum = 0u; cnt = 0u; mine = 0u;
#pragma unroll
    for (unsigned j = 0; j < 16; ++j) { const unsigned c = xb_ld(&bar[XB_XCNT(j)]); sum += c; cnt += (c > 0u) ? 1u : 0u; mine = (j == x) ? c : mine; }
    if (sum == G) break;
    __builtin_amdgcn_s_sleep(1);
    if ((++sp & 255u) == 0u) { if (xb_ld(&bar[XB_TMO])) break; if (sp > XB_SPIN_CAP) { atomicAdd(&bar[XB_TMO], 1u); break; } }
  }
  nloc = mine > 0u ? mine : 1u; nx = cnt > 0u ? cnt : 1u;
}
__device__ __forceinline__ void xb_sync(XB& b) {
  asm volatile("s_waitcnt vmcnt(0)" ::: "memory");
  __syncthreads();
  if (threadIdx.x == 0) {
    unsigned* bar = b.bar;
    __builtin_amdgcn_s_waitcnt(0);
    if (b.nloc == 0u) xb_complete(bar, b.x, b.nloc, b.nx);
    const unsigned nloc = b.nloc, nx = b.nx;
    const unsigned old = xb_add(&bar[XB_XSUB(b.x)], 1u);
    const unsigned gen = old / nloc;
    if (old + 1u == (gen + 1u) * nloc) {
      __builtin_amdgcn_fence(__ATOMIC_RELEASE, "agent");
      asm volatile("s_waitcnt vmcnt(0)" ::: "memory");
      const unsigned og = xb_add(&bar[XB_TOP], 1u);
      const unsigned tg = og / nx;
      if (og + 1u == (tg + 1u) * nx) xb_add(&bar[XB_TOPGEN], 1u);
      else XB_SPIN(xb_ld(&bar[XB_TOPGEN]) == tg, bar);
      __builtin_amdgcn_fence(__ATOMIC_ACQUIRE, "agent");
      xb_add(&bar[XB_XGEN(b.x)], 1u);
      asm volatile("s_waitcnt vmcnt(0)" ::: "memory");
    } else {
      XB_SPIN(xb_ld(&bar[XB_XGEN(b.x)]) == gen, bar);
      __builtin_amdgcn_fence(__ATOMIC_ACQUIRE, "agent");
      asm volatile("s_waitcnt vmcnt(0)" ::: "memory");
    }
  }
  __syncthreads();
}

#define N_PHASES 16
template <int PH>
__device__ __forceinline__ void run_phase(const Params p, char* smem) {
  if constexpr (PH == 0) phase_prep(p, smem);
  else if constexpr (PH == 15) phase_final(p);
  else {
    constexpr int layer = (PH - 1) / 7, s = (PH - 1) % 7;
    if constexpr (s == 0) phase_norm(p, layer);
    else if constexpr (s == 1) phase_g1(p, layer, smem);
    else if constexpr (s == 2) phase_g2(p, layer, smem);
    else if constexpr (s == 3) phase_att(p, layer, smem);
    else if constexpr (s == 4) phase_glu(p, layer, smem);
    else if constexpr (s == 5) phase_g3(p, layer, smem);
    else phase_g4(p, layer, smem);
  }
}

template <int PH>
__global__ void __launch_bounds__(256, 2) phase_kernel(Params p) {
  __shared__ __attribute__((aligned(16))) char smem[65536];
  run_phase<PH>(p, smem);
}

#ifndef MULTI_LAUNCH
template <int PH>
__device__ __forceinline__ void run_from(const Params p, char* smem, XB& xb) {
  run_phase<PH>(p, smem);
  if constexpr (PH + 1 < N_PHASES) {
    if constexpr (PH == 0) cg::this_grid().sync();
    else xb_sync(xb);
    run_from<PH + 1>(p, smem, xb);
  }
}

__global__ void __launch_bounds__(256, 2) mega(Params p) {
  __shared__ __attribute__((aligned(16))) char smem[65536];
  XB xb;
  xb_post(xb, p.bar);
  run_from<0>(p, smem, xb);
}
#endif

template <int PH>
static void launch_phases(const Params p, int grid, hipStream_t stream) {
  hipLaunchKernelGGL(phase_kernel<PH>, dim3(grid), dim3(256), 0, stream, p);
  if constexpr (PH + 1 < N_PHASES) launch_phases<PH + 1>(p, grid, stream);
}

static inline size_t al256(size_t x) { return (x + 255) & ~(size_t)255; }

extern "C" void kernel_launch(void* const* d_in, const int* in_sizes, int n_in, void* d_out, int out_size, void* d_ws,
                              size_t ws_size, hipStream_t stream) {
  Params p{};
  const float** ip = (const float**)&p;
  for (int i = 0; i < 35; i++) ip[i] = (const float*)d_in[i];
  p.out = (float*)d_out;
  char* w = (char*)d_ws;
  size_t off = 0;
  auto take = [&](size_t bytes) { char* r = w + off; off = al256(off + bytes); return r; };
  p.wt_in = (h16*)take((size_t)2 * 3072 * 1024 * 2);
  p.wt_merge = (h16*)take((size_t)2 * 4096 * 1024 * 2);
  p.wt_branch = (h16*)take((size_t)2 * 4 * 1024 * 256 * 2);
  p.wt_out = (h16*)take((size_t)2 * 1024 * 1024 * 2);
  p.wt_qup = (h16*)take((size_t)2 * 384 * 256 * 2);
  p.wt_kvup = (h16*)take((size_t)2 * 512 * 128 * 2);
  p.wt_kvraw = (h16*)take((size_t)2 * 512 * 128 * 2);
  p.wt_glu = (h16*)take((size_t)2 * 512 * 256 * 2);
  p.hbuf = (h16*)take((size_t)T_ALL * 1024 * 2);
  p.zbuf = (h16*)take((size_t)T_ALL * ZLD * 2);
  p.br = (h16*)take((size_t)T_ALL * 1024 * 2);
  p.qm = (h16*)take((size_t)T_ALL * 384 * 2);
  p.kmla = (h16*)take((size_t)T_ALL * 384 * 2);
  p.kcx = (h16*)take((size_t)2048 * 384 * 2);
  p.vt_a_ctx = (h16*)take((size_t)32 * 2 * 64 * 256 * 2);
  p.vt_a_lat = (h16*)take((size_t)4 * 2 * 64 * 2048 * 2);
  p.vt_d_ctx = (h16*)take((size_t)32 * 4 * 64 * 256 * 2);
  p.vt_d_lat = (h16*)take((size_t)4 * 4 * 64 * 2048 * 2);
  p.vt_m_ctx = (h16*)take((size_t)32 * 4 * 64 * 256 * 2);
  p.vt_m_lat = (h16*)take((size_t)4 * 4 * 64 * 2048 * 2);
  p.vcx_t = (h16*)take((size_t)4 * 4 * 64 * 512 * 2);
  p.ck_a = (h16*)take((size_t)524288 * 2);
  p.cvt_a = (h16*)take((size_t)524288 * 2);
  p.ck_n = (h16*)take((size_t)1048576 * 2);
  p.cvt_n = (h16*)take((size_t)1048576 * 2);
  p.ckv_c = (h16*)take((size_t)524288 * 2);
  p.s5_bmt = (h16*)take((size_t)64 * 128 * 16 * 2);
  p.s5_cmt = (h16*)take((size_t)64 * 16 * 128 * 2);
  p.s5_abar = (float*)take(4096 * 2 * 4);
  p.s5_lamdt = (float*)take(4096 * 2 * 4);
  p.s5_dt = (float*)take(64 * 4);
  p.s5_e = (float*)take((size_t)4 * 16 * 2 * 8 * 128 * 4);
  p.modv = (float*)take(2 * 5 * 3072 * 4);
  p.cs16 = (float*)take(64 * 16 * 2 * 4);
  p.cs8 = (float*)take(64 * 8 * 2 * 4);
  p.bar = (unsigned*)take(XCD_BAR_WORDS * 4);
  if (off > ws_size) { fprintf(stderr, "workspace too small: need %zu have %zu\n", off, ws_size); return; }

  static int grid_blocks = 0;
  if (!grid_blocks) {
    int dev = 0, cus = 0, per_cu = 0;
    (void)hipGetDevice(&dev);
    (void)hipDeviceGetAttribute(&cus, hipDeviceAttributeMultiprocessorCount, dev);
    #ifdef MULTI_LAUNCH
    (void)hipOccupancyMaxActiveBlocksPerMultiprocessor(&per_cu, phase_kernel<3>, 256, 0);
#else
    (void)hipOccupancyMaxActiveBlocksPerMultiprocessor(&per_cu, mega, 256, 0);
#endif
    if (per_cu > 2) per_cu = 2;
    if (per_cu < 1) per_cu = 1;
    grid_blocks = cus * per_cu;
  }
#ifdef MULTI_LAUNCH
  launch_phases<0>(p, grid_blocks, stream);
#else
  (void)hipMemsetAsync(p.bar, 0, XCD_BAR_WORDS * 4, stream);
  void* args[] = {&p};
  hipError_t e = hipLaunchCooperativeKernel((void*)mega, dim3(grid_blocks), dim3(256), args, 0, stream);
  if (e != hipSuccess) fprintf(stderr, "cooperative launch failed: %s (grid %d)\n", hipGetErrorString(e), grid_blocks);
#endif
}
```

```cpp
#include <hip/hip_runtime.h>
#include <hip/hip_cooperative_groups.h>
#include <cstdio>
#include <cstdint>
namespace cg = cooperative_groups;

typedef _Float16 h16;
typedef __attribute__((ext_vector_type(8))) _Float16 h16x8;
typedef __attribute__((ext_vector_type(4))) _Float16 h16x4;
typedef __attribute__((ext_vector_type(4))) float f32x4;
typedef __attribute__((ext_vector_type(4))) unsigned int u32x4;

#define T_ALL 16384
#define T_CTX 8192
#define ZLD 2976
#define LOG2E 1.4426950408889634f

#define O_AK   16777216
#define O_AV   18874368
#define O_CKV  20971520
#define O_KPE  23068672
#define O_NK   23592960
#define O_NV   27787264
#define O_SRE  31981568
#define O_SIM  32112640

struct Params {
  const float *x_prompt, *x_sample, *cache_a_k, *cache_a_v, *cache_mla_ckv, *cache_mla_kpe, *cache_na_k, *cache_na_v,
      *state_re, *state_im, *c, *c_ctx, *w_mod, *b_mod, *norm_g, *w_in, *w_merge, *a_sink, *mla_q_norm, *mla_w_q_up,
      *mla_kv_norm, *mla_w_kv_up, *s5_lam_re, *s5_lam_im, *s5_log_dt, *s5_b_re, *s5_b_im, *s5_c_re, *s5_c_im, *s5_d,
      *s5_w_glu, *na_rpb, *w_branch, *w_out, *final_norm_g;
  float* out;
  h16 *wt_in, *wt_merge, *wt_branch, *wt_out, *wt_qup, *wt_kvup, *wt_kvraw, *wt_glu;
  h16 *hbuf, *zbuf, *br, *qm, *kmla, *kcx, *vt_a_ctx, *vt_a_lat, *vt_d_ctx, *vt_d_lat, *vt_m_ctx, *vt_m_lat, *vcx_t,
      *ck_a, *cvt_a, *ck_n, *cvt_n, *ckv_c, *s5_bmt, *s5_cmt;
  float *s5_abar, *s5_lamdt, *s5_dt, *s5_e, *modv, *cs16, *cs8;
  unsigned* bar;
};


__device__ __forceinline__ int otid() { int t = __builtin_amdgcn_workitem_id_x(); asm volatile("" : "+v"(t)); return t; }
__device__ __forceinline__ float sigmoidf_(float x) { return 1.f / (1.f + __expf(-x)); }
__device__ __forceinline__ float siluf_(float x) { return x * sigmoidf_(x); }
__device__ __forceinline__ float geluf_(float x) {
  float u = 0.7978845608028654f * (x + 0.044715f * x * x * x);
  return x / (1.f + __expf(-2.f * u));
}
__device__ __forceinline__ float wave_sum(float v) {
#pragma unroll
  for (int o = 32; o > 0; o >>= 1) v += __shfl_xor(v, o);
  return v;
}
__device__ __forceinline__ const float* xptr(const Params p, int layer, int tok) {
  if (layer == 0) return tok < T_CTX ? p.x_prompt + (size_t)tok * 1024 : p.x_sample + (size_t)(tok - T_CTX) * 1024;
  return p.out + (size_t)tok * 1024;
}
__device__ __forceinline__ int cond_of(int tok) { return tok < T_CTX ? 0 : 1 + ((tok - T_CTX) >> 11); }

#define SWZ(row, slot) (((row) << 7) + ((((slot) ^ (((row) >> 1) & 7))) << 4))

template <int BM, int BN, bool LOWREG = false>
__device__ __forceinline__ void gemm_acc(f32x4 (&acc)[BM / 32][BN / 32], const h16* __restrict__ A, int lda,
                                         const h16* __restrict__ Bt, int ldb, int K, char* smem) {
  constexpr int MREP = BM / 32, NREP = BN / 32;
  constexpr int ACH = BM * 8 / 256, BCH = BN * 8 / 256;
  constexpr int ABYTES = BM * 128, STAGE = (BM + BN) * 128;
  const int tid = otid(), lane = tid & 63, wid = tid >> 6;
  const int wr = wid >> 1, wc = wid & 1;
  const int l15 = lane & 15, g = lane >> 4;
  const int nk = K >> 6;
  const int ls = (tid & 7) ^ ((tid >> 4) & 7);
  const h16* Ap = A + (size_t)(tid >> 3) * lda + ls * 8;
  const h16* Bp = Bt + (size_t)(tid >> 3) * ldb + ls * 8;
  char* dstA = smem + tid * 16;
  char* dstB = smem + ABYTES + tid * 16;
#pragma unroll
  for (int i = 0; i < ACH; i++)
    __builtin_amdgcn_global_load_lds((const unsigned*)(Ap + (size_t)(i * 32) * lda), (__attribute__((address_space(3))) unsigned*)(dstA + i * 4096), 16, 0, 0);
#pragma unroll
  for (int i = 0; i < BCH; i++)
    __builtin_amdgcn_global_load_lds((const unsigned*)(Bp + (size_t)(i * 32) * ldb), (__attribute__((address_space(3))) unsigned*)(dstB + i * 4096), 16, 0, 0);
  for (int kt = 0; kt < nk; kt++) {
    asm volatile("s_waitcnt vmcnt(0)" ::: "memory");
    __syncthreads();
    if (kt + 1 < nk) {
      const int nb = ((kt + 1) & 1) * STAGE;
#pragma unroll
      for (int i = 0; i < ACH; i++)
        __builtin_amdgcn_global_load_lds((const unsigned*)(Ap + (size_t)(i * 32) * lda + (kt + 1) * 64), (__attribute__((address_space(3))) unsigned*)(dstA + nb + i * 4096), 16, 0, 0);
#pragma unroll
      for (int i = 0; i < BCH; i++)
        __builtin_amdgcn_global_load_lds((const unsigned*)(Bp + (size_t)(i * 32) * ldb + (kt + 1) * 64), (__attribute__((address_space(3))) unsigned*)(dstB + nb + i * 4096), 16, 0, 0);
    }
    const char* sa = smem + (kt & 1) * STAGE;
    const char* sb = sa + ABYTES;
    if (!LOWREG) {
      h16x8 af[2][MREP], bf[2][NREP];
#pragma unroll
      for (int ks = 0; ks < 2; ks++) {
#pragma unroll
        for (int mi = 0; mi < MREP; mi++) af[ks][mi] = *(const h16x8*)(sa + SWZ(wr * (BM / 2) + mi * 16 + l15, ks * 4 + g));
#pragma unroll
        for (int ni = 0; ni < NREP; ni++) bf[ks][ni] = *(const h16x8*)(sb + SWZ(wc * (BN / 2) + ni * 16 + l15, ks * 4 + g));
      }
      __builtin_amdgcn_sched_barrier(0);
#pragma unroll
      for (int ks = 0; ks < 2; ks++)
#pragma unroll
        for (int mi = 0; mi < MREP; mi++)
#pragma unroll
          for (int ni = 0; ni < NREP; ni++)
            acc[mi][ni] = __builtin_amdgcn_mfma_f32_16x16x32_f16(bf[ks][ni], af[ks][mi], acc[mi][ni], 0, 0, 0);
      __builtin_amdgcn_sched_barrier(0);
    } else {
#pragma unroll
      for (int ks = 0; ks < 2; ks++) {
        h16x8 af[MREP], bf[NREP];
#pragma unroll
        for (int mi = 0; mi < MREP; mi++) af[mi] = *(const h16x8*)(sa + SWZ(wr * (BM / 2) + mi * 16 + l15, ks * 4 + g));
#pragma unroll
        for (int ni = 0; ni < NREP; ni++) bf[ni] = *(const h16x8*)(sb + SWZ(wc * (BN / 2) + ni * 16 + l15, ks * 4 + g));
        __builtin_amdgcn_sched_barrier(0);
#pragma unroll
        for (int mi = 0; mi < MREP; mi++)
#pragma unroll
          for (int ni = 0; ni < NREP; ni++)
            acc[mi][ni] = __builtin_amdgcn_mfma_f32_16x16x32_f16(bf[ni], af[mi], acc[mi][ni], 0, 0, 0);
        __builtin_amdgcn_sched_barrier(0);
      }
    }
  }
  __syncthreads();
}

__device__ __forceinline__ bool xcd_tile(int i, int RT, int CT, int& rt, int& ct) {
  const int nbx = gridDim.x >> 3, x = blockIdx.x & 7, j = blockIdx.x >> 3;
  const int RTL = RT >> 3;
  const int L = i * nbx + j;
  if (L >= RTL * CT) return false;
  if ((CT & 7) == 0 && (RTL & 7) == 0) {
    const int gi = L >> 6, w = L & 63, nrg = RTL >> 3;
    rt = x * RTL + (gi % nrg) * 8 + (w >> 3);
    ct = (gi / nrg) * 8 + (w & 7);
  } else {
    rt = x * RTL + L / CT;
    ct = L % CT;
  }
  return true;
}

template <int M, int N>
__device__ __forceinline__ void zero_acc(f32x4 (&a)[M][N]) {
#pragma unroll
  for (int i = 0; i < M; i++)
#pragma unroll
    for (int j = 0; j < N; j++) a[i][j] = f32x4{0.f, 0.f, 0.f, 0.f};
}

__device__ __forceinline__ void store_h4(h16* dst, float a, float b, float c, float d) {
  h16x4 v = {(h16)a, (h16)b, (h16)c, (h16)d};
  *(h16x4*)dst = v;
}

__device__ void tr_tile(const float* __restrict__ src, int lds_, h16* __restrict__ dst, int ldd, int k0, int n0, int N,
                        char* smem) {
  float* tile = (float*)smem;
  const int tid = otid();
  const int r = tid >> 4, c4 = tid & 15;
#pragma unroll
  for (int rr = 0; rr < 4; rr++) {
    int kl = r + rr * 16;
    int n = n0 + c4 * 4;
    float4 v = make_float4(0.f, 0.f, 0.f, 0.f);
    if (n < N) v = *(const float4*)(src + (size_t)(k0 + kl) * lds_ + n);
    tile[kl * 65 + c4 * 4 + 0] = v.x;
    tile[kl * 65 + c4 * 4 + 1] = v.y;
    tile[kl * 65 + c4 * 4 + 2] = v.z;
    tile[kl * 65 + c4 * 4 + 3] = v.w;
  }
  __syncthreads();
  const int nl = tid >> 2, kq = tid & 3;
  h16x8 o0, o1;
#pragma unroll
  for (int i = 0; i < 8; i++) {
    o0[i] = (h16)tile[(kq * 16 + i) * 65 + nl];
    o1[i] = (h16)tile[(kq * 16 + 8 + i) * 65 + nl];
  }
  h16* d = dst + (size_t)(n0 + nl) * ldd + k0 + kq * 16;
  *(h16x8*)d = o0;
  *(h16x8*)(d + 8) = o1;
  __syncthreads();
}

__device__ void phase_prep(const Params p, char* smem) {
  const int tid = otid();
  const size_t gtid = (size_t)blockIdx.x * 256 + tid, gsz = (size_t)gridDim.x * 256;
  for (size_t i = gtid; i < 2 * 384 * 256; i += gsz) {
    int l = i / (384 * 256), r = i % (384 * 256), n = r / 256, k = r % 256;
    p.wt_qup[i] = (h16)(p.mla_q_norm[l * 256 + k] * p.mla_w_q_up[(size_t)l * 256 * 384 + k * 384 + n]);
  }
  for (size_t i = gtid; i < 2 * 512 * 128; i += gsz) {
    int l = i / (512 * 128), r = i % (512 * 128), n = r / 128, k = r % 128;
    float w = p.mla_w_kv_up[(size_t)l * 128 * 512 + k * 512 + n];
    p.wt_kvraw[i] = (h16)w;
    p.wt_kvup[i] = (h16)(w * p.mla_kv_norm[l * 128 + k]);
  }
  for (size_t i = gtid; i < 2 * 512 * 256; i += gsz) {
    int l = i / (512 * 256), r = i % (512 * 256), n = r / 256, k = r % 256;
    int q = n >> 5, w = n & 31;
    int orig = (w < 16) ? (q * 16 + w) : (256 + q * 16 + (w - 16));
    p.wt_glu[i] = (h16)p.s5_w_glu[(size_t)l * 256 * 512 + k * 512 + orig];
  }
  for (size_t i = gtid; i < 262144; i += gsz) {
    const float* src; h16* dst; size_t e;
    if (i < 65536) { src = p.cache_a_k; dst = p.ck_a; e = i * 8; }
    else if (i < 131072) { src = p.cache_mla_ckv; dst = p.ckv_c; e = (i - 65536) * 8; }
    else { src = p.cache_na_k; dst = p.ck_n; e = (i - 131072) * 8; }
    const f32x4 a = __builtin_nontemporal_load((const f32x4*)(src + e)), b = __builtin_nontemporal_load((const f32x4*)(src + e + 4));
    h16x8 o = {(h16)a[0], (h16)a[1], (h16)a[2], (h16)a[3], (h16)b[0], (h16)b[1], (h16)b[2], (h16)b[3]};
    *(h16x8*)(dst + e) = o;
  }
  for (size_t ii = gtid; ii < 65536; ii += gsz) {
    const int i = ii >> 4, c = ii & 15;
    int ldg = i >> 6;
    float lr = fminf(p.s5_lam_re[i], -1e-4f), li = p.s5_lam_im[i];
    float dt = __expf(p.s5_log_dt[ldg]);
    float er = expf(lr * dt), sn, cs;
    sincosf(li * dt, &sn, &cs);
    float ar = er * cs, ai = er * sn;
    if (c == 0) {
      p.s5_abar[i * 2] = ar;
      p.s5_abar[i * 2 + 1] = ai;
      p.s5_lamdt[i * 2] = lr * dt;
      p.s5_lamdt[i * 2 + 1] = li * dt;
      if ((i & 63) == 0) p.s5_dt[ldg] = dt;
    }
    float nr = ar - 1.f, ni = ai, den = lr * lr + li * li;
    float cr = (nr * lr + ni * li) / den / dt, ci = (ni * lr - nr * li) / den / dt;
    int pp = i & 63;
    {
      float br_ = p.s5_b_re[(size_t)i * 16 + c], bi_ = p.s5_b_im[(size_t)i * 16 + c];
      p.s5_bmt[((size_t)ldg * 128 + pp) * 16 + c] = (h16)(cr * br_ - ci * bi_);
      p.s5_bmt[((size_t)ldg * 128 + 64 + pp) * 16 + c] = (h16)(cr * bi_ + ci * br_);
      p.s5_cmt[((size_t)ldg * 16 + c) * 128 + pp] = (h16)p.s5_c_re[((size_t)ldg * 16 + c) * 64 + pp];
      p.s5_cmt[((size_t)ldg * 16 + c) * 128 + 64 + pp] = (h16)(-p.s5_c_im[((size_t)ldg * 16 + c) * 64 + pp]);
    }
  }
  for (size_t i = gtid; i < 64 * 16; i += gsz) {
    int pos = i >> 4, k = i & 15;
    float inv = powf(10000.f, -(float)k / 16.f), sn, cs;
    sincosf((float)pos * inv, &sn, &cs);
    p.cs16[i * 2] = cs;
    p.cs16[i * 2 + 1] = sn;
  }
  for (size_t i = gtid; i < 64 * 8; i += gsz) {
    int pos = i >> 3, k = i & 7;
    float inv = powf(10000.f, -(float)k / 8.f), sn, cs;
    sincosf((float)pos * inv, &sn, &cs);
    p.cs8[i * 2] = cs;
    p.cs8[i * 2 + 1] = sn;
  }
  for (int it = blockIdx.x; it < 384; it += gridDim.x) {
    float* sc = (float*)smem;
    float* red = sc + 5 * 1024;
    const int layer = it / 192, col0 = (it % 192) * 16;
    for (int i = tid; i < 5120; i += 256) {
      int c = i >> 10, k = i & 1023;
      float v = (c == 0) ? p.c_ctx[k] : p.c[(c - 1) * 1024 + k];
      sc[i] = siluf_(v);
    }
    __syncthreads();
    const int cl = tid & 15, kg = tid >> 4;
    float a0 = 0, a1 = 0, a2 = 0, a3 = 0, a4 = 0;
    const float* w = p.w_mod + (size_t)layer * 1024 * 3072 + col0 + cl;
#pragma unroll 16
    for (int kk = 0; kk < 64; kk++) {
      int k = kg * 64 + kk;
      float wv = __builtin_nontemporal_load(w + (size_t)k * 3072);
      a0 += sc[k] * wv;
      a1 += sc[1024 + k] * wv;
      a2 += sc[2048 + k] * wv;
      a3 += sc[3072 + k] * wv;
      a4 += sc[4096 + k] * wv;
    }
    red[(kg * 5 + 0) * 16 + cl] = a0;
    red[(kg * 5 + 1) * 16 + cl] = a1;
    red[(kg * 5 + 2) * 16 + cl] = a2;
    red[(kg * 5 + 3) * 16 + cl] = a3;
    red[(kg * 5 + 4) * 16 + cl] = a4;
    __syncthreads();
    if (tid < 80) {
      int c = tid >> 4, cc = tid & 15;
      float s = 0;
      for (int q = 0; q < 16; q++) s += red[(q * 5 + c) * 16 + cc];
      p.modv[(layer * 5 + c) * 3072 + col0 + cc] = s + p.b_mod[layer * 3072 + col0 + cc];
    }
    __syncthreads();
  }
  {
    float* tl = (float*)smem;
    const int r = tid >> 4, c4 = tid & 15, nl = tid >> 2, kq = tid & 3;
    const float* src = nullptr; h16* dst = nullptr; int lds_ = 0, ldd = 0, N = 0, k0 = 0, n0 = 0;
    f32x4 v[4];
#define TR_DECODE(it_)                                                                                                  \
    {                                                                                                                   \
      int NT_, tile_;                                                                                                   \
      if ((it_) < 4608) {                                                                                               \
        const int l = (it_) / 2304, rr_ = (it_) % 2304;                                                                 \
        if (rr_ < 768) { src = p.w_in + (size_t)l * 1024 * 2976; lds_ = 2976; dst = p.wt_in + (size_t)l * 3072 * 1024; ldd = 1024; N = 2976; NT_ = 48; tile_ = rr_; } \
        else if (rr_ < 1792) { src = p.w_merge + (size_t)l * 1024 * 4096; lds_ = 4096; dst = p.wt_merge + (size_t)l * 4096 * 1024; ldd = 1024; N = 4096; NT_ = 64; tile_ = rr_ - 768; } \
        else if (rr_ < 2048) { const int k = (rr_ - 1792) >> 6; src = p.w_branch + (size_t)(l * 4 + k) * 256 * 1024; lds_ = 1024; dst = p.wt_branch + (size_t)(l * 4 + k) * 1024 * 256; ldd = 256; N = 1024; NT_ = 16; tile_ = (rr_ - 1792) & 63; } \
        else { src = p.w_out + (size_t)l * 1048576; lds_ = 1024; dst = p.wt_out + (size_t)l * 1048576; ldd = 1024; N = 1024; NT_ = 16; tile_ = rr_ - 2048; } \
      } else {                                                                                                          \
        int rr_ = (it_) - 4608;                                                                                         \
        if (rr_ < 128) { const int m = rr_ >> 4; src = p.cache_a_v + (size_t)m * 512 * 128; lds_ = 128; dst = p.cvt_a + (size_t)m * 128 * 512; ldd = 512; N = 128; NT_ = 2; tile_ = rr_ & 15; } \
        else { rr_ -= 128; const int m = rr_ >> 5; src = p.cache_na_v + (size_t)m * 512 * 256; lds_ = 256; dst = p.cvt_n + (size_t)m * 256 * 512; ldd = 512; N = 256; NT_ = 4; tile_ = rr_ & 31; } \
      }                                                                                                                 \
      k0 = (tile_ / NT_) * 64; n0 = (tile_ % NT_) * 64;                                                                 \
      _Pragma("unroll") for (int q = 0; q < 4; q++) {                                                                   \
        v[q] = f32x4{0.f, 0.f, 0.f, 0.f};                                                                               \
        if (n0 + c4 * 4 < N) v[q] = __builtin_nontemporal_load((const f32x4*)(src + (size_t)(k0 + r + q * 16) * lds_ + n0 + c4 * 4));              \
      }                                                                                                                 \
    }
    int it = blockIdx.x, tstride = gridDim.x, tend = 4992;
    if (gridDim.x == 512) {
      if (blockIdx.x < 384) { tstride = 384; tend = 2688; }
      else { it = 2688 + (blockIdx.x - 384); tstride = 128; }
    }
    if (it < tend) TR_DECODE(it)
    while (it < tend) {
#pragma unroll
      for (int q = 0; q < 4; q++) {
        const int kl = r + q * 16;
        tl[kl * 65 + c4 * 4 + 0] = v[q][0];
        tl[kl * 65 + c4 * 4 + 1] = v[q][1];
        tl[kl * 65 + c4 * 4 + 2] = v[q][2];
        tl[kl * 65 + c4 * 4 + 3] = v[q][3];
      }
      h16* d = dst + (size_t)(n0 + nl) * ldd + k0 + kq * 16;
      it += tstride;
      if (it < tend) TR_DECODE(it)
      __syncthreads();
      h16x8 o0, o1;
#pragma unroll
      for (int i = 0; i < 8; i++) {
        o0[i] = (h16)tl[(kq * 16 + i) * 65 + nl];
        o1[i] = (h16)tl[(kq * 16 + 8 + i) * 65 + nl];
      }
      *(h16x8*)d = o0;
      *(h16x8*)(d + 8) = o1;
      __syncthreads();
    }
  }
}

__device__ void phase_norm(const Params p, int layer) {
  const int lane = otid() & 63, wid = otid() >> 6;
  const float* g = p.norm_g + layer * 1024;
  const int stride = gridDim.x * 4;
  for (int row0 = blockIdx.x * 4 + wid; row0 < T_ALL; row0 += 2 * stride) {
    const int row1 = row0 + stride;
    const bool has1 = row1 < T_ALL;
    const int r1 = has1 ? row1 : row0;
    const float* x0 = xptr(p, layer, row0);
    const float* x1 = xptr(p, layer, r1);
    f32x4 v0[4], v1[4];
    float s0 = 0.f, s1 = 0.f;
#pragma unroll
    for (int i = 0; i < 4; i++) {
      v0[i] = *(const f32x4*)(x0 + i * 256 + lane * 4);
      v1[i] = *(const f32x4*)(x1 + i * 256 + lane * 4);
    }
#pragma unroll
    for (int i = 0; i < 4; i++) {
      s0 += v0[i][0] * v0[i][0] + v0[i][1] * v0[i][1] + v0[i][2] * v0[i][2] + v0[i][3] * v0[i][3];
      s1 += v1[i][0] * v1[i][0] + v1[i][1] * v1[i][1] + v1[i][2] * v1[i][2] + v1[i][3] * v1[i][3];
    }
    s0 = wave_sum(s0);
    s1 = wave_sum(s1);
    const float rs0 = rsqrtf(s0 * (1.f / 1024.f) + 1e-6f), rs1 = rsqrtf(s1 * (1.f / 1024.f) + 1e-6f);
    const float* m0 = p.modv + (layer * 5 + cond_of(row0)) * 3072;
    const float* m1 = p.modv + (layer * 5 + cond_of(r1)) * 3072;
    f32x4 ggv[4], sh0v[4], sc0v[4], sh1v[4], sc1v[4];
#pragma unroll
    for (int i = 0; i < 4; i++) {
      const int k = i * 256 + lane * 4;
      ggv[i] = *(const f32x4*)(g + k);
      sh0v[i] = *(const f32x4*)(m0 + k); sc0v[i] = *(const f32x4*)(m0 + 1024 + k);
      sh1v[i] = *(const f32x4*)(m1 + k); sc1v[i] = *(const f32x4*)(m1 + 1024 + k);
    }
#pragma unroll
    for (int i = 0; i < 4; i++) {
      const int k = i * 256 + lane * 4;
      const f32x4 gg = ggv[i], sh0 = sh0v[i], sc0 = sc0v[i], sh1 = sh1v[i], sc1 = sc1v[i];
      const f32x4 o0 = v0[i] * rs0 * gg * (sc0 + 1.f) + sh0;
      const f32x4 o1 = v1[i] * rs1 * gg * (sc1 + 1.f) + sh1;
      store_h4(p.hbuf + (size_t)row0 * 1024 + k, o0[0], o0[1], o0[2], o0[3]);
      if (has1) store_h4(p.hbuf + (size_t)row1 * 1024 + k, o1[0], o1[1], o1[2], o1[3]);
    }
  }
}

__device__ void phase_final(const Params p) {
  const int lane = otid() & 63, wid = otid() >> 6;
  const float* g = p.final_norm_g;
  const int stride = gridDim.x * 4;
  for (int row0 = blockIdx.x * 4 + wid; row0 < T_ALL; row0 += 2 * stride) {
    const int row1 = row0 + stride;
    const bool has1 = row1 < T_ALL;
    float* x0 = p.out + (size_t)row0 * 1024;
    float* x1 = p.out + (size_t)(has1 ? row1 : row0) * 1024;
    f32x4 v0[4], v1[4];
    float s0 = 0.f, s1 = 0.f;
#pragma unroll
    for (int i = 0; i < 4; i++) {
      v0[i] = __builtin_nontemporal_load((const f32x4*)(x0 + i * 256 + lane * 4));
      v1[i] = __builtin_nontemporal_load((const f32x4*)(x1 + i * 256 + lane * 4));
    }
#pragma unroll
    for (int i = 0; i < 4; i++) {
      s0 += v0[i][0] * v0[i][0] + v0[i][1] * v0[i][1] + v0[i][2] * v0[i][2] + v0[i][3] * v0[i][3];
      s1 += v1[i][0] * v1[i][0] + v1[i][1] * v1[i][1] + v1[i][2] * v1[i][2] + v1[i][3] * v1[i][3];
    }
    s0 = wave_sum(s0);
    s1 = wave_sum(s1);
    const float rs0 = rsqrtf(s0 * (1.f / 1024.f) + 1e-6f), rs1 = rsqrtf(s1 * (1.f / 1024.f) + 1e-6f);
    f32x4 ggv[4];
#pragma unroll
    for (int i = 0; i < 4; i++) ggv[i] = *(const f32x4*)(g + i * 256 + lane * 4);
#pragma unroll
    for (int i = 0; i < 4; i++) {
      const int k = i * 256 + lane * 4;
      const f32x4 gg = ggv[i];
      __builtin_nontemporal_store(v0[i] * rs0 * gg, (f32x4*)(x0 + k));
      if (has1) __builtin_nontemporal_store(v1[i] * rs1 * gg, (f32x4*)(x1 + k));
    }
  }
}

__device__ void phase_g1(const Params p, int layer, char* smem) {
  const int lane = otid() & 63, wid = otid() >> 6, wr = wid >> 1, wc = wid & 1, l15 = lane & 15, g = lane >> 4;
  const h16* Wt = p.wt_in + (size_t)layer * 3072 * 1024;
  for (int tile = blockIdx.x; tile < 128 * 24; tile += gridDim.x) {
    const int rt = tile / 24, ct = tile % 24;
    const int r0 = rt * 128, n0 = ct * 128;
    f32x4 acc[4][4];
    zero_acc(acc);
    gemm_acc<128, 128>(acc, p.hbuf + (size_t)r0 * 1024, 1024, Wt + (size_t)n0 * 1024, 1024, 1024, smem);
    const bool ctx = r0 < T_CTX;
#pragma unroll
    for (int ni = 0; ni < 4; ni++) {
      const int col = n0 + wc * 64 + ni * 16 + 4 * g;
      if (col >= ZLD) continue;
      const int fb = n0 + wc * 64 + ni * 16;
#pragma unroll
      for (int mi = 0; mi < 4; mi++) {
        const int tok = r0 + wr * 64 + mi * 16 + l15;
        f32x4 v = acc[mi][ni];
        store_h4(p.zbuf + (size_t)tok * ZLD + col, v[0], v[1], v[2], v[3]);
        int b, l, Ls;
        if (ctx) { b = tok >> 8; l = tok & 255; Ls = 256; } else { b = (tok - T_CTX) >> 11; l = (tok - T_CTX) & 2047; Ls = 2048; }
        if (fb >= 384 && fb < 512) {
          h16* vt = p.vt_a_ctx + (ctx ? 0 : 1048576);
          int cc = col - 384;
#pragma unroll
          for (int j = 0; j < 4; j++) vt[((size_t)(b * 2 + ((cc + j) >> 6)) * 64 + ((cc + j) & 63)) * Ls + l] = (h16)v[j];
        } else if (fb >= 2464 && fb < 2720) {
          h16* vt = p.vt_d_ctx + (ctx ? 0 : 2097152);
          int cc = col - 2464;
#pragma unroll
          for (int j = 0; j < 4; j++) vt[((size_t)(b * 4 + ((cc + j) >> 6)) * 64 + ((cc + j) & 63)) * Ls + l] = (h16)v[j];
        }
        if (ctx) {
          const size_t rowi = (size_t)(b * 2 + layer) * 256 + l;
          const f32x4 fv = v;
          if (fb >= 256 && fb < 384) __builtin_nontemporal_store(fv, (f32x4*)(p.out + O_AK + rowi * 128 + (col - 256)));
          else if (fb >= 384 && fb < 512) __builtin_nontemporal_store(fv, (f32x4*)(p.out + O_AV + rowi * 128 + (col - 384)));
          else if (fb >= 1152 && fb < 1184) __builtin_nontemporal_store(fv, (f32x4*)(p.out + O_KPE + rowi * 32 + (col - 1152)));
          else if (fb >= 2208 && fb < 2464) __builtin_nontemporal_store(fv, (f32x4*)(p.out + O_NK + rowi * 256 + (col - 2208)));
          else if (fb >= 2464 && fb < 2720) __builtin_nontemporal_store(fv, (f32x4*)(p.out + O_NV + rowi * 256 + (col - 2464)));
        }
      }
    }
  }
}

#define BUS 136
__device__ void s5_item(const Params p, int layer, int mode0, int b0, int g0, int chunk0, int mode1, int b1, int g1, int chunk1, char* smem) {
  const int tid = otid(), lane = tid & 63, wid = tid >> 6, l15 = lane & 15, gq = lane >> 4;
  const int pr = wid >> 1, ptid = tid & 127;
  const int mode = pr ? mode1 : mode0, b = pr ? b1 : b0, g = pr ? g1 : g0, chunk = pr ? chunk1 : chunk0;
  char* pbase = smem + pr * 33280;
  h16* su = (h16*)pbase;
  h16* sbu = su + 256 * 16;
  h16* sy = sbu + 2 * 16 * BUS;
  const int tok0 = (mode == 0) ? b * 256 : T_CTX + b * 2048 + chunk * 256;
  if (mode >= 0) {
    for (int i = ptid; i < 512; i += 128) {
      int t = i >> 1, hf = i & 1;
      *(u32x4*)(su + t * 16 + hf * 8) = *(const u32x4*)(p.zbuf + (size_t)(tok0 + t) * ZLD + 1440 + g * 16 + hf * 8);
    }
  }
  __syncthreads();
  if (mode >= 0) {
    const int dir = wid & 1;
    const int ldg = (layer * 2 + dir) * 16 + g;
    const float ar = p.s5_abar[(ldg * 64 + lane) * 2], ai = p.s5_abar[(ldg * 64 + lane) * 2 + 1];
    const float dt = p.s5_dt[ldg];
    float hr = 0.f, hi = 0.f;
    if (mode == 2) {
      const size_t sidx = ((((size_t)b * 2 + layer) * 2 + dir) * 16 + g) * 64 + lane;
      hr = p.state_re[sidx];
      hi = p.state_im[sidx];
      float lr = p.s5_lamdt[(ldg * 64 + lane) * 2] * 256.f, li = p.s5_lamdt[(ldg * 64 + lane) * 2 + 1] * 256.f;
      float er = expf(lr), sn, cs;
      sincosf(li, &sn, &cs);
      const float pr = er * cs, pi = er * sn;
      const float* e = p.s5_e + ((((size_t)b * 16 + g) * 2 + dir) * 8) * 128;
      float ev_r[8], ev_i[8];
#pragma unroll
      for (int c2 = 0; c2 < 8; c2++) { ev_r[c2] = e[c2 * 128 + lane * 2]; ev_i[c2] = e[c2 * 128 + lane * 2 + 1]; }
      if (dir == 0) {
#pragma unroll
        for (int c2 = 0; c2 < 8; c2++)
          if (c2 < chunk) { const float nr = pr * hr - pi * hi + ev_r[c2], ni = pr * hi + pi * hr + ev_i[c2]; hr = nr; hi = ni; }
      } else {
#pragma unroll
        for (int c2 = 7; c2 >= 0; c2--)
          if (c2 > chunk) { const float nr = pr * hr - pi * hi + ev_r[c2], ni = pr * hi + pi * hr + ev_i[c2]; hr = nr; hi = ni; }
      }
    }
    h16x4 bfr[8];
    const h16* bmt = p.s5_bmt + (size_t)ldg * 128 * 16;
#pragma unroll
    for (int nf = 0; nf < 8; nf++) bfr[nf] = *(const h16x4*)(bmt + (nf * 16 + l15) * 16 + 4 * gq);
    h16x8 cfr[4];
    const h16* cmt = p.s5_cmt + (size_t)ldg * 16 * 128;
#pragma unroll
    for (int ks = 0; ks < 4; ks++) cfr[ks] = *(const h16x8*)(cmt + l15 * 128 + ks * 32 + 8 * gq);
    h16* bu = sbu + dir * 16 * BUS;
    h16* ydir = sy + dir * 256 * 16;
    for (int sub = 0; sub < 16; sub++) {
      const int sc = dir == 0 ? sub : 15 - sub;
      const int tt0 = sc * 16;
      h16x4 ua = *(const h16x4*)(su + (tt0 + l15) * 16 + 4 * gq);
#pragma unroll
      for (int nf = 0; nf < 8; nf++) {
        f32x4 r = __builtin_amdgcn_mfma_f32_16x16x16f16(bfr[nf], ua, f32x4{0.f, 0.f, 0.f, 0.f}, 0, 0, 0);
        store_h4(bu + l15 * BUS + nf * 16 + 4 * gq, r[0], r[1], r[2], r[3]);
      }
      __builtin_amdgcn_wave_barrier();
      {
        float vr[16], vi[16];
#pragma unroll
        for (int s = 0; s < 16; s++) { vr[s] = (float)bu[s * BUS + lane]; vi[s] = (float)bu[s * BUS + 64 + lane]; }
        if (dir == 0) {
#pragma unroll
          for (int s = 0; s < 16; s++) {
            const float nr = ar * hr - ai * hi + dt * vr[s], ni = ar * hi + ai * hr + dt * vi[s];
            hr = nr; hi = ni; vr[s] = nr; vi[s] = ni;
          }
        } else {
#pragma unroll
          for (int s = 15; s >= 0; s--) {
            const float nr = ar * hr - ai * hi + dt * vr[s], ni = ar * hi + ai * hr + dt * vi[s];
            hr = nr; hi = ni; vr[s] = nr; vi[s] = ni;
          }
        }
#pragma unroll
        for (int s = 0; s < 16; s++) { bu[s * BUS + lane] = (h16)vr[s]; bu[s * BUS + 64 + lane] = (h16)vi[s]; }
      }
      __builtin_amdgcn_wave_barrier();
      if (mode != 1) {
        f32x4 y = {0.f, 0.f, 0.f, 0.f};
#pragma unroll
        for (int ks = 0; ks < 4; ks++) {
          h16x8 ha = *(const h16x8*)(bu + l15 * BUS + ks * 32 + 8 * gq);
          y = __builtin_amdgcn_mfma_f32_16x16x32_f16(cfr[ks], ha, y, 0, 0, 0);
        }
        store_h4(ydir + (tt0 + l15) * 16 + 4 * gq, y[0], y[1], y[2], y[3]);
      }
      __builtin_amdgcn_wave_barrier();
    }
    if (mode == 0) {
      const size_t oi = ((((size_t)b * 2 + layer) * 2 + dir) * 16 + g) * 64 + lane;
      p.out[O_SRE + oi] = hr;
      p.out[O_SIM + oi] = hi;
    } else if (mode == 1) {
      float* e = p.s5_e + (((((size_t)b * 16 + g) * 2 + dir) * 8) + chunk) * 128;
      e[lane * 2] = hr;
      e[lane * 2 + 1] = hi;
    }
  }
  __syncthreads();
  if (mode == 0 || mode == 2) {
    const float dsk = p.s5_d[layer * 256 + g * 16 + (ptid & 15)];
    for (int i = ptid; i < 256 * 16; i += 128) {
      int t = i >> 4, c = i & 15;
      float u = (float)su[i];
      float v = (float)sy[i] + (float)sy[256 * 16 + i] + dsk * u;
      p.zbuf[(size_t)(tok0 + t) * ZLD + 1440 + g * 16 + c] = (h16)geluf_(v);
    }
  }
  __syncthreads();
}


template <int NCOL>
__device__ __forceinline__ void row_rstd(const h16* __restrict__ base, float* rs) {
  const int tid = otid(), row = tid >> 1, hf = tid & 1;
  const h16* ptr = base + (size_t)row * ZLD + hf * (NCOL / 2);
  float s = 0.f;
#pragma unroll
  for (int i = 0; i < NCOL / 16; i++) {
    h16x8 v = *(const h16x8*)(ptr + i * 8);
#pragma unroll
    for (int j = 0; j < 8; j++) s += (float)v[j] * (float)v[j];
  }
  s += __shfl_xor(s, 1);
  if (hf == 0) rs[row] = rsqrtf(s * (1.f / NCOL) + 1e-6f);
}

__device__ void phase_g2(const Params p, int layer, char* smem) {
  const int tid = otid(), lane = tid & 63, wid = tid >> 6, wr = wid >> 1, wc = wid & 1, l15 = lane & 15, g = lane >> 4;
  for (int it = blockIdx.x; it < 512; it += gridDim.x)
    s5_item(p, layer, 0, it >> 4, it & 15, 0, 1, it >> 7, (it >> 3) & 15, it & 7, smem);
  for (int it = blockIdx.x; it < 768; it += gridDim.x) {
    {
      const int rt = it / 6, ct = it % 6, r0 = rt * 128, n0 = ct * 64;
      float* rs = (float*)(smem + 49152);
      row_rstd<256>(p.zbuf + (size_t)r0 * ZLD + 768, rs);
      f32x4 acc[4][2];
      zero_acc(acc);
      gemm_acc<128, 64>(acc, p.zbuf + (size_t)r0 * ZLD + 768, ZLD, p.wt_qup + (size_t)layer * 384 * 256 + (size_t)n0 * 256, 256, 256, smem);
      __syncthreads();
      const bool lat = r0 >= T_CTX;
#pragma unroll
      for (int mi = 0; mi < 4; mi++) {
        const int row = wr * 64 + mi * 16 + l15, tok = r0 + row;
        const float rstd = rs[row];
#pragma unroll
        for (int ni = 0; ni < 2; ni++) {
          const int fb = n0 + wc * 32 + ni * 16;
          f32x4 v = acc[mi][ni] * rstd;
          store_h4(p.qm + (size_t)tok * 384 + fb + 4 * g, v[0], v[1], v[2], v[3]);
        }
      }
      __syncthreads();
      if (lat && ct != 0 && ct != 3) {
        const int rc0 = n0 + ((ct == 2 || ct == 5) ? 32 : 0);
        float rx1[8], rx2[8], rcs[8], rsn[8];
#pragma unroll
        for (int q = 0; q < 8; q++) {
          const int i = tid + q * 256, row = i >> 4, e = i & 15, tok = r0 + row;
          const int i8 = e & 7, base = (e < 8) ? 0 : 16;
          const int lpos = (tok - T_CTX) & 2047;
          const int pos = (e < 8) ? (lpos >> 6) : (lpos & 63);
          const h16* ptr = p.qm + (size_t)tok * 384 + rc0 + base + i8;
          rx1[q] = (float)ptr[0]; rx2[q] = (float)ptr[8];
          rcs[q] = p.cs8[(pos * 8 + i8) * 2]; rsn[q] = p.cs8[(pos * 8 + i8) * 2 + 1];
        }
#pragma unroll
        for (int q = 0; q < 8; q++) {
          const int i = tid + q * 256, row = i >> 4, e = i & 15, tok = r0 + row;
          const int i8 = e & 7, base = (e < 8) ? 0 : 16;
          h16* ptr = p.qm + (size_t)tok * 384 + rc0 + base + i8;
          ptr[0] = (h16)(rx1[q] * rcs[q] - rx2[q] * rsn[q]);
          ptr[8] = (h16)(rx1[q] * rsn[q] + rx2[q] * rcs[q]);
        }
      }
      __syncthreads();
    }
  }
  for (int it = gridDim.x - 1 - blockIdx.x; it < 1024 + 128; it += gridDim.x) {
    const int N_KV = 1024;
    {
      const bool cached = it >= N_KV;
      int rt, ct;
      const h16 *A, *Bt;
      int lda;
      if (!cached) { rt = it >> 3; ct = it & 7; A = p.zbuf + (size_t)(rt * 128) * ZLD + 1024; lda = ZLD; Bt = p.wt_kvup + (size_t)layer * 512 * 128; }
      else { int i2 = it - N_KV; rt = i2 >> 3; ct = i2 & 7; int b = rt >> 2, k0 = (rt & 3) * 128; A = p.ckv_c + ((size_t)(b * 2 + layer) * 512 + k0) * 128; lda = 128; Bt = p.wt_kvraw + (size_t)layer * 512 * 128; }
      const int r0 = rt * 128, n0 = ct * 64;
      float* rs = (float*)(smem + 49152);
      if (!cached) {
        row_rstd<128>(p.zbuf + (size_t)r0 * ZLD + 1024, rs);
      } else {
        if (tid < 128) rs[tid] = 1.f;
      }
      f32x4 acc[4][2];
      zero_acc(acc);
      gemm_acc<128, 64>(acc, A, lda, Bt + (size_t)n0 * 128, 128, 128, smem);
      const int head = n0 >> 7;
      const bool vtype = (n0 & 64) != 0;
#pragma unroll
      for (int mi = 0; mi < 4; mi++) {
        const int row = wr * 64 + mi * 16 + l15, tok = r0 + row;
        const float rstd = rs[row];
#pragma unroll
        for (int ni = 0; ni < 2; ni++) {
          const int d0 = wc * 32 + ni * 16 + 4 * g;
          f32x4 v = acc[mi][ni] * rstd;
          if (!vtype) {
            h16* dst = p.kmla + (cached ? (size_t)T_ALL * 384 : (size_t)0);
            store_h4(dst + (size_t)tok * 384 + head * 96 + d0, v[0], v[1], v[2], v[3]);
          } else {
            h16* vt; int bb, l, Ls;
            int voff;
            if (cached) { voff = 4194304; bb = tok >> 9; l = tok & 511; Ls = 512; }
            else if (tok < T_CTX) { voff = 0; bb = tok >> 8; l = tok & 255; Ls = 256; }
            else { voff = 2097152; bb = (tok - T_CTX) >> 11; l = (tok - T_CTX) & 2047; Ls = 2048; }
            vt = p.vt_m_ctx + voff;
#pragma unroll
            for (int j = 0; j < 4; j++) vt[((size_t)(bb * 4 + head) * 64 + d0 + j) * Ls + l] = (h16)v[j];
          }
        }
      }
      if (ct == 0 && !cached && r0 < T_CTX) {
        const float* gk = p.mla_kv_norm + layer * 128;
#pragma unroll
        for (int q = 0; q < 8; q++) {
          const int i = tid + q * 256, row = i >> 4, k = (i & 15) * 8, tok = r0 + row;
          const h16x8 zv = *(const h16x8*)(p.zbuf + (size_t)tok * ZLD + 1024 + k);
          const float rr = rs[row];
          const f32x4 g0 = *(const f32x4*)(gk + k), g1 = *(const f32x4*)(gk + k + 4);
          float* dst = p.out + O_CKV + ((size_t)((tok >> 8) * 2 + layer) * 256 + (tok & 255)) * 128 + k;
          __builtin_nontemporal_store(f32x4{(float)zv[0] * rr * g0[0], (float)zv[1] * rr * g0[1], (float)zv[2] * rr * g0[2], (float)zv[3] * rr * g0[3]}, (f32x4*)dst);
          __builtin_nontemporal_store(f32x4{(float)zv[4] * rr * g1[0], (float)zv[5] * rr * g1[1], (float)zv[6] * rr * g1[2], (float)zv[7] * rr * g1[3]}, (f32x4*)(dst + 4));
        }
      }
      if (ct == 1) {
        float kx1[8], kx2[8];
#pragma unroll
        for (int q = 0; q < 8; q++) {
          const int i = tid + q * 256, row = i >> 4, e = i & 15, tok = r0 + row;
          if (cached) {
            const int bb = tok >> 9, key = tok & 511;
            const float* src = p.cache_mla_kpe + ((size_t)(bb * 2 + layer) * 512 + key) * 32;
            kx1[q] = src[e]; kx2[q] = src[16 + e];
          } else {
            const h16* src = p.zbuf + (size_t)tok * ZLD + 1152;
            const int i8 = e & 7, base = (e < 8) ? 0 : 16;
            float x1 = (float)src[base + i8], x2 = (float)src[base + 8 + i8];
            if (tok >= T_CTX) {
              const int lpos = (tok - T_CTX) & 2047;
              const int pos = (e < 8) ? (lpos >> 6) : (lpos & 63);
              const float cs = p.cs8[(pos * 8 + i8) * 2], sn = p.cs8[(pos * 8 + i8) * 2 + 1];
              const float o1 = x1 * cs - x2 * sn, o2 = x1 * sn + x2 * cs;
              x1 = o1; x2 = o2;
            }
            kx1[q] = x1; kx2[q] = x2;
          }
        }
#pragma unroll
        for (int q = 0; q < 8; q++) {
          const int i = tid + q * 256, row = i >> 4, e = i & 15, tok = r0 + row;
          const h16 v1 = (h16)kx1[q], v2 = (h16)kx2[q];
          if (cached) {
            h16* dst = p.kmla + (size_t)T_ALL * 384 + (size_t)tok * 384;
#pragma unroll
            for (int h = 0; h < 4; h++) { dst[h * 96 + 64 + e] = v1; dst[h * 96 + 80 + e] = v2; }
          } else {
            const int i8 = e & 7, base = (e < 8) ? 0 : 16;
            h16* dst = p.kmla + (size_t)tok * 384;
#pragma unroll
            for (int h = 0; h < 4; h++) { dst[h * 96 + 64 + base + i8] = v1; dst[h * 96 + 64 + base + 8 + i8] = v2; }
          }
        }
      }
      __syncthreads();
    }
  }
  for (int it = (blockIdx.x + (gridDim.x >> 1)) % gridDim.x; it < 128; it += gridDim.x) {
    {
      const int t0 = T_CTX + it * 64;
#pragma unroll
      for (int q = 0; q < 6; q++) {
        const int i = tid + q * 256;
        const int tl = i / 24, vi = i % 24;
        const int tok = t0 + tl, lpos = (tok - T_CTX) & 2047;
        const int head = vi >> 2, part = (vi >> 1) & 1, grp = vi & 1;
        const int pos = part ? (lpos & 63) : (lpos >> 6);
        h16* ptr = p.zbuf + (size_t)tok * ZLD + head * 64 + part * 32 + grp * 8;
        const h16x8 x1 = *(const h16x8*)ptr, x2 = *(const h16x8*)(ptr + 16);
        const float* tb = p.cs16 + (pos * 16 + grp * 8) * 2;
        h16x8 o1, o2;
#pragma unroll
        for (int j = 0; j < 8; j++) {
          const float cs = tb[2 * j], sn = tb[2 * j + 1];
          o1[j] = (h16)((float)x1[j] * cs - (float)x2[j] * sn);
          o2[j] = (h16)((float)x1[j] * sn + (float)x2[j] * cs);
        }
        *(h16x8*)ptr = o1;
        *(h16x8*)(ptr + 16) = o2;
      }
    }
  }
}

struct Seg { const h16* K; const h16* Vt; int ldk, ldv, ntiles; };

#define LDSP(x) ((__attribute__((address_space(3))) unsigned*)(x))
template <int DQK, int MODE, int QREP>
__device__ void attn_item(const h16* __restrict__ Q, int ldq, Seg s0, Seg s1, float scale_l2, bool has_sink, float sink_l2,
                          int qpos0, int kpos0, const float* __restrict__ rpb_h, int qrow, int krow0,
                          h16* __restrict__ outp, const h16* __restrict__ gate, char* smem) {
  constexpr int KCH = DQK / 8;
  constexpr int KROWB = DQK * 2;
  constexpr int KPT = 64 * KCH / 256;
  constexpr int KBYTES = 64 * KROWB;
  constexpr int STAGE = KBYTES + 8192;
  constexpr int NKS = DQK / 32;
  constexpr int G = KPT + 2;
  const int tid = otid(), lane = tid & 63, wid = tid >> 6, l15 = lane & 15, g = lane >> 4;
  float* sbias = (float*)(smem + 49152);
  if (MODE == 2) {
    for (int i = tid; i < 15 * 31; i += 256) sbias[i] = rpb_h[i] * LOG2E;
  }
  h16x8 qf[QREP][NKS];
#pragma unroll
  for (int qi = 0; qi < QREP; qi++)
#pragma unroll
    for (int ks = 0; ks < NKS; ks++) {
      h16x8 qv = *(const h16x8*)(Q + (size_t)(wid * 16 * QREP + qi * 16 + l15) * ldq + ks * 32 + 8 * g);
#pragma unroll
      for (int j = 0; j < 8; j++) qv[j] = (h16)((float)qv[j] * scale_l2);
      qf[qi][ks] = qv;
    }
  float m[QREP], lsum[QREP];
  f32x4 o[QREP][4];
#pragma unroll
  for (int qi = 0; qi < QREP; qi++) {
    m[qi] = has_sink ? sink_l2 : -1e30f;
    lsum[qi] = (has_sink && g == 0) ? 1.f : 0.f;
#pragma unroll
    for (int i = 0; i < 4; i++) o[qi][i] = f32x4{0.f, 0.f, 0.f, 0.f};
  }
  const int ntot = s0.ntiles + s1.ntiles;
  const int lsl = (tid & 7) ^ ((tid >> 4) & 7);
#define TILE_PTRS(ti_) \
    const h16 *kp, *vp; int ldk, ldv; \
    if ((ti_) < s0.ntiles) { kp = s0.K + (size_t)(ti_) * 64 * s0.ldk; vp = s0.Vt + (ti_) * 64; ldk = s0.ldk; ldv = s0.ldv; } \
    else { int t2 = (ti_) - s0.ntiles; kp = s1.K + (size_t)t2 * 64 * s1.ldk; vp = s1.Vt + t2 * 64; ldk = s1.ldk; ldv = s1.ldv; }
#define ATT_ISSUE(ti_, st_)                                                                                         \
  {                                                                                                                 \
    TILE_PTRS(ti_)                                                                                                  \
    char* dk_ = smem + (st_) * STAGE + tid * 16;                                                                    \
    _Pragma("unroll") for (int i = 0; i < KPT; i++) {                                                               \
      const h16* src_;                                                                                              \
      if (DQK == 64) src_ = kp + (size_t)((tid >> 3) + i * 32) * ldk + lsl * 8;                                     \
      else { const int c_ = tid + i * 256; src_ = kp + (size_t)(c_ / KCH) * ldk + (c_ % KCH) * 8; }                 \
      __builtin_amdgcn_global_load_lds((const unsigned*)src_, LDSP(dk_ + i * 4096), 16, 0, 0);                      \
    }                                                                                                               \
    _Pragma("unroll") for (int i = 0; i < 2; i++)                                                                   \
      __builtin_amdgcn_global_load_lds((const unsigned*)(vp + (size_t)((tid >> 3) + i * 32) * ldv + lsl * 8), LDSP(dk_ + KBYTES + i * 4096), 16, 0, 0); \
  }
  asm volatile("s_waitcnt vmcnt(0)" ::: "memory");
  ATT_ISSUE(0, 0)
  if (ntot > 1) ATT_ISSUE(1, 1)
  int st = 0;
  for (int ti = 0; ti < ntot; ti++) {
    if (ti + 1 < ntot) asm volatile("s_waitcnt vmcnt(%0)" ::"n"(G) : "memory");
    else asm volatile("s_waitcnt vmcnt(0)" ::: "memory");
    asm volatile("s_waitcnt lgkmcnt(0)" ::: "memory");
    __builtin_amdgcn_s_barrier();
    asm volatile("" ::: "memory");
    if (ti + 2 < ntot) { const int st2 = (st == 0) ? 2 : st - 1; ATT_ISSUE(ti + 2, st2) }
    const char* sk = smem + st * STAGE;
    const char* sv = sk + KBYTES;
    st = (st == 2) ? 0 : st + 1;
    f32x4 s[QREP][4];
#pragma unroll
    for (int kf = 0; kf < 4; kf++) {
#pragma unroll
      for (int qi = 0; qi < QREP; qi++) s[qi][kf] = f32x4{0.f, 0.f, 0.f, 0.f};
#pragma unroll
      for (int ks = 0; ks < NKS; ks++) {
        const int row = kf * 16 + l15, sl = ks * 4 + g;
        const int off = (DQK == 64) ? SWZ(row, sl) : (row * KROWB + sl * 16);
        h16x8 ka = *(const h16x8*)(sk + off);
#pragma unroll
        for (int qi = 0; qi < QREP; qi++) s[qi][kf] = __builtin_amdgcn_mfma_f32_16x16x32_f16(ka, qf[qi][ks], s[qi][kf], 0, 0, 0);
      }
    }
    const bool masked = (MODE != 0) && (ti < s0.ntiles);
    typedef float f32x2 __attribute__((ext_vector_type(2)));
    h16x8 pb[QREP][2];
    float alpha[QREP];
#pragma unroll
    for (int qi = 0; qi < QREP; qi++) {
      if (MODE != 0 && masked) {
#pragma unroll
        for (int kf = 0; kf < 4; kf++)
#pragma unroll
          for (int j = 0; j < 4; j++) {
            float x = s[qi][kf][j];
            if (MODE == 1) {
              int kpos = kpos0 + ti * 64 + kf * 16 + 4 * g + j, qpos = qpos0 + wid * 16 * QREP + qi * 16 + l15;
              int d = qpos - kpos;
              if (d > 128 || d < -128) x = -INFINITY;
            }
            if (MODE == 2) {
              int ck = kf * 16 + 4 * g + j, cq = wid * 16 * QREP + qi * 16 + l15;
              int cs = min(max(cq - 8, 0), 48);
              int rel = ck - cs;
              if (rel < 0 || rel >= 16) x = -INFINITY;
              else {
                int co = min(max(ck - cq, -15), 15) + 15;
                int ro = (krow0 + ti) - qrow + 7;
                x += sbias[ro * 31 + co];
              }
            }
            s[qi][kf][j] = x;
          }
      }
      float mx = fmaxf(fmaxf(fmaxf(s[qi][0][0], s[qi][0][1]), fmaxf(s[qi][0][2], s[qi][0][3])), fmaxf(fmaxf(s[qi][1][0], s[qi][1][1]), fmaxf(s[qi][1][2], s[qi][1][3])));
      mx = fmaxf(mx, fmaxf(fmaxf(fmaxf(s[qi][2][0], s[qi][2][1]), fmaxf(s[qi][2][2], s[qi][2][3])), fmaxf(fmaxf(s[qi][3][0], s[qi][3][1]), fmaxf(s[qi][3][2], s[qi][3][3]))));
      mx = fmaxf(mx, __shfl_xor(mx, 16));
      mx = fmaxf(mx, __shfl_xor(mx, 32));
      const float mnew = fmaxf(m[qi], mx);
      alpha[qi] = __builtin_amdgcn_exp2f(m[qi] - mnew);
      m[qi] = mnew;
      const f32x2 mn2 = {mnew, mnew};
      f32x2 ps2 = {0.f, 0.f};
#pragma unroll
      for (int kf = 0; kf < 4; kf++)
#pragma unroll
        for (int jp = 0; jp < 2; jp++) {
          f32x2 d2 = f32x2{s[qi][kf][2 * jp], s[qi][kf][2 * jp + 1]} - mn2;
          f32x2 e2 = {__builtin_amdgcn_exp2f(d2[0]), __builtin_amdgcn_exp2f(d2[1])};
          ps2 += e2;
          pb[qi][kf >> 1][(kf & 1) * 4 + 2 * jp] = (h16)e2[0];
          pb[qi][kf >> 1][(kf & 1) * 4 + 2 * jp + 1] = (h16)e2[1];
        }
      lsum[qi] = lsum[qi] * alpha[qi] + (ps2[0] + ps2[1]);
    }
#pragma unroll
    for (int df = 0; df < 4; df++) {
#pragma unroll
      for (int qi = 0; qi < QREP; qi++) o[qi][df] = o[qi][df] * alpha[qi];
#pragma unroll
      for (int kk = 0; kk < 2; kk++) {
        const int row = df * 16 + l15;
        const int c0 = 8 * kk + g, c1 = 8 * kk + 4 + g;
        h16x4 v0 = *(const h16x4*)(sv + SWZ(row, c0 >> 1) + (c0 & 1) * 8);
        h16x4 v1 = *(const h16x4*)(sv + SWZ(row, c1 >> 1) + (c1 & 1) * 8);
        h16x8 va = {v0[0], v0[1], v0[2], v0[3], v1[0], v1[1], v1[2], v1[3]};
#pragma unroll
        for (int qi = 0; qi < QREP; qi++) o[qi][df] = __builtin_amdgcn_mfma_f32_16x16x32_f16(va, pb[qi][kk], o[qi][df], 0, 0, 0);
      }
    }
  }
  asm volatile("" ::: "memory");
  __builtin_amdgcn_s_barrier();
  asm volatile("" ::: "memory");
#pragma unroll
  for (int qi = 0; qi < QREP; qi++) {
    float l = lsum[qi];
    l += __shfl_xor(l, 16);
    l += __shfl_xor(l, 32);
    const float inv = 1.f / l;
    const int qr = wid * 16 * QREP + qi * 16 + l15;
    h16x4 gva[4];
#pragma unroll
    for (int df = 0; df < 4; df++) gva[df] = *(const h16x4*)(gate + (size_t)qr * ZLD + df * 16 + 4 * g);
#pragma unroll
    for (int df = 0; df < 4; df++) {
      const int d = df * 16 + 4 * g;
      const h16x4 gv = gva[df];
      store_h4(outp + (size_t)qr * 1024 + d, o[qi][df][0] * inv * siluf_((float)gv[0]), o[qi][df][1] * inv * siluf_((float)gv[1]),
               o[qi][df][2] * inv * siluf_((float)gv[2]), o[qi][df][3] * inv * siluf_((float)gv[3]));
    }
  }
}

__device__ void phase_att(const Params p, int layer, char* smem) {
  const float sc64 = 0.125f * LOG2E, sc96 = 0.10206207261596575f * LOG2E;
  Seg s0, s1;
  for (int vb = blockIdx.x; vb < 512; vb += gridDim.x) {
    const bool first = vb < 256;
    const int i = (vb & 7) * 32 + ((vb >> 3) & 31);
    {
      const int idx = vb;
      s5_item(p, layer, 2, idx >> 7, (idx >> 3) & 15, idx & 7, -1, 0, 0, 0, smem);
    }
    if (first)
    for (int e3 = 0; e3 < 2; e3++) {
      const bool first = e3 == 0;
      int b, h, tokb, tok0;
      if (first) { b = i >> 6; h = (i >> 4) & 3; tokb = T_CTX + b * 2048; tok0 = tokb + (i & 15) * 128; }
      else { b = i >> 3; h = (i >> 1) & 3; tokb = b * 256; tok0 = tokb + (i & 1) * 128; }
      s0.K = p.kmla + (size_t)tokb * 384 + h * 96; s0.ldk = 384;
      if (first) {
        s0.Vt = p.vt_m_lat + (size_t)(b * 4 + h) * 64 * 2048; s0.ldv = 2048; s0.ntiles = 32;
        s1.K = p.kcx + (size_t)(b * 512) * 384 + h * 96; s1.ldk = 384; s1.Vt = p.vcx_t + (size_t)(b * 4 + h) * 64 * 512; s1.ldv = 512; s1.ntiles = 8;
      } else {
        s0.Vt = p.vt_m_ctx + (size_t)(b * 4 + h) * 64 * 256; s0.ldv = 256; s0.ntiles = 4;
        s1.K = s0.K; s1.Vt = s0.Vt; s1.ldk = 0; s1.ldv = 0; s1.ntiles = 0;
      }
      attn_item<96, 0, 2>(p.qm + (size_t)tok0 * 384 + h * 96, 384, s0, s1, sc96, false, 0.f, 0, 0, nullptr, 0, 0,
                          p.br + (size_t)tok0 * 1024 + 256 + h * 64, p.zbuf + (size_t)tok0 * ZLD + 1184 + h * 64, smem);
    }
    if (first)
    for (int e2 = 0; e2 < 2; e2++) {
      const bool isA = e2 == 0;
      const int b = i >> 3, h = (i >> 1) & 3, qt = i & 1;
      const int tokb = b * 256, tok0 = tokb + qt * 128;
      int qcol, kcol, gcol, bcol;
      if (isA) { const int hk = h >> 1; qcol = h * 64; kcol = 256 + hk * 64; gcol = 512 + h * 64; bcol = h * 64; s0.Vt = p.vt_a_ctx + (size_t)(b * 2 + hk) * 64 * 256; }
      else { qcol = 1952 + h * 64; kcol = 2208 + h * 64; gcol = 2720 + h * 64; bcol = 768 + h * 64; s0.Vt = p.vt_d_ctx + (size_t)(b * 4 + h) * 64 * 256; }
      s0.K = p.zbuf + (size_t)tokb * ZLD + kcol; s0.ldk = ZLD; s0.ldv = 256; s0.ntiles = 4;
      s1.K = s0.K; s1.Vt = s0.Vt; s1.ldk = 0; s1.ldv = 0; s1.ntiles = 0;
      const float sink = isA ? p.a_sink[layer * 4 + h] * LOG2E : 0.f;
      attn_item<64, 0, 2>(p.zbuf + (size_t)tok0 * ZLD + qcol, ZLD, s0, s1, sc64, isA, sink, 0, 0, nullptr, 0, 0,
                          p.br + (size_t)tok0 * 1024 + bcol, p.zbuf + (size_t)tok0 * ZLD + gcol, smem);
    }
    if (!first) {
      for (int e = 0; e < 2; e++) {
        const int idx = 2 * i + e;
        const int b = idx >> 7, h = (idx >> 5) & 3, qt = idx & 31;
        const int tokb = T_CTX + b * 2048, tok0 = tokb + qt * 64;
        const int r = qt, rs = min(max(r - 4, 0), 24);
        s0.K = p.zbuf + (size_t)(tokb + rs * 64) * ZLD + 2208 + h * 64; s0.ldk = ZLD; s0.Vt = p.vt_d_lat + (size_t)(b * 4 + h) * 64 * 2048 + rs * 64; s0.ldv = 2048; s0.ntiles = 8;
        s1.K = p.ck_n + (size_t)((b * 2 + layer) * 512) * 256 + h * 64; s1.ldk = 256; s1.Vt = p.cvt_n + (size_t)((b * 2 + layer) * 4 + h) * 64 * 512; s1.ldv = 512; s1.ntiles = 8;
        attn_item<64, 2, 1>(p.zbuf + (size_t)tok0 * ZLD + 1952 + h * 64, ZLD, s0, s1, sc64, false, 0.f, 0, 0,
                            p.na_rpb + (size_t)(layer * 4 + h) * 15 * 31, r, rs,
                            p.br + (size_t)tok0 * 1024 + 768 + h * 64, p.zbuf + (size_t)tok0 * ZLD + 2720 + h * 64, smem);
      }
      for (int e = 0; e < 2; e++) {
        const int idx = 2 * i + e;
        const int b = idx >> 7, h = (idx >> 5) & 3, qt = idx & 31;
        const int tokb = T_CTX + b * 2048, tok0 = tokb + qt * 64;
        const int hk = h >> 1, q0 = qt * 64;
        const int ks = max(0, q0 - 128), ke = min(2048, q0 + 192);
        s0.K = p.zbuf + (size_t)(tokb + ks) * ZLD + 256 + hk * 64; s0.ldk = ZLD; s0.Vt = p.vt_a_lat + (size_t)(b * 2 + hk) * 64 * 2048 + ks; s0.ldv = 2048; s0.ntiles = (ke - ks) >> 6;
        s1.K = p.ck_a + (size_t)((b * 2 + layer) * 512) * 128 + hk * 64; s1.ldk = 128; s1.Vt = p.cvt_a + (size_t)((b * 2 + layer) * 2 + hk) * 64 * 512; s1.ldv = 512; s1.ntiles = 8;
        attn_item<64, 1, 1>(p.zbuf + (size_t)tok0 * ZLD + h * 64, ZLD, s0, s1, sc64, true, p.a_sink[layer * 4 + h] * LOG2E, q0, ks, nullptr, 0, 0,
                            p.br + (size_t)tok0 * 1024 + h * 64, p.zbuf + (size_t)tok0 * ZLD + 512 + h * 64, smem);
      }
    }
  }
}

__device__ void phase_glu(const Params p, int layer, char* smem) {
  const int lane = otid() & 63, wid = otid() >> 6, wr = wid >> 1, wc = wid & 1, l15 = lane & 15, g = lane >> 4;
  int rt, ct;
  for (int ti = 0; xcd_tile(ti, 128, 4, rt, ct); ti++) {
    const int r0 = rt * 128, n0 = ct * 128;
    f32x4 acc[4][4];
    zero_acc(acc);
    gemm_acc<128, 128>(acc, p.zbuf + (size_t)r0 * ZLD + 1440, ZLD, p.wt_glu + (size_t)layer * 512 * 256 + (size_t)n0 * 256, 256, 256, smem);
    h16x4 cgv[4][2];
#pragma unroll
    for (int mi = 0; mi < 4; mi++)
#pragma unroll
      for (int np = 0; np < 2; np++) {
        const int tok = r0 + wr * 64 + mi * 16 + l15, col = ((n0 + wc * 64 + np * 32) >> 5) * 16 + 4 * g;
        cgv[mi][np] = *(const h16x4*)(p.zbuf + (size_t)tok * ZLD + 1696 + col);
      }
#pragma unroll
    for (int mi = 0; mi < 4; mi++) {
      const int tok = r0 + wr * 64 + mi * 16 + l15;
#pragma unroll
      for (int np = 0; np < 2; np++) {
        const int pn = n0 + wc * 64 + np * 32;
        const int col = (pn >> 5) * 16 + 4 * g;
        f32x4 val = acc[mi][np * 2], gt = acc[mi][np * 2 + 1];
        const h16x4 cg_ = cgv[mi][np];
        store_h4(p.br + (size_t)tok * 1024 + 512 + col, val[0] * sigmoidf_(gt[0]) * siluf_((float)cg_[0]),
                 val[1] * sigmoidf_(gt[1]) * siluf_((float)cg_[1]), val[2] * sigmoidf_(gt[2]) * siluf_((float)cg_[2]),
                 val[3] * sigmoidf_(gt[3]) * siluf_((float)cg_[3]));
      }
    }
  }
}

__device__ void phase_g3(const Params p, int layer, char* smem) {
  const int lane = otid() & 63, wid = otid() >> 6, wr = wid >> 1, wc = wid & 1, l15 = lane & 15, g = lane >> 4;
  const h16* Wm = p.wt_merge + (size_t)layer * 4096 * 1024;
  const h16* Wb = p.wt_branch + (size_t)layer * 4 * 1024 * 256;
  h16* mbuf = p.zbuf;
  typedef __attribute__((ext_vector_type(2))) unsigned u32x2;
  int rt, ct;
  for (int ti = 0; xcd_tile(ti, 128, 8, rt, ct); ti++) {
    const int r0 = rt * 128, d0 = ct * 128;
    h16x4 macc[4][4];
#pragma unroll
    for (int mi = 0; mi < 4; mi++)
#pragma unroll
      for (int ni = 0; ni < 4; ni++) macc[mi][ni] = h16x4{(h16)0.f, (h16)0.f, (h16)0.f, (h16)0.f};
#pragma unroll 1
    for (int k = 0; k < 4; k++) {
      u32x2 sg[4][4];
      {
        f32x4 a1[4][4];
        zero_acc(a1);
        gemm_acc<128, 128, true>(a1, p.hbuf + (size_t)r0 * 1024, 1024, Wm + (size_t)(k * 1024 + d0) * 1024, 1024, 1024, smem);
#pragma unroll
        for (int mi = 0; mi < 4; mi++)
#pragma unroll
          for (int ni = 0; ni < 4; ni++) {
            h16x4 hv = {(h16)sigmoidf_(a1[mi][ni][0]), (h16)sigmoidf_(a1[mi][ni][1]), (h16)sigmoidf_(a1[mi][ni][2]), (h16)sigmoidf_(a1[mi][ni][3])};
            sg[mi][ni] = __builtin_bit_cast(u32x2, hv);
          }
      }
      f32x4 a2[4][4];
      zero_acc(a2);
      gemm_acc<128, 128, true>(a2, p.br + (size_t)r0 * 1024 + k * 256, 1024, Wb + (size_t)(k * 1024 + d0) * 256, 256, 256, smem);
#pragma unroll
      for (int mi = 0; mi < 4; mi++)
#pragma unroll
        for (int ni = 0; ni < 4; ni++) {
          const h16x4 hv = __builtin_bit_cast(h16x4, sg[mi][ni]);
          const h16x4 a2h = {(h16)a2[mi][ni][0], (h16)a2[mi][ni][1], (h16)a2[mi][ni][2], (h16)a2[mi][ni][3]};
          macc[mi][ni] = hv * a2h + macc[mi][ni];
        }
    }
#pragma unroll
    for (int mi = 0; mi < 4; mi++)
#pragma unroll
      for (int ni = 0; ni < 4; ni++) {
        const int tok = r0 + wr * 64 + mi * 16 + l15, col = d0 + wc * 64 + ni * 16 + 4 * g;
        *(h16x4*)(mbuf + (size_t)tok * 1024 + col) = macc[mi][ni];
      }
  }
}

__device__ void phase_g4(const Params p, int layer, char* smem) {
  const int lane = otid() & 63, wid = otid() >> 6, wr = wid >> 1, wc = wid & 1, l15 = lane & 15, g = lane >> 4;
  const h16* Wo = p.wt_out + (size_t)layer * 1048576;
  const h16* mbuf = p.zbuf;
  int rt, ct;
  for (int ti = 0; xcd_tile(ti, 128, 8, rt, ct); ti++) {
    const int r0 = rt * 128, n0 = ct * 128;
    f32x4 acc[4][4];
    zero_acc(acc);
    gemm_acc<128, 128>(acc, mbuf + (size_t)r0 * 1024, 1024, Wo + (size_t)n0 * 1024, 1024, 1024, smem);
    f32x4 gv[4];
    {
      const float* gt = p.modv + (layer * 5 + cond_of(r0)) * 3072 + 2048;
#pragma unroll
      for (int ni = 0; ni < 4; ni++) gv[ni] = *(const f32x4*)(gt + n0 + wc * 64 + ni * 16 + 4 * g);
    }
    f32x4 xv[4][4];
#pragma unroll
    for (int mi = 0; mi < 4; mi++) {
      const float* xo = xptr(p, layer, r0 + wr * 64 + mi * 16 + l15);
#pragma unroll
      for (int ni = 0; ni < 4; ni++) xv[mi][ni] = *(const f32x4*)(xo + n0 + wc * 64 + ni * 16 + 4 * g);
    }
#pragma unroll
    for (int mi = 0; mi < 4; mi++) {
      const int tok = r0 + wr * 64 + mi * 16 + l15;
#pragma unroll
      for (int ni = 0; ni < 4; ni++) {
        const int col = n0 + wc * 64 + ni * 16 + 4 * g;
        *(f32x4*)(p.out + (size_t)tok * 1024 + col) = xv[mi][ni] + gv[ni] * acc[mi][ni];
      }
    }
  }
}


#define XB_TMO      128
#define XB_XCNT(j)  (256  + 64 * (j))
#define XB_XSUB(j)  (1280 + 64 * (j))
#define XB_XGEN(j)  (2304 + 64 * (j))
#define XB_TOP      3328
#define XB_TOPGEN   3392
#define XCD_BAR_WORDS 3456
#define XB_SPIN_CAP (1u << 20)
__device__ __forceinline__ unsigned xb_ld(unsigned* p) { return __hip_atomic_load(p, __ATOMIC_RELAXED, __HIP_MEMORY_SCOPE_AGENT); }
__device__ __forceinline__ unsigned xb_add(unsigned* p, unsigned v) { return __hip_atomic_fetch_add(p, v, __ATOMIC_RELAXED, __HIP_MEMORY_SCOPE_AGENT); }
__device__ __forceinline__ unsigned xb_xcc_id() { return (unsigned)__builtin_amdgcn_s_getreg((3 << 11) | 20) & 0xFu; }
#define XB_SPIN(cond, bar) do { unsigned _sp = 0; while (cond) { __builtin_amdgcn_s_sleep(1); \
    if ((++_sp & 255u) == 0u) { if (xb_ld(&(bar)[XB_TMO])) break; if (_sp > XB_SPIN_CAP) { atomicAdd(&(bar)[XB_TMO], 1u); break; } } } } while (0)
struct XB { unsigned* bar; unsigned x, nloc, nx; };
__device__ __forceinline__ void xb_post(XB& b, unsigned* bar) {
  b.bar = bar; b.x = xb_xcc_id(); b.nloc = 0u; b.nx = 0u;
  if (otid() == 0) (void)xb_add(&bar[XB_XCNT(b.x)], 1u);
}
__device__ __forceinline__ void xb_complete(unsigned* bar, unsigned x, unsigned& nloc, unsigned& nx) {
  const unsigned G = gridDim.x;
  unsigned sum, cnt, mine, sp = 0u;
  for (;;) {
    sum = 0u; cnt = 0u; mine = 0u;
#pragma unroll
    for (unsigned j = 0; j < 16; ++j) { const unsigned c = xb_ld(&bar[XB_XCNT(j)]); sum += c; cnt += (c > 0u) ? 1u : 0u; mine = (j == x) ? c : mine; }
    if (sum == G) break;
    __builtin_amdgcn_s_sleep(1);
    if ((++sp & 255u) == 0u) { if (xb_ld(&bar[XB_TMO])) break; if (sp > XB_SPIN_CAP) { atomicAdd(&bar[XB_TMO], 1u); break; } }
  }
  nloc = mine > 0u ? mine : 1u; nx = cnt > 0u ? cnt : 1u;
}
__device__ __forceinline__ void xb_sync(XB& b) {
  asm volatile("s_waitcnt vmcnt(0)" ::: "memory");
  __syncthreads();
  if (otid() == 0) {
    unsigned* bar = b.bar;
    __builtin_amdgcn_s_waitcnt(0);
    if (b.nloc == 0u) xb_complete(bar, b.x, b.nloc, b.nx);
    const unsigned nloc = b.nloc, nx = b.nx;
    const unsigned old = xb_add(&bar[XB_XSUB(b.x)], 1u);
    const unsigned gen = old / nloc;
    if (old + 1u == (gen + 1u) * nloc) {
      __builtin_amdgcn_fence(__ATOMIC_RELEASE, "agent");
      asm volatile("s_waitcnt vmcnt(0)" ::: "memory");
      const unsigned og = xb_add(&bar[XB_TOP], 1u);
      const unsigned tg = og / nx;
      if (og + 1u == (tg + 1u) * nx) xb_add(&bar[XB_TOPGEN], 1u);
      else XB_SPIN(xb_ld(&bar[XB_TOPGEN]) == tg, bar);
      __builtin_amdgcn_fence(__ATOMIC_ACQUIRE, "agent");
      xb_add(&bar[XB_XGEN(b.x)], 1u);
      asm volatile("s_waitcnt vmcnt(0)" ::: "memory");
    } else {
      XB_SPIN(xb_ld(&bar[XB_XGEN(b.x)]) == gen, bar);
      __builtin_amdgcn_fence(__ATOMIC_ACQUIRE, "agent");
      asm volatile("s_waitcnt vmcnt(0)" ::: "memory");
    }
  }
  __syncthreads();
}

#define N_PHASES 16
template <int PH>
__device__ __forceinline__ void run_phase(const Params p, char* smem) {
  if constexpr (PH == 0) phase_prep(p, smem);
  else if constexpr (PH == 15) phase_final(p);
  else {
    constexpr int layer = (PH - 1) / 7, s = (PH - 1) % 7;
    if constexpr (s == 0) phase_norm(p, layer);
    else if constexpr (s == 1) phase_g1(p, layer, smem);
    else if constexpr (s == 2) phase_g2(p, layer, smem);
    else if constexpr (s == 3) phase_att(p, layer, smem);
    else if constexpr (s == 4) phase_glu(p, layer, smem);
    else if constexpr (s == 5) phase_g3(p, layer, smem);
    else phase_g4(p, layer, smem);
  }
}

template <int PH>
__global__ void __launch_bounds__(256, 2) phase_kernel(Params p) {
  __shared__ __attribute__((aligned(16))) char smem[65536];
  run_phase<PH>(p, smem);
}

#ifndef MULTI_LAUNCH
#ifndef PROBE_MASK
#define PROBE_MASK 0
#endif
#define PROBE_MULT 4
template <int PH>
__device__ __forceinline__ void run_from(const Params p, char* smem, XB& xb, unsigned long long tprev, unsigned long long& tacc) {
  run_phase<PH>(p, smem);
  if constexpr (PH + 1 < N_PHASES) {
    xb_sync(xb);
  }
  unsigned long long tnow = tprev;
  if constexpr (PROBE_MASK != 0) {
    tnow = wall_clock64();
    if constexpr ((PROBE_MASK >> PH) & 1) tacc += tnow - tprev;
  }
  if constexpr (PH + 1 < N_PHASES) run_from<PH + 1>(p, smem, xb, tnow, tacc);
}

__global__ void __launch_bounds__(256, 2) mega(Params p) {
  __shared__ __attribute__((aligned(16))) char smem[65536];
  XB xb;
  xb_post(xb, p.bar);
  unsigned long long tacc = 0;
  unsigned long long t0 = 0;
  if constexpr (PROBE_MASK != 0) t0 = wall_clock64();
  run_from<0>(p, smem, xb, t0, tacc);
  if constexpr (PROBE_MASK != 0) {
    if (blockIdx.x == 0 && otid() == 0) {
      const unsigned long long tend = wall_clock64();
      while (wall_clock64() - tend < tacc * PROBE_MULT) __builtin_amdgcn_s_sleep(8);
    }
  }
}
#endif

template <int PH>
static void launch_phases(const Params p, int grid, hipStream_t stream) {
  hipLaunchKernelGGL(phase_kernel<PH>, dim3(grid), dim3(256), 0, stream, p);
  if constexpr (PH + 1 < N_PHASES) launch_phases<PH + 1>(p, grid, stream);
}

static inline size_t al256(size_t x) { return (x + 255) & ~(size_t)255; }

extern "C" void kernel_launch(void* const* d_in, const int* in_sizes, int n_in, void* d_out, int out_size, void* d_ws,
                              size_t ws_size, hipStream_t stream) {
  Params p{};
  const float** ip = (const float**)&p;
  for (int i = 0; i < 35; i++) ip[i] = (const float*)d_in[i];
  p.out = (float*)d_out;
  char* w = (char*)d_ws;
  size_t off = 0;
  auto take = [&](size_t bytes) { char* r = w + off; off = al256(off + bytes); return r; };
  p.wt_in = (h16*)take((size_t)2 * 3072 * 1024 * 2);
  p.wt_merge = (h16*)take((size_t)2 * 4096 * 1024 * 2);
  p.wt_branch = (h16*)take((size_t)2 * 4 * 1024 * 256 * 2);
  p.wt_out = (h16*)take((size_t)2 * 1024 * 1024 * 2);
  p.wt_qup = (h16*)take((size_t)2 * 384 * 256 * 2);
  p.wt_kvup = (h16*)take((size_t)2 * 512 * 128 * 2);
  p.wt_kvraw = (h16*)take((size_t)2 * 512 * 128 * 2);
  p.wt_glu = (h16*)take((size_t)2 * 512 * 256 * 2);
  p.hbuf = (h16*)take((size_t)T_ALL * 1024 * 2);
  p.zbuf = (h16*)take((size_t)T_ALL * ZLD * 2);
  p.br = (h16*)take((size_t)T_ALL * 1024 * 2);
  p.qm = (h16*)take((size_t)T_ALL * 384 * 2);
  p.kmla = (h16*)take((size_t)T_ALL * 384 * 2);
  p.kcx = (h16*)take((size_t)2048 * 384 * 2);
  p.vt_a_ctx = (h16*)take((size_t)32 * 2 * 64 * 256 * 2);
  p.vt_a_lat = (h16*)take((size_t)4 * 2 * 64 * 2048 * 2);
  p.vt_d_ctx = (h16*)take((size_t)32 * 4 * 64 * 256 * 2);
  p.vt_d_lat = (h16*)take((size_t)4 * 4 * 64 * 2048 * 2);
  p.vt_m_ctx = (h16*)take((size_t)32 * 4 * 64 * 256 * 2);
  p.vt_m_lat = (h16*)take((size_t)4 * 4 * 64 * 2048 * 2);
  p.vcx_t = (h16*)take((size_t)4 * 4 * 64 * 512 * 2);
  p.ck_a = (h16*)take((size_t)524288 * 2);
  p.cvt_a = (h16*)take((size_t)524288 * 2);
  p.ck_n = (h16*)take((size_t)1048576 * 2);
  p.cvt_n = (h16*)take((size_t)1048576 * 2);
  p.ckv_c = (h16*)take((size_t)524288 * 2);
  p.s5_bmt = (h16*)take((size_t)64 * 128 * 16 * 2);
  p.s5_cmt = (h16*)take((size_t)64 * 16 * 128 * 2);
  p.s5_abar = (float*)take(4096 * 2 * 4);
  p.s5_lamdt = (float*)take(4096 * 2 * 4);
  p.s5_dt = (float*)take(64 * 4);
  p.s5_e = (float*)take((size_t)4 * 16 * 2 * 8 * 128 * 4);
  p.modv = (float*)take(2 * 5 * 3072 * 4);
  p.cs16 = (float*)take(64 * 16 * 2 * 4);
  p.cs8 = (float*)take(64 * 8 * 2 * 4);
  p.bar = (unsigned*)take(XCD_BAR_WORDS * 4);
  if (off > ws_size) { fprintf(stderr, "workspace too small: need %zu have %zu\n", off, ws_size); return; }

  static int grid_blocks = 0;
  if (!grid_blocks) {
    int dev = 0, cus = 0, per_cu = 0;
    (void)hipGetDevice(&dev);
    (void)hipDeviceGetAttribute(&cus, hipDeviceAttributeMultiprocessorCount, dev);
    #ifdef MULTI_LAUNCH
    (void)hipOccupancyMaxActiveBlocksPerMultiprocessor(&per_cu, phase_kernel<3>, 256, 0);
#else
    (void)hipOccupancyMaxActiveBlocksPerMultiprocessor(&per_cu, mega, 256, 0);
#endif
    if (per_cu > 2) per_cu = 2;
    if (per_cu < 1) per_cu = 1;
    grid_blocks = cus * per_cu;
  }
#ifdef MULTI_LAUNCH
  launch_phases<0>(p, grid_blocks, stream);
#else
  (void)hipMemsetAsync(p.bar, 0, XCD_BAR_WORDS * 4, stream);
  void* args[] = {&p};
  hipError_t e = hipLaunchCooperativeKernel((void*)mega, dim3(grid_blocks), dim3(256), args, 0, stream);
  if (e != hipSuccess) fprintf(stderr, "cooperative launch failed: %s (grid %d)\n", hipGetErrorString(e), grid_blocks);
#endif
}
```

```cpp
#include <hip/hip_runtime.h>
#include <hip/hip_cooperative_groups.h>
#include <cstdio>
#include <cstdint>
namespace cg = cooperative_groups;

typedef _Float16 h16;
typedef __attribute__((ext_vector_type(8))) _Float16 h16x8;
typedef __attribute__((ext_vector_type(4))) _Float16 h16x4;
typedef __attribute__((ext_vector_type(4))) float f32x4;
typedef __attribute__((ext_vector_type(4))) unsigned int u32x4;

#define T_ALL 16384
#define T_CTX 8192
#define ZLD 2976
#define LOG2E 1.4426950408889634f

#define O_AK   16777216
#define O_AV   18874368
#define O_CKV  20971520
#define O_KPE  23068672
#define O_NK   23592960
#define O_NV   27787264
#define O_SRE  31981568
#define O_SIM  32112640

struct Params {
  const float *x_prompt, *x_sample, *cache_a_k, *cache_a_v, *cache_mla_ckv, *cache_mla_kpe, *cache_na_k, *cache_na_v,
      *state_re, *state_im, *c, *c_ctx, *w_mod, *b_mod, *norm_g, *w_in, *w_merge, *a_sink, *mla_q_norm, *mla_w_q_up,
      *mla_kv_norm, *mla_w_kv_up, *s5_lam_re, *s5_lam_im, *s5_log_dt, *s5_b_re, *s5_b_im, *s5_c_re, *s5_c_im, *s5_d,
      *s5_w_glu, *na_rpb, *w_branch, *w_out, *final_norm_g;
  float* out;
  h16 *wt_in, *wt_merge, *wt_branch, *wt_out, *wt_qup, *wt_kvup, *wt_kvraw, *wt_glu;
  h16 *hbuf, *zbuf, *br, *qm, *kmla, *kcx, *vt_a_ctx, *vt_a_lat, *vt_d_ctx, *vt_d_lat, *vt_m_ctx, *vt_m_lat, *vcx_t,
      *ck_a, *cvt_a, *ck_n, *cvt_n, *ckv_c, *s5_bmt, *s5_cmt;
  float *s5_abar, *s5_lamdt, *s5_dt, *s5_e, *modv, *cs16, *cs8;
  unsigned* bar;
};


__device__ __forceinline__ int otid() { int t = __builtin_amdgcn_workitem_id_x(); asm volatile("" : "+v"(t)); return t; }
__device__ __forceinline__ float sigmoidf_(float x) { return 1.f / (1.f + __expf(-x)); }
__device__ __forceinline__ float siluf_(float x) { return x * sigmoidf_(x); }
__device__ __forceinline__ float geluf_(float x) {
  float u = 0.7978845608028654f * (x + 0.044715f * x * x * x);
  return x / (1.f + __expf(-2.f * u));
}
__device__ __forceinline__ float wave_sum(float v) {
#pragma unroll
  for (int o = 32; o > 0; o >>= 1) v += __shfl_xor(v, o);
  return v;
}
__device__ __forceinline__ const float* xptr(const Params p, int layer, int tok) {
  if (layer == 0) return tok < T_CTX ? p.x_prompt + (size_t)tok * 1024 : p.x_sample + (size_t)(tok - T_CTX) * 1024;
  return p.out + (size_t)tok * 1024;
}
__device__ __forceinline__ int cond_of(int tok) { return tok < T_CTX ? 0 : 1 + ((tok - T_CTX) >> 11); }

#define SWZ(row, slot) (((row) << 7) + ((((slot) ^ (((row) >> 1) & 7))) << 4))

template <int BM, int BN, bool LOWREG = false>
__device__ __forceinline__ void gemm_acc(f32x4 (&acc)[BM / 32][BN / 32], const h16* __restrict__ A, int lda,
                                         const h16* __restrict__ Bt, int ldb, int K, char* smem) {
  constexpr int MREP = BM / 32, NREP = BN / 32;
  constexpr int ACH = BM * 8 / 256, BCH = BN * 8 / 256;
  constexpr int ABYTES = BM * 128, STAGE = (BM + BN) * 128;
  const int tid = otid(), lane = tid & 63, wid = tid >> 6;
  const int wr = wid >> 1, wc = wid & 1;
  const int l15 = lane & 15, g = lane >> 4;
  const int nk = K >> 6;
  const int ls = (tid & 7) ^ ((tid >> 4) & 7);
  const h16* Ap = A + (size_t)(tid >> 3) * lda + ls * 8;
  const h16* Bp = Bt + (size_t)(tid >> 3) * ldb + ls * 8;
  char* dstA = smem + tid * 16;
  char* dstB = smem + ABYTES + tid * 16;
#pragma unroll
  for (int i = 0; i < ACH; i++)
    __builtin_amdgcn_global_load_lds((const unsigned*)(Ap + (size_t)(i * 32) * lda), (__attribute__((address_space(3))) unsigned*)(dstA + i * 4096), 16, 0, 0);
#pragma unroll
  for (int i = 0; i < BCH; i++)
    __builtin_amdgcn_global_load_lds((const unsigned*)(Bp + (size_t)(i * 32) * ldb), (__attribute__((address_space(3))) unsigned*)(dstB + i * 4096), 16, 0, 0);
  for (int kt = 0; kt < nk; kt++) {
    asm volatile("s_waitcnt vmcnt(0)" ::: "memory");
    __syncthreads();
    if (kt + 1 < nk) {
      const int nb = ((kt + 1) & 1) * STAGE;
#pragma unroll
      for (int i = 0; i < ACH; i++)
        __builtin_amdgcn_global_load_lds((const unsigned*)(Ap + (size_t)(i * 32) * lda + (kt + 1) * 64), (__attribute__((address_space(3))) unsigned*)(dstA + nb + i * 4096), 16, 0, 0);
#pragma unroll
      for (int i = 0; i < BCH; i++)
        __builtin_amdgcn_global_load_lds((const unsigned*)(Bp + (size_t)(i * 32) * ldb + (kt + 1) * 64), (__attribute__((address_space(3))) unsigned*)(dstB + nb + i * 4096), 16, 0, 0);
    }
    const char* sa = smem + (kt & 1) * STAGE;
    const char* sb = sa + ABYTES;
    if (!LOWREG) {
      h16x8 af[2][MREP], bf[2][NREP];
#pragma unroll
      for (int ks = 0; ks < 2; ks++) {
#pragma unroll
        for (int mi = 0; mi < MREP; mi++) af[ks][mi] = *(const h16x8*)(sa + SWZ(wr * (BM / 2) + mi * 16 + l15, ks * 4 + g));
#pragma unroll
        for (int ni = 0; ni < NREP; ni++) bf[ks][ni] = *(const h16x8*)(sb + SWZ(wc * (BN / 2) + ni * 16 + l15, ks * 4 + g));
      }
      __builtin_amdgcn_sched_barrier(0);
#pragma unroll
      for (int ks = 0; ks < 2; ks++)
#pragma unroll
        for (int mi = 0; mi < MREP; mi++)
#pragma unroll
          for (int ni = 0; ni < NREP; ni++)
            acc[mi][ni] = __builtin_amdgcn_mfma_f32_16x16x32_f16(bf[ks][ni], af[ks][mi], acc[mi][ni], 0, 0, 0);
      __builtin_amdgcn_sched_barrier(0);
    } else {
#pragma unroll
      for (int ks = 0; ks < 2; ks++) {
        h16x8 af[MREP], bf[NREP];
#pragma unroll
        for (int mi = 0; mi < MREP; mi++) af[mi] = *(const h16x8*)(sa + SWZ(wr * (BM / 2) + mi * 16 + l15, ks * 4 + g));
#pragma unroll
        for (int ni = 0; ni < NREP; ni++) bf[ni] = *(const h16x8*)(sb + SWZ(wc * (BN / 2) + ni * 16 + l15, ks * 4 + g));
        __builtin_amdgcn_sched_barrier(0);
#pragma unroll
        for (int mi = 0; mi < MREP; mi++)
#pragma unroll
          for (int ni = 0; ni < NREP; ni++)
            acc[mi][ni] = __builtin_amdgcn_mfma_f32_16x16x32_f16(bf[ni], af[mi], acc[mi][ni], 0, 0, 0);
        __builtin_amdgcn_sched_barrier(0);
      }
    }
  }
  __syncthreads();
}

__device__ __forceinline__ bool xcd_tile(int i, int RT, int CT, int& rt, int& ct) {
  const int nbx = gridDim.x >> 3, x = blockIdx.x & 7, j = blockIdx.x >> 3;
  const int RTL = RT >> 3;
  const int L = i * nbx + j;
  if (L >= RTL * CT) return false;
  if ((CT & 7) == 0 && (RTL & 7) == 0) {
    const int gi = L >> 6, w = L & 63, nrg = RTL >> 3;
    rt = x * RTL + (gi % nrg) * 8 + (w >> 3);
    ct = (gi / nrg) * 8 + (w & 7);
  } else {
    rt = x * RTL + L / CT;
    ct = L % CT;
  }
  return true;
}

template <int M, int N>
__device__ __forceinline__ void zero_acc(f32x4 (&a)[M][N]) {
#pragma unroll
  for (int i = 0; i < M; i++)
#pragma unroll
    for (int j = 0; j < N; j++) a[i][j] = f32x4{0.f, 0.f, 0.f, 0.f};
}

__device__ __forceinline__ void store_h4(h16* dst, float a, float b, float c, float d) {
  h16x4 v = {(h16)a, (h16)b, (h16)c, (h16)d};
  *(h16x4*)dst = v;
}

__device__ void tr_tile(const float* __restrict__ src, int lds_, h16* __restrict__ dst, int ldd, int k0, int n0, int N,
                        char* smem) {
  float* tile = (float*)smem;
  const int tid = otid();
  const int r = tid >> 4, c4 = tid & 15;
#pragma unroll
  for (int rr = 0; rr < 4; rr++) {
    int kl = r + rr * 16;
    int n = n0 + c4 * 4;
    float4 v = make_float4(0.f, 0.f, 0.f, 0.f);
    if (n < N) v = *(const float4*)(src + (size_t)(k0 + kl) * lds_ + n);
    tile[kl * 65 + c4 * 4 + 0] = v.x;
    tile[kl * 65 + c4 * 4 + 1] = v.y;
    tile[kl * 65 + c4 * 4 + 2] = v.z;
    tile[kl * 65 + c4 * 4 + 3] = v.w;
  }
  __syncthreads();
  const int nl = tid >> 2, kq = tid & 3;
  h16x8 o0, o1;
#pragma unroll
  for (int i = 0; i < 8; i++) {
    o0[i] = (h16)tile[(kq * 16 + i) * 65 + nl];
    o1[i] = (h16)tile[(kq * 16 + 8 + i) * 65 + nl];
  }
  h16* d = dst + (size_t)(n0 + nl) * ldd + k0 + kq * 16;
  *(h16x8*)d = o0;
  *(h16x8*)(d + 8) = o1;
  __syncthreads();
}

__device__ void phase_prep(const Params p, char* smem) {
  const int tid = otid();
  const size_t gtid = (size_t)blockIdx.x * 256 + tid, gsz = (size_t)gridDim.x * 256;
  for (size_t i = gtid; i < 2 * 384 * 256; i += gsz) {
    int l = i / (384 * 256), r = i % (384 * 256), n = r / 256, k = r % 256;
    p.wt_qup[i] = (h16)(p.mla_q_norm[l * 256 + k] * p.mla_w_q_up[(size_t)l * 256 * 384 + k * 384 + n]);
  }
  for (size_t i = gtid; i < 2 * 512 * 128; i += gsz) {
    int l = i / (512 * 128), r = i % (512 * 128), n = r / 128, k = r % 128;
    float w = p.mla_w_kv_up[(size_t)l * 128 * 512 + k * 512 + n];
    p.wt_kvraw[i] = (h16)w;
    p.wt_kvup[i] = (h16)(w * p.mla_kv_norm[l * 128 + k]);
  }
  for (size_t i = gtid; i < 2 * 512 * 256; i += gsz) {
    int l = i / (512 * 256), r = i % (512 * 256), n = r / 256, k = r % 256;
    int q = n >> 5, w = n & 31;
    int orig = (w < 16) ? (q * 16 + w) : (256 + q * 16 + (w - 16));
    p.wt_glu[i] = (h16)p.s5_w_glu[(size_t)l * 256 * 512 + k * 512 + orig];
  }
  for (size_t i = gtid; i < 262144; i += gsz) {
    const float* src; h16* dst; size_t e;
    if (i < 65536) { src = p.cache_a_k; dst = p.ck_a; e = i * 8; }
    else if (i < 131072) { src = p.cache_mla_ckv; dst = p.ckv_c; e = (i - 65536) * 8; }
    else { src = p.cache_na_k; dst = p.ck_n; e = (i - 131072) * 8; }
    const f32x4 a = __builtin_nontemporal_load((const f32x4*)(src + e)), b = __builtin_nontemporal_load((const f32x4*)(src + e + 4));
    h16x8 o = {(h16)a[0], (h16)a[1], (h16)a[2], (h16)a[3], (h16)b[0], (h16)b[1], (h16)b[2], (h16)b[3]};
    *(h16x8*)(dst + e) = o;
  }
  for (size_t ii = gtid; ii < 65536; ii += gsz) {
    const int i = ii >> 4, c = ii & 15;
    int ldg = i >> 6;
    float lr = fminf(p.s5_lam_re[i], -1e-4f), li = p.s5_lam_im[i];
    float dt = __expf(p.s5_log_dt[ldg]);
    float er = expf(lr * dt), sn, cs;
    sincosf(li * dt, &sn, &cs);
    float ar = er * cs, ai = er * sn;
    if (c == 0) {
      p.s5_abar[i * 2] = ar;
      p.s5_abar[i * 2 + 1] = ai;
      p.s5_lamdt[i * 2] = lr * dt;
      p.s5_lamdt[i * 2 + 1] = li * dt;
      if ((i & 63) == 0) p.s5_dt[ldg] = dt;
    }
    float nr = ar - 1.f, ni = ai, den = lr * lr + li * li;
    float cr = (nr * lr + ni * li) / den / dt, ci = (ni * lr - nr * li) / den / dt;
    int pp = i & 63;
    {
      float br_ = p.s5_b_re[(size_t)i * 16 + c], bi_ = p.s5_b_im[(size_t)i * 16 + c];
      p.s5_bmt[((size_t)ldg * 128 + pp) * 16 + c] = (h16)(cr * br_ - ci * bi_);
      p.s5_bmt[((size_t)ldg * 128 + 64 + pp) * 16 + c] = (h16)(cr * bi_ + ci * br_);
      p.s5_cmt[((size_t)ldg * 16 + c) * 128 + pp] = (h16)p.s5_c_re[((size_t)ldg * 16 + c) * 64 + pp];
      p.s5_cmt[((size_t)ldg * 16 + c) * 128 + 64 + pp] = (h16)(-p.s5_c_im[((size_t)ldg * 16 + c) * 64 + pp]);
    }
  }
  for (size_t i = gtid; i < 64 * 16; i += gsz) {
    int pos = i >> 4, k = i & 15;
    float inv = powf(10000.f, -(float)k / 16.f), sn, cs;
    sincosf((float)pos * inv, &sn, &cs);
    p.cs16[i * 2] = cs;
    p.cs16[i * 2 + 1] = sn;
  }
  for (size_t i = gtid; i < 64 * 8; i += gsz) {
    int pos = i >> 3, k = i & 7;
    float inv = powf(10000.f, -(float)k / 8.f), sn, cs;
    sincosf((float)pos * inv, &sn, &cs);
    p.cs8[i * 2] = cs;
    p.cs8[i * 2 + 1] = sn;
  }
  for (int it = blockIdx.x; it < 384; it += gridDim.x) {
    float* sc = (float*)smem;
    float* red = sc + 5 * 1024;
    const int layer = it / 192, col0 = (it % 192) * 16;
    for (int i = tid; i < 5120; i += 256) {
      int c = i >> 10, k = i & 1023;
      float v = (c == 0) ? p.c_ctx[k] : p.c[(c - 1) * 1024 + k];
      sc[i] = siluf_(v);
    }
    __syncthreads();
    const int cl = tid & 15, kg = tid >> 4;
    float a0 = 0, a1 = 0, a2 = 0, a3 = 0, a4 = 0;
    const float* w = p.w_mod + (size_t)layer * 1024 * 3072 + col0 + cl;
#pragma unroll 16
    for (int kk = 0; kk < 64; kk++) {
      int k = kg * 64 + kk;
      float wv = __builtin_nontemporal_load(w + (size_t)k * 3072);
      a0 += sc[k] * wv;
      a1 += sc[1024 + k] * wv;
      a2 += sc[2048 + k] * wv;
      a3 += sc[3072 + k] * wv;
      a4 += sc[4096 + k] * wv;
    }
    red[(kg * 5 + 0) * 16 + cl] = a0;
    red[(kg * 5 + 1) * 16 + cl] = a1;
    red[(kg * 5 + 2) * 16 + cl] = a2;
    red[(kg * 5 + 3) * 16 + cl] = a3;
    red[(kg * 5 + 4) * 16 + cl] = a4;
    __syncthreads();
    if (tid < 80) {
      int c = tid >> 4, cc = tid & 15;
      float s = 0;
      for (int q = 0; q < 16; q++) s += red[(q * 5 + c) * 16 + cc];
      p.modv[(layer * 5 + c) * 3072 + col0 + cc] = s + p.b_mod[layer * 3072 + col0 + cc];
    }
    __syncthreads();
  }
  {
    float* tl = (float*)smem;
    const int r = tid >> 4, c4 = tid & 15, nl = tid >> 2, kq = tid & 3;
    const float* src = nullptr; h16* dst = nullptr; int lds_ = 0, ldd = 0, N = 0, k0 = 0, n0 = 0;
    f32x4 v[4];
#define TR_DECODE(it_)                                                                                                  \
    {                                                                                                                   \
      int NT_, tile_;                                                                                                   \
      if ((it_) < 4608) {                                                                                               \
        const int l = (it_) / 2304, rr_ = (it_) % 2304;                                                                 \
        if (rr_ < 768) { src = p.w_in + (size_t)l * 1024 * 2976; lds_ = 2976; dst = p.wt_in + (size_t)l * 3072 * 1024; ldd = 1024; N = 2976; NT_ = 48; tile_ = rr_; } \
        else if (rr_ < 1792) { src = p.w_merge + (size_t)l * 1024 * 4096; lds_ = 4096; dst = p.wt_merge + (size_t)l * 4096 * 1024; ldd = 1024; N = 4096; NT_ = 64; tile_ = rr_ - 768; } \
        else if (rr_ < 2048) { const int k = (rr_ - 1792) >> 6; src = p.w_branch + (size_t)(l * 4 + k) * 256 * 1024; lds_ = 1024; dst = p.wt_branch + (size_t)(l * 4 + k) * 1024 * 256; ldd = 256; N = 1024; NT_ = 16; tile_ = (rr_ - 1792) & 63; } \
        else { src = p.w_out + (size_t)l * 1048576; lds_ = 1024; dst = p.wt_out + (size_t)l * 1048576; ldd = 1024; N = 1024; NT_ = 16; tile_ = rr_ - 2048; } \
      } else {                                                                                                          \
        int rr_ = (it_) - 4608;                                                                                         \
        if (rr_ < 128) { const int m = rr_ >> 4; src = p.cache_a_v + (size_t)m * 512 * 128; lds_ = 128; dst = p.cvt_a + (size_t)m * 128 * 512; ldd = 512; N = 128; NT_ = 2; tile_ = rr_ & 15; } \
        else { rr_ -= 128; const int m = rr_ >> 5; src = p.cache_na_v + (size_t)m * 512 * 256; lds_ = 256; dst = p.cvt_n + (size_t)m * 256 * 512; ldd = 512; N = 256; NT_ = 4; tile_ = rr_ & 31; } \
      }                                                                                                                 \
      k0 = (tile_ / NT_) * 64; n0 = (tile_ % NT_) * 64;                                                                 \
      _Pragma("unroll") for (int q = 0; q < 4; q++) {                                                                   \
        v[q] = f32x4{0.f, 0.f, 0.f, 0.f};                                                                               \
        if (n0 + c4 * 4 < N) v[q] = __builtin_nontemporal_load((const f32x4*)(src + (size_t)(k0 + r + q * 16) * lds_ + n0 + c4 * 4));              \
      }                                                                                                                 \
    }
    int it = blockIdx.x, tstride = gridDim.x, tend = 4992;
    if (gridDim.x == 512) {
      if (blockIdx.x < 384) { tstride = 384; tend = 3072; }
      else { it = 3072 + (blockIdx.x - 384); tstride = 128; }
    }
    if (it < tend) TR_DECODE(it)
    while (it < tend) {
#pragma unroll
      for (int q = 0; q < 4; q++) {
        const int kl = r + q * 16;
        tl[kl * 65 + c4 * 4 + 0] = v[q][0];
        tl[kl * 65 + c4 * 4 + 1] = v[q][1];
        tl[kl * 65 + c4 * 4 + 2] = v[q][2];
        tl[kl * 65 + c4 * 4 + 3] = v[q][3];
      }
      h16* d = dst + (size_t)(n0 + nl) * ldd + k0 + kq * 16;
      it += tstride;
      if (it < tend) TR_DECODE(it)
      __syncthreads();
      h16x8 o0, o1;
#pragma unroll
      for (int i = 0; i < 8; i++) {
        o0[i] = (h16)tl[(kq * 16 + i) * 65 + nl];
        o1[i] = (h16)tl[(kq * 16 + 8 + i) * 65 + nl];
      }
      *(h16x8*)d = o0;
      *(h16x8*)(d + 8) = o1;
      __syncthreads();
    }
  }
}

__device__ void phase_norm(const Params p, int layer) {
  const int lane = otid() & 63, wid = otid() >> 6;
  const float* g = p.norm_g + layer * 1024;
  const int stride = gridDim.x * 4;
  for (int row0 = blockIdx.x * 4 + wid; row0 < T_ALL; row0 += 2 * stride) {
    const int row1 = row0 + stride;
    const bool has1 = row1 < T_ALL;
    const int r1 = has1 ? row1 : row0;
    const float* x0 = xptr(p, layer, row0);
    const float* x1 = xptr(p, layer, r1);
    f32x4 v0[4], v1[4];
    float s0 = 0.f, s1 = 0.f;
#pragma unroll
    for (int i = 0; i < 4; i++) {
      v0[i] = __builtin_nontemporal_load((const f32x4*)(x0 + i * 256 + lane * 4));
      v1[i] = __builtin_nontemporal_load((const f32x4*)(x1 + i * 256 + lane * 4));
    }
#pragma unroll
    for (int i = 0; i < 4; i++) {
      s0 += v0[i][0] * v0[i][0] + v0[i][1] * v0[i][1] + v0[i][2] * v0[i][2] + v0[i][3] * v0[i][3];
      s1 += v1[i][0] * v1[i][0] + v1[i][1] * v1[i][1] + v1[i][2] * v1[i][2] + v1[i][3] * v1[i][3];
    }
    s0 = wave_sum(s0);
    s1 = wave_sum(s1);
    const float rs0 = rsqrtf(s0 * (1.f / 1024.f) + 1e-6f), rs1 = rsqrtf(s1 * (1.f / 1024.f) + 1e-6f);
    const float* m0 = p.modv + (layer * 5 + cond_of(row0)) * 3072;
    const float* m1 = p.modv + (layer * 5 + cond_of(r1)) * 3072;
    f32x4 ggv[4], sh0v[4], sc0v[4], sh1v[4], sc1v[4];
#pragma unroll
    for (int i = 0; i < 4; i++) {
      const int k = i * 256 + lane * 4;
      ggv[i] = *(const f32x4*)(g + k);
      sh0v[i] = *(const f32x4*)(m0 + k); sc0v[i] = *(const f32x4*)(m0 + 1024 + k);
      sh1v[i] = *(const f32x4*)(m1 + k); sc1v[i] = *(const f32x4*)(m1 + 1024 + k);
    }
#pragma unroll
    for (int i = 0; i < 4; i++) {
      const int k = i * 256 + lane * 4;
      const f32x4 gg = ggv[i], sh0 = sh0v[i], sc0 = sc0v[i], sh1 = sh1v[i], sc1 = sc1v[i];
      const f32x4 o0 = v0[i] * rs0 * gg * (sc0 + 1.f) + sh0;
      const f32x4 o1 = v1[i] * rs1 * gg * (sc1 + 1.f) + sh1;
      store_h4(p.hbuf + (size_t)row0 * 1024 + k, o0[0], o0[1], o0[2], o0[3]);
      if (has1) store_h4(p.hbuf + (size_t)row1 * 1024 + k, o1[0], o1[1], o1[2], o1[3]);
    }
  }
}

__device__ void phase_final(const Params p) {
  const int lane = otid() & 63, wid = otid() >> 6;
  const float* g = p.final_norm_g;
  const int stride = gridDim.x * 4;
  for (int row0 = blockIdx.x * 4 + wid; row0 < T_ALL; row0 += 2 * stride) {
    const int row1 = row0 + stride;
    const bool has1 = row1 < T_ALL;
    float* x0 = p.out + (size_t)row0 * 1024;
    float* x1 = p.out + (size_t)(has1 ? row1 : row0) * 1024;
    f32x4 v0[4], v1[4];
    float s0 = 0.f, s1 = 0.f;
#pragma unroll
    for (int i = 0; i < 4; i++) {
      v0[i] = __builtin_nontemporal_load((const f32x4*)(x0 + i * 256 + lane * 4));
      v1[i] = __builtin_nontemporal_load((const f32x4*)(x1 + i * 256 + lane * 4));
    }
#pragma unroll
    for (int i = 0; i < 4; i++) {
      s0 += v0[i][0] * v0[i][0] + v0[i][1] * v0[i][1] + v0[i][2] * v0[i][2] + v0[i][3] * v0[i][3];
      s1 += v1[i][0] * v1[i][0] + v1[i][1] * v1[i][1] + v1[i][2] * v1[i][2] + v1[i][3] * v1[i][3];
    }
    s0 = wave_sum(s0);
    s1 = wave_sum(s1);
    const float rs0 = rsqrtf(s0 * (1.f / 1024.f) + 1e-6f), rs1 = rsqrtf(s1 * (1.f / 1024.f) + 1e-6f);
    f32x4 ggv[4];
#pragma unroll
    for (int i = 0; i < 4; i++) ggv[i] = *(const f32x4*)(g + i * 256 + lane * 4);
#pragma unroll
    for (int i = 0; i < 4; i++) {
      const int k = i * 256 + lane * 4;
      const f32x4 gg = ggv[i];
      __builtin_nontemporal_store(v0[i] * rs0 * gg, (f32x4*)(x0 + k));
      if (has1) __builtin_nontemporal_store(v1[i] * rs1 * gg, (f32x4*)(x1 + k));
    }
  }
}

__device__ void phase_g1(const Params p, int layer, char* smem) {
  const int lane = otid() & 63, wid = otid() >> 6, wr = wid >> 1, wc = wid & 1, l15 = lane & 15, g = lane >> 4;
  const h16* Wt = p.wt_in + (size_t)layer * 3072 * 1024;
  for (int tile = blockIdx.x; tile < 128 * 24; tile += gridDim.x) {
    const int rt = tile / 24, ct = tile % 24;
    const int r0 = rt * 128, n0 = ct * 128;
    f32x4 acc[4][4];
    zero_acc(acc);
    gemm_acc<128, 128>(acc, p.hbuf + (size_t)r0 * 1024, 1024, Wt + (size_t)n0 * 1024, 1024, 1024, smem);
    const bool ctx = r0 < T_CTX;
#pragma unroll
    for (int ni = 0; ni < 4; ni++) {
      const int col = n0 + wc * 64 + ni * 16 + 4 * g;
      if (col >= ZLD) continue;
      const int fb = n0 + wc * 64 + ni * 16;
#pragma unroll
      for (int mi = 0; mi < 4; mi++) {
        const int tok = r0 + wr * 64 + mi * 16 + l15;
        f32x4 v = acc[mi][ni];
        store_h4(p.zbuf + (size_t)tok * ZLD + col, v[0], v[1], v[2], v[3]);
        int b, l, Ls;
        if (ctx) { b = tok >> 8; l = tok & 255; Ls = 256; } else { b = (tok - T_CTX) >> 11; l = (tok - T_CTX) & 2047; Ls = 2048; }
        if (fb >= 384 && fb < 512) {
          h16* vt = p.vt_a_ctx + (ctx ? 0 : 1048576);
          int cc = col - 384;
#pragma unroll
          for (int j = 0; j < 4; j++) vt[((size_t)(b * 2 + ((cc + j) >> 6)) * 64 + ((cc + j) & 63)) * Ls + l] = (h16)v[j];
        } else if (fb >= 2464 && fb < 2720) {
          h16* vt = p.vt_d_ctx + (ctx ? 0 : 2097152);
          int cc = col - 2464;
#pragma unroll
          for (int j = 0; j < 4; j++) vt[((size_t)(b * 4 + ((cc + j) >> 6)) * 64 + ((cc + j) & 63)) * Ls + l] = (h16)v[j];
        }
        if (ctx) {
          const size_t rowi = (size_t)(b * 2 + layer) * 256 + l;
          const f32x4 fv = v;
          if (fb >= 256 && fb < 384) __builtin_nontemporal_store(fv, (f32x4*)(p.out + O_AK + rowi * 128 + (col - 256)));
          else if (fb >= 384 && fb < 512) __builtin_nontemporal_store(fv, (f32x4*)(p.out + O_AV + rowi * 128 + (col - 384)));
          else if (fb >= 1152 && fb < 1184) __builtin_nontemporal_store(fv, (f32x4*)(p.out + O_KPE + rowi * 32 + (col - 1152)));
          else if (fb >= 2208 && fb < 2464) __builtin_nontemporal_store(fv, (f32x4*)(p.out + O_NK + rowi * 256 + (col - 2208)));
          else if (fb >= 2464 && fb < 2720) __builtin_nontemporal_store(fv, (f32x4*)(p.out + O_NV + rowi * 256 + (col - 2464)));
        }
      }
    }
  }
}

#define BUS 136
__device__ void s5_item(const Params p, int layer, int mode0, int b0, int g0, int chunk0, int mode1, int b1, int g1, int chunk1, char* smem) {
  const int tid = otid(), lane = tid & 63, wid = tid >> 6, l15 = lane & 15, gq = lane >> 4;
  const int pr = wid >> 1, ptid = tid & 127;
  const int mode = pr ? mode1 : mode0, b = pr ? b1 : b0, g = pr ? g1 : g0, chunk = pr ? chunk1 : chunk0;
  char* pbase = smem + pr * 33280;
  h16* su = (h16*)pbase;
  h16* sbu = su + 256 * 16;
  h16* sy = sbu + 2 * 16 * BUS;
  const int tok0 = (mode == 0) ? b * 256 : T_CTX + b * 2048 + chunk * 256;
  if (mode >= 0) {
    for (int i = ptid; i < 512; i += 128) {
      int t = i >> 1, hf = i & 1;
      *(u32x4*)(su + t * 16 + hf * 8) = *(const u32x4*)(p.zbuf + (size_t)(tok0 + t) * ZLD + 1440 + g * 16 + hf * 8);
    }
  }
  __syncthreads();
  if (mode >= 0) {
    const int dir = wid & 1;
    const int ldg = (layer * 2 + dir) * 16 + g;
    const float ar = p.s5_abar[(ldg * 64 + lane) * 2], ai = p.s5_abar[(ldg * 64 + lane) * 2 + 1];
    const float dt = p.s5_dt[ldg];
    float hr = 0.f, hi = 0.f;
    if (mode == 2) {
      const size_t sidx = ((((size_t)b * 2 + layer) * 2 + dir) * 16 + g) * 64 + lane;
      hr = p.state_re[sidx];
      hi = p.state_im[sidx];
      float lr = p.s5_lamdt[(ldg * 64 + lane) * 2] * 256.f, li = p.s5_lamdt[(ldg * 64 + lane) * 2 + 1] * 256.f;
      float er = expf(lr), sn, cs;
      sincosf(li, &sn, &cs);
      const float pr = er * cs, pi = er * sn;
      const float* e = p.s5_e + ((((size_t)b * 16 + g) * 2 + dir) * 8) * 128;
      float ev_r[8], ev_i[8];
#pragma unroll
      for (int c2 = 0; c2 < 8; c2++) { ev_r[c2] = e[c2 * 128 + lane * 2]; ev_i[c2] = e[c2 * 128 + lane * 2 + 1]; }
      if (dir == 0) {
#pragma unroll
        for (int c2 = 0; c2 < 8; c2++)
          if (c2 < chunk) { const float nr = pr * hr - pi * hi + ev_r[c2], ni = pr * hi + pi * hr + ev_i[c2]; hr = nr; hi = ni; }
      } else {
#pragma unroll
        for (int c2 = 7; c2 >= 0; c2--)
          if (c2 > chunk) { const float nr = pr * hr - pi * hi + ev_r[c2], ni = pr * hi + pi * hr + ev_i[c2]; hr = nr; hi = ni; }
      }
    }
    h16x4 bfr[8];
    const h16* bmt = p.s5_bmt + (size_t)ldg * 128 * 16;
#pragma unroll
    for (int nf = 0; nf < 8; nf++) bfr[nf] = *(const h16x4*)(bmt + (nf * 16 + l15) * 16 + 4 * gq);
    h16x8 cfr[4];
    const h16* cmt = p.s5_cmt + (size_t)ldg * 16 * 128;
#pragma unroll
    for (int ks = 0; ks < 4; ks++) cfr[ks] = *(const h16x8*)(cmt + l15 * 128 + ks * 32 + 8 * gq);
    h16* bu = sbu + dir * 16 * BUS;
    h16* ydir = sy + dir * 256 * 16;
    for (int sub = 0; sub < 16; sub++) {
      const int sc = dir == 0 ? sub : 15 - sub;
      const int tt0 = sc * 16;
      h16x4 ua = *(const h16x4*)(su + (tt0 + l15) * 16 + 4 * gq);
#pragma unroll
      for (int nf = 0; nf < 8; nf++) {
        f32x4 r = __builtin_amdgcn_mfma_f32_16x16x16f16(bfr[nf], ua, f32x4{0.f, 0.f, 0.f, 0.f}, 0, 0, 0);
        store_h4(bu + l15 * BUS + nf * 16 + 4 * gq, r[0], r[1], r[2], r[3]);
      }
      __builtin_amdgcn_wave_barrier();
      {
        float vr[16], vi[16];
#pragma unroll
        for (int s = 0; s < 16; s++) { vr[s] = (float)bu[s * BUS + lane]; vi[s] = (float)bu[s * BUS + 64 + lane]; }
        if (dir == 0) {
#pragma unroll
          for (int s = 0; s < 16; s++) {
            const float nr = ar * hr - ai * hi + dt * vr[s], ni = ar * hi + ai * hr + dt * vi[s];
            hr = nr; hi = ni; vr[s] = nr; vi[s] = ni;
          }
        } else {
#pragma unroll
          for (int s = 15; s >= 0; s--) {
            const float nr = ar * hr - ai * hi + dt * vr[s], ni = ar * hi + ai * hr + dt * vi[s];
            hr = nr; hi = ni; vr[s] = nr; vi[s] = ni;
          }
        }
#pragma unroll
        for (int s = 0; s < 16; s++) { bu[s * BUS + lane] = (h16)vr[s]; bu[s * BUS + 64 + lane] = (h16)vi[s]; }
      }
      __builtin_amdgcn_wave_barrier();
      if (mode != 1) {
        f32x4 y = {0.f, 0.f, 0.f, 0.f};
#pragma unroll
        for (int ks = 0; ks < 4; ks++) {
          h16x8 ha = *(const h16x8*)(bu + l15 * BUS + ks * 32 + 8 * gq);
          y = __builtin_amdgcn_mfma_f32_16x16x32_f16(cfr[ks], ha, y, 0, 0, 0);
        }
        store_h4(ydir + (tt0 + l15) * 16 + 4 * gq, y[0], y[1], y[2], y[3]);
      }
      __builtin_amdgcn_wave_barrier();
    }
    if (mode == 0) {
      const size_t oi = ((((size_t)b * 2 + layer) * 2 + dir) * 16 + g) * 64 + lane;
      p.out[O_SRE + oi] = hr;
      p.out[O_SIM + oi] = hi;
    } else if (mode == 1) {
      float* e = p.s5_e + (((((size_t)b * 16 + g) * 2 + dir) * 8) + chunk) * 128;
      e[lane * 2] = hr;
      e[lane * 2 + 1] = hi;
    }
  }
  __syncthreads();
  if (mode == 0 || mode == 2) {
    const float dsk = p.s5_d[layer * 256 + g * 16 + (ptid & 15)];
    for (int i = ptid; i < 256 * 16; i += 128) {
      int t = i >> 4, c = i & 15;
      float u = (float)su[i];
      float v = (float)sy[i] + (float)sy[256 * 16 + i] + dsk * u;
      p.zbuf[(size_t)(tok0 + t) * ZLD + 1440 + g * 16 + c] = (h16)geluf_(v);
    }
  }
  __syncthreads();
}


template <int NCOL>
__device__ __forceinline__ void row_rstd(const h16* __restrict__ base, float* rs) {
  const int tid = otid(), row = tid >> 1, hf = tid & 1;
  const h16* ptr = base + (size_t)row * ZLD + hf * (NCOL / 2);
  float s = 0.f;
#pragma unroll
  for (int i = 0; i < NCOL / 16; i++) {
    h16x8 v = *(const h16x8*)(ptr + i * 8);
#pragma unroll
    for (int j = 0; j < 8; j++) s += (float)v[j] * (float)v[j];
  }
  s += __shfl_xor(s, 1);
  if (hf == 0) rs[row] = rsqrtf(s * (1.f / NCOL) + 1e-6f);
}

__device__ void phase_g2(const Params p, int layer, char* smem) {
  const int tid = otid(), lane = tid & 63, wid = tid >> 6, wr = wid >> 1, wc = wid & 1, l15 = lane & 15, g = lane >> 4;
  for (int it = blockIdx.x; it < 512; it += gridDim.x)
    s5_item(p, layer, 0, it >> 4, it & 15, 0, 1, it >> 7, (it >> 3) & 15, it & 7, smem);
  for (int it = blockIdx.x; it < 768; it += gridDim.x) {
    {
      const int rt = it / 6, ct = it % 6, r0 = rt * 128, n0 = ct * 64;
      float* rs = (float*)(smem + 49152);
      row_rstd<256>(p.zbuf + (size_t)r0 * ZLD + 768, rs);
      f32x4 acc[4][2];
      zero_acc(acc);
      gemm_acc<128, 64>(acc, p.zbuf + (size_t)r0 * ZLD + 768, ZLD, p.wt_qup + (size_t)layer * 384 * 256 + (size_t)n0 * 256, 256, 256, smem);
      __syncthreads();
      const bool lat = r0 >= T_CTX;
#pragma unroll
      for (int mi = 0; mi < 4; mi++) {
        const int row = wr * 64 + mi * 16 + l15, tok = r0 + row;
        const float rstd = rs[row];
#pragma unroll
        for (int ni = 0; ni < 2; ni++) {
          const int fb = n0 + wc * 32 + ni * 16;
          f32x4 v = acc[mi][ni] * rstd;
          store_h4(p.qm + (size_t)tok * 384 + fb + 4 * g, v[0], v[1], v[2], v[3]);
        }
      }
      __syncthreads();
      if (lat && ct != 0 && ct != 3) {
        const int rc0 = n0 + ((ct == 2 || ct == 5) ? 32 : 0);
        float rx1[8], rx2[8], rcs[8], rsn[8];
#pragma unroll
        for (int q = 0; q < 8; q++) {
          const int i = tid + q * 256, row = i >> 4, e = i & 15, tok = r0 + row;
          const int i8 = e & 7, base = (e < 8) ? 0 : 16;
          const int lpos = (tok - T_CTX) & 2047;
          const int pos = (e < 8) ? (lpos >> 6) : (lpos & 63);
          const h16* ptr = p.qm + (size_t)tok * 384 + rc0 + base + i8;
          rx1[q] = (float)ptr[0]; rx2[q] = (float)ptr[8];
          rcs[q] = p.cs8[(pos * 8 + i8) * 2]; rsn[q] = p.cs8[(pos * 8 + i8) * 2 + 1];
        }
#pragma unroll
        for (int q = 0; q < 8; q++) {
          const int i = tid + q * 256, row = i >> 4, e = i & 15, tok = r0 + row;
          const int i8 = e & 7, base = (e < 8) ? 0 : 16;
          h16* ptr = p.qm + (size_t)tok * 384 + rc0 + base + i8;
          ptr[0] = (h16)(rx1[q] * rcs[q] - rx2[q] * rsn[q]);
          ptr[8] = (h16)(rx1[q] * rsn[q] + rx2[q] * rcs[q]);
        }
      }
      __syncthreads();
    }
  }
  for (int it = gridDim.x - 1 - blockIdx.x; it < 1024 + 128; it += gridDim.x) {
    const int N_KV = 1024;
    {
      const bool cached = it >= N_KV;
      int rt, ct;
      const h16 *A, *Bt;
      int lda;
      if (!cached) { rt = it >> 3; ct = it & 7; A = p.zbuf + (size_t)(rt * 128) * ZLD + 1024; lda = ZLD; Bt = p.wt_kvup + (size_t)layer * 512 * 128; }
      else { int i2 = it - N_KV; rt = i2 >> 3; ct = i2 & 7; int b = rt >> 2, k0 = (rt & 3) * 128; A = p.ckv_c + ((size_t)(b * 2 + layer) * 512 + k0) * 128; lda = 128; Bt = p.wt_kvraw + (size_t)layer * 512 * 128; }
      const int r0 = rt * 128, n0 = ct * 64;
      float* rs = (float*)(smem + 49152);
      if (!cached) {
        row_rstd<128>(p.zbuf + (size_t)r0 * ZLD + 1024, rs);
      } else {
        if (tid < 128) rs[tid] = 1.f;
      }
      f32x4 acc[4][2];
      zero_acc(acc);
      gemm_acc<128, 64>(acc, A, lda, Bt + (size_t)n0 * 128, 128, 128, smem);
      const int head = n0 >> 7;
      const bool vtype = (n0 & 64) != 0;
#pragma unroll
      for (int mi = 0; mi < 4; mi++) {
        const int row = wr * 64 + mi * 16 + l15, tok = r0 + row;
        const float rstd = rs[row];
#pragma unroll
        for (int ni = 0; ni < 2; ni++) {
          const int d0 = wc * 32 + ni * 16 + 4 * g;
          f32x4 v = acc[mi][ni] * rstd;
          if (!vtype) {
            h16* dst = p.kmla + (cached ? (size_t)T_ALL * 384 : (size_t)0);
            store_h4(dst + (size_t)tok * 384 + head * 96 + d0, v[0], v[1], v[2], v[3]);
          } else {
            h16* vt; int bb, l, Ls;
            int voff;
            if (cached) { voff = 4194304; bb = tok >> 9; l = tok & 511; Ls = 512; }
            else if (tok < T_CTX) { voff = 0; bb = tok >> 8; l = tok & 255; Ls = 256; }
            else { voff = 2097152; bb = (tok - T_CTX) >> 11; l = (tok - T_CTX) & 2047; Ls = 2048; }
            vt = p.vt_m_ctx + voff;
#pragma unroll
            for (int j = 0; j < 4; j++) vt[((size_t)(bb * 4 + head) * 64 + d0 + j) * Ls + l] = (h16)v[j];
          }
        }
      }
      if (ct == 0 && !cached && r0 < T_CTX) {
        const float* gk = p.mla_kv_norm + layer * 128;
#pragma unroll
        for (int q = 0; q < 8; q++) {
          const int i = tid + q * 256, row = i >> 4, k = (i & 15) * 8, tok = r0 + row;
          const h16x8 zv = *(const h16x8*)(p.zbuf + (size_t)tok * ZLD + 1024 + k);
          const float rr = rs[row];
          const f32x4 g0 = *(const f32x4*)(gk + k), g1 = *(const f32x4*)(gk + k + 4);
          float* dst = p.out + O_CKV + ((size_t)((tok >> 8) * 2 + layer) * 256 + (tok & 255)) * 128 + k;
          __builtin_nontemporal_store(f32x4{(float)zv[0] * rr * g0[0], (float)zv[1] * rr * g0[1], (float)zv[2] * rr * g0[2], (float)zv[3] * rr * g0[3]}, (f32x4*)dst);
          __builtin_nontemporal_store(f32x4{(float)zv[4] * rr * g1[0], (float)zv[5] * rr * g1[1], (float)zv[6] * rr * g1[2], (float)zv[7] * rr * g1[3]}, (f32x4*)(dst + 4));
        }
      }
      if (ct == 1) {
        float kx1[8], kx2[8];
#pragma unroll
        for (int q = 0; q < 8; q++) {
          const int i = tid + q * 256, row = i >> 4, e = i & 15, tok = r0 + row;
          if (cached) {
            const int bb = tok >> 9, key = tok & 511;
            const float* src = p.cache_mla_kpe + ((size_t)(bb * 2 + layer) * 512 + key) * 32;
            kx1[q] = src[e]; kx2[q] = src[16 + e];
          } else {
            const h16* src = p.zbuf + (size_t)tok * ZLD + 1152;
            const int i8 = e & 7, base = (e < 8) ? 0 : 16;
            float x1 = (float)src[base + i8], x2 = (float)src[base + 8 + i8];
            if (tok >= T_CTX) {
              const int lpos = (tok - T_CTX) & 2047;
              const int pos = (e < 8) ? (lpos >> 6) : (lpos & 63);
              const float cs = p.cs8[(pos * 8 + i8) * 2], sn = p.cs8[(pos * 8 + i8) * 2 + 1];
              const float o1 = x1 * cs - x2 * sn, o2 = x1 * sn + x2 * cs;
              x1 = o1; x2 = o2;
            }
            kx1[q] = x1; kx2[q] = x2;
          }
        }
#pragma unroll
        for (int q = 0; q < 8; q++) {
          const int i = tid + q * 256, row = i >> 4, e = i & 15, tok = r0 + row;
          const h16 v1 = (h16)kx1[q], v2 = (h16)kx2[q];
          if (cached) {
            h16* dst = p.kmla + (size_t)T_ALL * 384 + (size_t)tok * 384;
#pragma unroll
            for (int h = 0; h < 4; h++) { dst[h * 96 + 64 + e] = v1; dst[h * 96 + 80 + e] = v2; }
          } else {
            const int i8 = e & 7, base = (e < 8) ? 0 : 16;
            h16* dst = p.kmla + (size_t)tok * 384;
#pragma unroll
            for (int h = 0; h < 4; h++) { dst[h * 96 + 64 + base + i8] = v1; dst[h * 96 + 64 + base + 8 + i8] = v2; }
          }
        }
      }
      __syncthreads();
    }
  }
  for (int it = (blockIdx.x + (gridDim.x >> 1)) % gridDim.x; it < 128; it += gridDim.x) {
    {
      const int t0 = T_CTX + it * 64;
#pragma unroll
      for (int q = 0; q < 6; q++) {
        const int i = tid + q * 256;
        const int tl = i / 24, vi = i % 24;
        const int tok = t0 + tl, lpos = (tok - T_CTX) & 2047;
        const int head = vi >> 2, part = (vi >> 1) & 1, grp = vi & 1;
        const int pos = part ? (lpos & 63) : (lpos >> 6);
        h16* ptr = p.zbuf + (size_t)tok * ZLD + head * 64 + part * 32 + grp * 8;
        const h16x8 x1 = *(const h16x8*)ptr, x2 = *(const h16x8*)(ptr + 16);
        const float* tb = p.cs16 + (pos * 16 + grp * 8) * 2;
        h16x8 o1, o2;
#pragma unroll
        for (int j = 0; j < 8; j++) {
          const float cs = tb[2 * j], sn = tb[2 * j + 1];
          o1[j] = (h16)((float)x1[j] * cs - (float)x2[j] * sn);
          o2[j] = (h16)((float)x1[j] * sn + (float)x2[j] * cs);
        }
        *(h16x8*)ptr = o1;
        *(h16x8*)(ptr + 16) = o2;
      }
    }
  }
}

struct Seg { const h16* K; const h16* Vt; int ldk, ldv, ntiles; };

#define LDSP(x) ((__attribute__((address_space(3))) unsigned*)(x))
template <int DQK, int MODE, int QREP>
__device__ void attn_item(const h16* __restrict__ Q, int ldq, Seg s0, Seg s1, float scale_l2, bool has_sink, float sink_l2,
                          int qpos0, int kpos0, const float* __restrict__ rpb_h, int qrow, int krow0,
                          h16* __restrict__ outp, const h16* __restrict__ gate, char* smem) {
  constexpr int KCH = DQK / 8;
  constexpr int KROWB = DQK * 2;
  constexpr int KPT = 64 * KCH / 256;
  constexpr int KBYTES = 64 * KROWB;
  constexpr int STAGE = KBYTES + 8192;
  constexpr int NKS = DQK / 32;
  constexpr int G = KPT + 2;
  const int tid = otid(), lane = tid & 63, wid = tid >> 6, l15 = lane & 15, g = lane >> 4;
  float* sbias = (float*)(smem + 49152);
  if (MODE == 2) {
    for (int i = tid; i < 15 * 31; i += 256) sbias[i] = rpb_h[i] * LOG2E;
  }
  h16x8 qf[QREP][NKS];
#pragma unroll
  for (int qi = 0; qi < QREP; qi++)
#pragma unroll
    for (int ks = 0; ks < NKS; ks++) {
      h16x8 qv = *(const h16x8*)(Q + (size_t)(wid * 16 * QREP + qi * 16 + l15) * ldq + ks * 32 + 8 * g);
#pragma unroll
      for (int j = 0; j < 8; j++) qv[j] = (h16)((float)qv[j] * scale_l2);
      qf[qi][ks] = qv;
    }
  float m[QREP], lsum[QREP];
  f32x4 o[QREP][4];
#pragma unroll
  for (int qi = 0; qi < QREP; qi++) {
    m[qi] = has_sink ? sink_l2 : -1e30f;
    lsum[qi] = (has_sink && g == 0) ? 1.f : 0.f;
#pragma unroll
    for (int i = 0; i < 4; i++) o[qi][i] = f32x4{0.f, 0.f, 0.f, 0.f};
  }
  const int ntot = s0.ntiles + s1.ntiles;
  const int lsl = (tid & 7) ^ ((tid >> 4) & 7);
#define TILE_PTRS(ti_) \
    const h16 *kp, *vp; int ldk, ldv; \
    if ((ti_) < s0.ntiles) { kp = s0.K + (size_t)(ti_) * 64 * s0.ldk; vp = s0.Vt + (ti_) * 64; ldk = s0.ldk; ldv = s0.ldv; } \
    else { int t2 = (ti_) - s0.ntiles; kp = s1.K + (size_t)t2 * 64 * s1.ldk; vp = s1.Vt + t2 * 64; ldk = s1.ldk; ldv = s1.ldv; }
#define ATT_ISSUE(ti_, st_)                                                                                         \
  {                                                                                                                 \
    TILE_PTRS(ti_)                                                                                                  \
    char* dk_ = smem + (st_) * STAGE + tid * 16;                                                                    \
    _Pragma("unroll") for (int i = 0; i < KPT; i++) {                                                               \
      const h16* src_;                                                                                              \
      if (DQK == 64) src_ = kp + (size_t)((tid >> 3) + i * 32) * ldk + lsl * 8;                                     \
      else { const int c_ = tid + i * 256; src_ = kp + (size_t)(c_ / KCH) * ldk + (c_ % KCH) * 8; }                 \
      __builtin_amdgcn_global_load_lds((const unsigned*)src_, LDSP(dk_ + i * 4096), 16, 0, 0);                      \
    }                                                                                                               \
    _Pragma("unroll") for (int i = 0; i < 2; i++)                                                                   \
      __builtin_amdgcn_global_load_lds((const unsigned*)(vp + (size_t)((tid >> 3) + i * 32) * ldv + lsl * 8), LDSP(dk_ + KBYTES + i * 4096), 16, 0, 0); \
  }
  asm volatile("s_waitcnt vmcnt(0)" ::: "memory");
  ATT_ISSUE(0, 0)
  if (ntot > 1) ATT_ISSUE(1, 1)
  int st = 0;
  for (int ti = 0; ti < ntot; ti++) {
    if (ti + 1 < ntot) asm volatile("s_waitcnt vmcnt(%0)" ::"n"(G) : "memory");
    else asm volatile("s_waitcnt vmcnt(0)" ::: "memory");
    asm volatile("s_waitcnt lgkmcnt(0)" ::: "memory");
    __builtin_amdgcn_s_barrier();
    asm volatile("" ::: "memory");
    if (ti + 2 < ntot) { const int st2 = (st == 0) ? 2 : st - 1; ATT_ISSUE(ti + 2, st2) }
    const char* sk = smem + st * STAGE;
    const char* sv = sk + KBYTES;
    st = (st == 2) ? 0 : st + 1;
    f32x4 s[QREP][4];
#pragma unroll
    for (int kf = 0; kf < 4; kf++) {
#pragma unroll
      for (int qi = 0; qi < QREP; qi++) s[qi][kf] = f32x4{0.f, 0.f, 0.f, 0.f};
#pragma unroll
      for (int ks = 0; ks < NKS; ks++) {
        const int row = kf * 16 + l15, sl = ks * 4 + g;
        const int off = (DQK == 64) ? SWZ(row, sl) : (row * KROWB + sl * 16);
        h16x8 ka = *(const h16x8*)(sk + off);
#pragma unroll
        for (int qi = 0; qi < QREP; qi++) s[qi][kf] = __builtin_amdgcn_mfma_f32_16x16x32_f16(ka, qf[qi][ks], s[qi][kf], 0, 0, 0);
      }
    }
    const bool masked = (MODE != 0) && (ti < s0.ntiles);
    typedef float f32x2 __attribute__((ext_vector_type(2)));
    h16x8 pb[QREP][2];
    float alpha[QREP];
#pragma unroll
    for (int qi = 0; qi < QREP; qi++) {
      if (MODE != 0 && masked) {
#pragma unroll
        for (int kf = 0; kf < 4; kf++)
#pragma unroll
          for (int j = 0; j < 4; j++) {
            float x = s[qi][kf][j];
            if (MODE == 1) {
              int kpos = kpos0 + ti * 64 + kf * 16 + 4 * g + j, qpos = qpos0 + wid * 16 * QREP + qi * 16 + l15;
              int d = qpos - kpos;
              if (d > 128 || d < -128) x = -INFINITY;
            }
            if (MODE == 2) {
              int ck = kf * 16 + 4 * g + j, cq = wid * 16 * QREP + qi * 16 + l15;
              int cs = min(max(cq - 8, 0), 48);
              int rel = ck - cs;
              if (rel < 0 || rel >= 16) x = -INFINITY;
              else {
                int co = min(max(ck - cq, -15), 15) + 15;
                int ro = (krow0 + ti) - qrow + 7;
                x += sbias[ro * 31 + co];
              }
            }
            s[qi][kf][j] = x;
          }
      }
      float mx = fmaxf(fmaxf(fmaxf(s[qi][0][0], s[qi][0][1]), fmaxf(s[qi][0][2], s[qi][0][3])), fmaxf(fmaxf(s[qi][1][0], s[qi][1][1]), fmaxf(s[qi][1][2], s[qi][1][3])));
      mx = fmaxf(mx, fmaxf(fmaxf(fmaxf(s[qi][2][0], s[qi][2][1]), fmaxf(s[qi][2][2], s[qi][2][3])), fmaxf(fmaxf(s[qi][3][0], s[qi][3][1]), fmaxf(s[qi][3][2], s[qi][3][3]))));
      mx = fmaxf(mx, __shfl_xor(mx, 16));
      mx = fmaxf(mx, __shfl_xor(mx, 32));
      const float mnew = fmaxf(m[qi], mx);
      alpha[qi] = __builtin_amdgcn_exp2f(m[qi] - mnew);
      m[qi] = mnew;
      const f32x2 mn2 = {mnew, mnew};
      f32x2 ps2 = {0.f, 0.f};
#pragma unroll
      for (int kf = 0; kf < 4; kf++)
#pragma unroll
        for (int jp = 0; jp < 2; jp++) {
          f32x2 d2 = f32x2{s[qi][kf][2 * jp], s[qi][kf][2 * jp + 1]} - mn2;
          f32x2 e2 = {__builtin_amdgcn_exp2f(d2[0]), __builtin_amdgcn_exp2f(d2[1])};
          ps2 += e2;
          pb[qi][kf >> 1][(kf & 1) * 4 + 2 * jp] = (h16)e2[0];
          pb[qi][kf >> 1][(kf & 1) * 4 + 2 * jp + 1] = (h16)e2[1];
        }
      lsum[qi] = lsum[qi] * alpha[qi] + (ps2[0] + ps2[1]);
    }
#pragma unroll
    for (int df = 0; df < 4; df++) {
#pragma unroll
      for (int qi = 0; qi < QREP; qi++) o[qi][df] = o[qi][df] * alpha[qi];
#pragma unroll
      for (int kk = 0; kk < 2; kk++) {
        const int row = df * 16 + l15;
        const int c0 = 8 * kk + g, c1 = 8 * kk + 4 + g;
        h16x4 v0 = *(const h16x4*)(sv + SWZ(row, c0 >> 1) + (c0 & 1) * 8);
        h16x4 v1 = *(const h16x4*)(sv + SWZ(row, c1 >> 1) + (c1 & 1) * 8);
        h16x8 va = {v0[0], v0[1], v0[2], v0[3], v1[0], v1[1], v1[2], v1[3]};
#pragma unroll
        for (int qi = 0; qi < QREP; qi++) o[qi][df] = __builtin_amdgcn_mfma_f32_16x16x32_f16(va, pb[qi][kk], o[qi][df], 0, 0, 0);
      }
    }
  }
  asm volatile("" ::: "memory");
  __builtin_amdgcn_s_barrier();
  asm volatile("" ::: "memory");
#pragma unroll
  for (int qi = 0; qi < QREP; qi++) {
    float l = lsum[qi];
    l += __shfl_xor(l, 16);
    l += __shfl_xor(l, 32);
    const float inv = 1.f / l;
    const int qr = wid * 16 * QREP + qi * 16 + l15;
    h16x4 gva[4];
#pragma unroll
    for (int df = 0; df < 4; df++) gva[df] = *(const h16x4*)(gate + (size_t)qr * ZLD + df * 16 + 4 * g);
#pragma unroll
    for (int df = 0; df < 4; df++) {
      const int d = df * 16 + 4 * g;
      const h16x4 gv = gva[df];
      store_h4(outp + (size_t)qr * 1024 + d, o[qi][df][0] * inv * siluf_((float)gv[0]), o[qi][df][1] * inv * siluf_((float)gv[1]),
               o[qi][df][2] * inv * siluf_((float)gv[2]), o[qi][df][3] * inv * siluf_((float)gv[3]));
    }
  }
}

__device__ void phase_att(const Params p, int layer, char* smem) {
  const float sc64 = 0.125f * LOG2E, sc96 = 0.10206207261596575f * LOG2E;
  Seg s0, s1;
  for (int vb = blockIdx.x; vb < 512; vb += gridDim.x) {
    const bool first = vb < 256;
    const int i = (vb & 7) * 32 + ((vb >> 3) & 31);
    {
      const int idx = vb;
      s5_item(p, layer, 2, idx >> 7, (idx >> 3) & 15, idx & 7, -1, 0, 0, 0, smem);
    }
    if (first)
    for (int e3 = 0; e3 < 2; e3++) {
      const bool first = e3 == 0;
      int b, h, tokb, tok0;
      if (first) { b = i >> 6; h = (i >> 4) & 3; tokb = T_CTX + b * 2048; tok0 = tokb + (i & 15) * 128; }
      else { b = i >> 3; h = (i >> 1) & 3; tokb = b * 256; tok0 = tokb + (i & 1) * 128; }
      s0.K = p.kmla + (size_t)tokb * 384 + h * 96; s0.ldk = 384;
      if (first) {
        s0.Vt = p.vt_m_lat + (size_t)(b * 4 + h) * 64 * 2048; s0.ldv = 2048; s0.ntiles = 32;
        s1.K = p.kcx + (size_t)(b * 512) * 384 + h * 96; s1.ldk = 384; s1.Vt = p.vcx_t + (size_t)(b * 4 + h) * 64 * 512; s1.ldv = 512; s1.ntiles = 8;
      } else {
        s0.Vt = p.vt_m_ctx + (size_t)(b * 4 + h) * 64 * 256; s0.ldv = 256; s0.ntiles = 4;
        s1.K = s0.K; s1.Vt = s0.Vt; s1.ldk = 0; s1.ldv = 0; s1.ntiles = 0;
      }
      attn_item<96, 0, 2>(p.qm + (size_t)tok0 * 384 + h * 96, 384, s0, s1, sc96, false, 0.f, 0, 0, nullptr, 0, 0,
                          p.br + (size_t)tok0 * 1024 + 256 + h * 64, p.zbuf + (size_t)tok0 * ZLD + 1184 + h * 64, smem);
    }
    if (first)
    for (int e2 = 0; e2 < 2; e2++) {
      const bool isA = e2 == 0;
      const int b = i >> 3, h = (i >> 1) & 3, qt = i & 1;
      const int tokb = b * 256, tok0 = tokb + qt * 128;
      int qcol, kcol, gcol, bcol;
      if (isA) { const int hk = h >> 1; qcol = h * 64; kcol = 256 + hk * 64; gcol = 512 + h * 64; bcol = h * 64; s0.Vt = p.vt_a_ctx + (size_t)(b * 2 + hk) * 64 * 256; }
      else { qcol = 1952 + h * 64; kcol = 2208 + h * 64; gcol = 2720 + h * 64; bcol = 768 + h * 64; s0.Vt = p.vt_d_ctx + (size_t)(b * 4 + h) * 64 * 256; }
      s0.K = p.zbuf + (size_t)tokb * ZLD + kcol; s0.ldk = ZLD; s0.ldv = 256; s0.ntiles = 4;
      s1.K = s0.K; s1.Vt = s0.Vt; s1.ldk = 0; s1.ldv = 0; s1.ntiles = 0;
      const float sink = isA ? p.a_sink[layer * 4 + h] * LOG2E : 0.f;
      attn_item<64, 0, 2>(p.zbuf + (size_t)tok0 * ZLD + qcol, ZLD, s0, s1, sc64, isA, sink, 0, 0, nullptr, 0, 0,
                          p.br + (size_t)tok0 * 1024 + bcol, p.zbuf + (size_t)tok0 * ZLD + gcol, smem);
    }
    if (!first) {
      for (int e = 0; e < 2; e++) {
        const int idx = 2 * i + e;
        const int b = idx >> 7, h = (idx >> 5) & 3, qt = idx & 31;
        const int tokb = T_CTX + b * 2048, tok0 = tokb + qt * 64;
        const int r = qt, rs = min(max(r - 4, 0), 24);
        s0.K = p.zbuf + (size_t)(tokb + rs * 64) * ZLD + 2208 + h * 64; s0.ldk = ZLD; s0.Vt = p.vt_d_lat + (size_t)(b * 4 + h) * 64 * 2048 + rs * 64; s0.ldv = 2048; s0.ntiles = 8;
        s1.K = p.ck_n + (size_t)((b * 2 + layer) * 512) * 256 + h * 64; s1.ldk = 256; s1.Vt = p.cvt_n + (size_t)((b * 2 + layer) * 4 + h) * 64 * 512; s1.ldv = 512; s1.ntiles = 8;
        attn_item<64, 2, 1>(p.zbuf + (size_t)tok0 * ZLD + 1952 + h * 64, ZLD, s0, s1, sc64, false, 0.f, 0, 0,
                            p.na_rpb + (size_t)(layer * 4 + h) * 15 * 31, r, rs,
                            p.br + (size_t)tok0 * 1024 + 768 + h * 64, p.zbuf + (size_t)tok0 * ZLD + 2720 + h * 64, smem);
      }
      for (int e = 0; e < 2; e++) {
        const int idx = 2 * i + e;
        const int b = idx >> 7, h = (idx >> 5) & 3, qt = idx & 31;
        const int tokb = T_CTX + b * 2048, tok0 = tokb + qt * 64;
        const int hk = h >> 1, q0 = qt * 64;
        const int ks = max(0, q0 - 128), ke = min(2048, q0 + 192);
        s0.K = p.zbuf + (size_t)(tokb + ks) * ZLD + 256 + hk * 64; s0.ldk = ZLD; s0.Vt = p.vt_a_lat + (size_t)(b * 2 + hk) * 64 * 2048 + ks; s0.ldv = 2048; s0.ntiles = (ke - ks) >> 6;
        s1.K = p.ck_a + (size_t)((b * 2 + layer) * 512) * 128 + hk * 64; s1.ldk = 128; s1.Vt = p.cvt_a + (size_t)((b * 2 + layer) * 2 + hk) * 64 * 512; s1.ldv = 512; s1.ntiles = 8;
        attn_item<64, 1, 1>(p.zbuf + (size_t)tok0 * ZLD + h * 64, ZLD, s0, s1, sc64, true, p.a_sink[layer * 4 + h] * LOG2E, q0, ks, nullptr, 0, 0,
                            p.br + (size_t)tok0 * 1024 + h * 64, p.zbuf + (size_t)tok0 * ZLD + 512 + h * 64, smem);
      }
    }
  }
}

__device__ void phase_glu(const Params p, int layer, char* smem) {
  const int lane = otid() & 63, wid = otid() >> 6, wr = wid >> 1, wc = wid & 1, l15 = lane & 15, g = lane >> 4;
  int rt, ct;
  for (int ti = 0; xcd_tile(ti, 128, 4, rt, ct); ti++) {
    const int r0 = rt * 128, n0 = ct * 128;
    f32x4 acc[4][4];
    zero_acc(acc);
    gemm_acc<128, 128>(acc, p.zbuf + (size_t)r0 * ZLD + 1440, ZLD, p.wt_glu + (size_t)layer * 512 * 256 + (size_t)n0 * 256, 256, 256, smem);
    h16x4 cgv[4][2];
#pragma unroll
    for (int mi = 0; mi < 4; mi++)
#pragma unroll
      for (int np = 0; np < 2; np++) {
        const int tok = r0 + wr * 64 + mi * 16 + l15, col = ((n0 + wc * 64 + np * 32) >> 5) * 16 + 4 * g;
        cgv[mi][np] = *(const h16x4*)(p.zbuf + (size_t)tok * ZLD + 1696 + col);
      }
#pragma unroll
    for (int mi = 0; mi < 4; mi++) {
      const int tok = r0 + wr * 64 + mi * 16 + l15;
#pragma unroll
      for (int np = 0; np < 2; np++) {
        const int pn = n0 + wc * 64 + np * 32;
        const int col = (pn >> 5) * 16 + 4 * g;
        f32x4 val = acc[mi][np * 2], gt = acc[mi][np * 2 + 1];
        const h16x4 cg_ = cgv[mi][np];
        store_h4(p.br + (size_t)tok * 1024 + 512 + col, val[0] * sigmoidf_(gt[0]) * siluf_((float)cg_[0]),
                 val[1] * sigmoidf_(gt[1]) * siluf_((float)cg_[1]), val[2] * sigmoidf_(gt[2]) * siluf_((float)cg_[2]),
                 val[3] * sigmoidf_(gt[3]) * siluf_((float)cg_[3]));
      }
    }
  }
}

__device__ void phase_g3(const Params p, int layer, char* smem) {
  const int lane = otid() & 63, wid = otid() >> 6, wr = wid >> 1, wc = wid & 1, l15 = lane & 15, g = lane >> 4;
  const h16* Wm = p.wt_merge + (size_t)layer * 4096 * 1024;
  const h16* Wb = p.wt_branch + (size_t)layer * 4 * 1024 * 256;
  h16* mbuf = p.zbuf;
  typedef __attribute__((ext_vector_type(2))) unsigned u32x2;
  int rt, ct;
  for (int ti = 0; xcd_tile(ti, 128, 8, rt, ct); ti++) {
    const int r0 = rt * 128, d0 = ct * 128;
    h16x4 macc[4][4];
#pragma unroll
    for (int mi = 0; mi < 4; mi++)
#pragma unroll
      for (int ni = 0; ni < 4; ni++) macc[mi][ni] = h16x4{(h16)0.f, (h16)0.f, (h16)0.f, (h16)0.f};
#pragma unroll 1
    for (int k = 0; k < 4; k++) {
      u32x2 sg[4][4];
      {
        f32x4 a1[4][4];
        zero_acc(a1);
        gemm_acc<128, 128, true>(a1, p.hbuf + (size_t)r0 * 1024, 1024, Wm + (size_t)(k * 1024 + d0) * 1024, 1024, 1024, smem);
#pragma unroll
        for (int mi = 0; mi < 4; mi++)
#pragma unroll
          for (int ni = 0; ni < 4; ni++) {
            h16x4 hv = {(h16)sigmoidf_(a1[mi][ni][0]), (h16)sigmoidf_(a1[mi][ni][1]), (h16)sigmoidf_(a1[mi][ni][2]), (h16)sigmoidf_(a1[mi][ni][3])};
            sg[mi][ni] = __builtin_bit_cast(u32x2, hv);
          }
      }
      f32x4 a2[4][4];
      zero_acc(a2);
      gemm_acc<128, 128, true>(a2, p.br + (size_t)r0 * 1024 + k * 256, 1024, Wb + (size_t)(k * 1024 + d0) * 256, 256, 256, smem);
#pragma unroll
      for (int mi = 0; mi < 4; mi++)
#pragma unroll
        for (int ni = 0; ni < 4; ni++) {
          const h16x4 hv = __builtin_bit_cast(h16x4, sg[mi][ni]);
          const h16x4 a2h = {(h16)a2[mi][ni][0], (h16)a2[mi][ni][1], (h16)a2[mi][ni][2], (h16)a2[mi][ni][3]};
          macc[mi][ni] = hv * a2h + macc[mi][ni];
        }
    }
#pragma unroll
    for (int mi = 0; mi < 4; mi++)
#pragma unroll
      for (int ni = 0; ni < 4; ni++) {
        const int tok = r0 + wr * 64 + mi * 16 + l15, col = d0 + wc * 64 + ni * 16 + 4 * g;
        *(h16x4*)(mbuf + (size_t)tok * 1024 + col) = macc[mi][ni];
      }
  }
}

__device__ void phase_g4(const Params p, int layer, char* smem) {
  const int lane = otid() & 63, wid = otid() >> 6, wr = wid >> 1, wc = wid & 1, l15 = lane & 15, g = lane >> 4;
  const h16* Wo = p.wt_out + (size_t)layer * 1048576;
  const h16* mbuf = p.zbuf;
  int rt, ct;
  for (int ti = 0; xcd_tile(ti, 128, 8, rt, ct); ti++) {
    const int r0 = rt * 128, n0 = ct * 128;
    f32x4 acc[4][4];
    zero_acc(acc);
    gemm_acc<128, 128>(acc, mbuf + (size_t)r0 * 1024, 1024, Wo + (size_t)n0 * 1024, 1024, 1024, smem);
    f32x4 gv[4];
    {
      const float* gt = p.modv + (layer * 5 + cond_of(r0)) * 3072 + 2048;
#pragma unroll
      for (int ni = 0; ni < 4; ni++) gv[ni] = *(const f32x4*)(gt + n0 + wc * 64 + ni * 16 + 4 * g);
    }
    f32x4 xv[4][4];
#pragma unroll
    for (int mi = 0; mi < 4; mi++) {
      const float* xo = xptr(p, layer, r0 + wr * 64 + mi * 16 + l15);
#pragma unroll
      for (int ni = 0; ni < 4; ni++) xv[mi][ni] = __builtin_nontemporal_load((const f32x4*)(xo + n0 + wc * 64 + ni * 16 + 4 * g));
    }
#pragma unroll
    for (int mi = 0; mi < 4; mi++) {
      const int tok = r0 + wr * 64 + mi * 16 + l15;
#pragma unroll
      for (int ni = 0; ni < 4; ni++) {
        const int col = n0 + wc * 64 + ni * 16 + 4 * g;
        *(f32x4*)(p.out + (size_t)tok * 1024 + col) = xv[mi][ni] + gv[ni] * acc[mi][ni];
      }
    }
  }
}


#define XB_TMO      128
#define XB_XCNT(j)  (256  + 64 * (j))
#define XB_XSUB(j)  (1280 + 64 * (j))
#define XB_XGEN(j)  (2304 + 64 * (j))
#define XB_TOP      3328
#define XB_TOPGEN   3392
#define XCD_BAR_WORDS 3456
#define XB_SPIN_CAP (1u << 20)
__device__ __forceinline__ unsigned xb_ld(unsigned* p) { return __hip_atomic_load(p, __ATOMIC_RELAXED, __HIP_MEMORY_SCOPE_AGENT); }
__device__ __forceinline__ unsigned xb_add(unsigned* p, unsigned v) { return __hip_atomic_fetch_add(p, v, __ATOMIC_RELAXED, __HIP_MEMORY_SCOPE_AGENT); }
__device__ __forceinline__ unsigned xb_xcc_id() { return (unsigned)__builtin_amdgcn_s_getreg((3 << 11) | 20) & 0xFu; }
#define XB_SPIN(cond, bar) do { unsigned _sp = 0; while (cond) { __builtin_amdgcn_s_sleep(1); \
    if ((++_sp & 255u) == 0u) { if (xb_ld(&(bar)[XB_TMO])) break; if (_sp > XB_SPIN_CAP) { atomicAdd(&(bar)[XB_TMO], 1u); break; } } } } while (0)
struct XB { unsigned* bar; unsigned x, nloc, nx; };
__device__ __forceinline__ void xb_post(XB& b, unsigned* bar) {
  b.bar = bar; b.x = xb_xcc_id(); b.nloc = 0u; b.nx = 0u;
  if (otid() == 0) (void)xb_add(&bar[XB_XCNT(b.x)], 1u);
}
__device__ __forceinline__ void xb_complete(unsigned* bar, unsigned x, unsigned& nloc, unsigned& nx) {
  const unsigned G = gridDim.x;
  unsigned sum, cnt, mine, sp = 0u;
  for (;;) {
    sum = 0u; cnt = 0u; mine = 0u;
#pragma unroll
    for (unsigned j = 0; j < 16; ++j) { const unsigned c = xb_ld(&bar[XB_XCNT(j)]); sum += c; cnt += (c > 0u) ? 1u : 0u; mine = (j == x) ? c : mine; }
    if (sum == G) break;
    __builtin_amdgcn_s_sleep(1);
    if ((++sp & 255u) == 0u) { if (xb_ld(&bar[XB_TMO])) break; if (sp > XB_SPIN_CAP) { atomicAdd(&bar[XB_TMO], 1u); break; } }
  }
  nloc = mine > 0u ? mine : 1u; nx = cnt > 0u ? cnt : 1u;
}
__device__ __forceinline__ void xb_sync(XB& b) {
  asm volatile("s_waitcnt vmcnt(0)" ::: "memory");
  __syncthreads();
  if (otid() == 0) {
    unsigned* bar = b.bar;
    __builtin_amdgcn_s_waitcnt(0);
    if (b.nloc == 0u) xb_complete(bar, b.x, b.nloc, b.nx);
    const unsigned nloc = b.nloc, nx = b.nx;
    const unsigned old = xb_add(&bar[XB_XSUB(b.x)], 1u);
    const unsigned gen = old / nloc;
    if (old + 1u == (gen + 1u) * nloc) {
      __builtin_amdgcn_fence(__ATOMIC_RELEASE, "agent");
      asm volatile("s_waitcnt vmcnt(0)" ::: "memory");
      const unsigned og = xb_add(&bar[XB_TOP], 1u);
      const unsigned tg = og / nx;
      if (og + 1u == (tg + 1u) * nx) xb_add(&bar[XB_TOPGEN], 1u);
      else XB_SPIN(xb_ld(&bar[XB_TOPGEN]) == tg, bar);
      __builtin_amdgcn_fence(__ATOMIC_ACQUIRE, "agent");
      xb_add(&bar[XB_XGEN(b.x)], 1u);
      asm volatile("s_waitcnt vmcnt(0)" ::: "memory");
    } else {
      XB_SPIN(xb_ld(&bar[XB_XGEN(b.x)]) == gen, bar);
      __builtin_amdgcn_fence(__ATOMIC_ACQUIRE, "agent");
      asm volatile("s_waitcnt vmcnt(0)" ::: "memory");
    }
  }
  __syncthreads();
}

#define N_PHASES 16
template <int PH>
__device__ __forceinline__ void run_phase(const Params p, char* smem) {
  if constexpr (PH == 0) phase_prep(p, smem);
  else if constexpr (PH == 15) phase_final(p);
  else {
    constexpr int layer = (PH - 1) / 7, s = (PH - 1) % 7;
    if constexpr (s == 0) phase_norm(p, layer);
    else if constexpr (s == 1) phase_g1(p, layer, smem);
    else if constexpr (s == 2) phase_g2(p, layer, smem);
    else if constexpr (s == 3) phase_att(p, layer, smem);
    else if constexpr (s == 4) phase_glu(p, layer, smem);
    else if constexpr (s == 5) phase_g3(p, layer, smem);
    else phase_g4(p, layer, smem);
  }
}

template <int PH>
__global__ void __launch_bounds__(256, 2) phase_kernel(Params p) {
  __shared__ __attribute__((aligned(16))) char smem[65536];
  run_phase<PH>(p, smem);
}

#ifndef MULTI_LAUNCH
#ifndef PROBE_MASK
#define PROBE_MASK 0
#endif
#define PROBE_MULT 4
template <int PH>
__device__ __forceinline__ void run_from(const Params p, char* smem, XB& xb, unsigned long long tprev, unsigned long long& tacc) {
  run_phase<PH>(p, smem);
  if constexpr (PH + 1 < N_PHASES) {
    xb_sync(xb);
  }
  unsigned long long tnow = tprev;
  if constexpr (PROBE_MASK != 0) {
    tnow = wall_clock64();
    if constexpr ((PROBE_MASK >> PH) & 1) tacc += tnow - tprev;
  }
  if constexpr (PH + 1 < N_PHASES) run_from<PH + 1>(p, smem, xb, tnow, tacc);
}

__global__ void __launch_bounds__(256, 2) mega(Params p) {
  __shared__ __attribute__((aligned(16))) char smem[65536];
  XB xb;
  xb_post(xb, p.bar);
  unsigned long long tacc = 0;
  unsigned long long t0 = 0;
  if constexpr (PROBE_MASK != 0) t0 = wall_clock64();
  run_from<0>(p, smem, xb, t0, tacc);
  if constexpr (PROBE_MASK != 0) {
    if (blockIdx.x == 0 && otid() == 0) {
      const unsigned long long tend = wall_clock64();
      while (wall_clock64() - tend < tacc * PROBE_MULT) __builtin_amdgcn_s_sleep(8);
    }
  }
}
#endif

template <int PH>
static void launch_phases(const Params p, int grid, hipStream_t stream) {
  hipLaunchKernelGGL(phase_kernel<PH>, dim3(grid), dim3(256), 0, stream, p);
  if constexpr (PH + 1 < N_PHASES) launch_phases<PH + 1>(p, grid, stream);
}

static inline size_t al256(size_t x) { return (x + 255) & ~(size_t)255; }

extern "C" void kernel_launch(void* const* d_in, const int* in_sizes, int n_in, void* d_out, int out_size, void* d_ws,
                              size_t ws_size, hipStream_t stream) {
  Params p{};
  const float** ip = (const float**)&p;
  for (int i = 0; i < 35; i++) ip[i] = (const float*)d_in[i];
  p.out = (float*)d_out;
  char* w = (char*)d_ws;
  size_t off = 0;
  auto take = [&](size_t bytes) { char* r = w + off; off = al256(off + bytes); return r; };
  p.wt_in = (h16*)take((size_t)2 * 3072 * 1024 * 2);
  p.wt_merge = (h16*)take((size_t)2 * 4096 * 1024 * 2);
  p.wt_branch = (h16*)take((size_t)2 * 4 * 1024 * 256 * 2);
  p.wt_out = (h16*)take((size_t)2 * 1024 * 1024 * 2);
  p.wt_qup = (h16*)take((size_t)2 * 384 * 256 * 2);
  p.wt_kvup = (h16*)take((size_t)2 * 512 * 128 * 2);
  p.wt_kvraw = (h16*)take((size_t)2 * 512 * 128 * 2);
  p.wt_glu = (h16*)take((size_t)2 * 512 * 256 * 2);
  p.hbuf = (h16*)take((size_t)T_ALL * 1024 * 2);
  p.zbuf = (h16*)take((size_t)T_ALL * ZLD * 2);
  p.br = (h16*)take((size_t)T_ALL * 1024 * 2);
  p.qm = (h16*)take((size_t)T_ALL * 384 * 2);
  p.kmla = (h16*)take((size_t)T_ALL * 384 * 2);
  p.kcx = (h16*)take((size_t)2048 * 384 * 2);
  p.vt_a_ctx = (h16*)take((size_t)32 * 2 * 64 * 256 * 2);
  p.vt_a_lat = (h16*)take((size_t)4 * 2 * 64 * 2048 * 2);
  p.vt_d_ctx = (h16*)take((size_t)32 * 4 * 64 * 256 * 2);
  p.vt_d_lat = (h16*)take((size_t)4 * 4 * 64 * 2048 * 2);
  p.vt_m_ctx = (h16*)take((size_t)32 * 4 * 64 * 256 * 2);
  p.vt_m_lat = (h16*)take((size_t)4 * 4 * 64 * 2048 * 2);
  p.vcx_t = (h16*)take((size_t)4 * 4 * 64 * 512 * 2);
  p.ck_a = (h16*)take((size_t)524288 * 2);
  p.cvt_a = (h16*)take((size_t)524288 * 2);
  p.ck_n = (h16*)take((size_t)1048576 * 2);
  p.cvt_n = (h16*)take((size_t)1048576 * 2);
  p.ckv_c = (h16*)take((size_t)524288 * 2);
  p.s5_bmt = (h16*)take((size_t)64 * 128 * 16 * 2);
  p.s5_cmt = (h16*)take((size_t)64 * 16 * 128 * 2);
  p.s5_abar = (float*)take(4096 * 2 * 4);
  p.s5_lamdt = (float*)take(4096 * 2 * 4);
  p.s5_dt = (float*)take(64 * 4);
  p.s5_e = (float*)take((size_t)4 * 16 * 2 * 8 * 128 * 4);
  p.modv = (float*)take(2 * 5 * 3072 * 4);
  p.cs16 = (float*)take(64 * 16 * 2 * 4);
  p.cs8 = (float*)take(64 * 8 * 2 * 4);
  p.bar = (unsigned*)take(XCD_BAR_WORDS * 4);
  if (off > ws_size) { fprintf(stderr, "workspace too small: need %zu have %zu\n", off, ws_size); return; }

  static int grid_blocks = 0;
  if (!grid_blocks) {
    int dev = 0, cus = 0, per_cu = 0;
    (void)hipGetDevice(&dev);
    (void)hipDeviceGetAttribute(&cus, hipDeviceAttributeMultiprocessorCount, dev);
    #ifdef MULTI_LAUNCH
    (void)hipOccupancyMaxActiveBlocksPerMultiprocessor(&per_cu, phase_kernel<3>, 256, 0);
#else
    (void)hipOccupancyMaxActiveBlocksPerMultiprocessor(&per_cu, mega, 256, 0);
#endif
    if (per_cu > 2) per_cu = 2;
    if (per_cu < 1) per_cu = 1;
    grid_blocks = cus * per_cu;
  }
#ifdef MULTI_LAUNCH
  launch_phases<0>(p, grid_blocks, stream);
#else
  (void)hipMemsetAsync(p.bar, 0, XCD_BAR_WORDS * 4, stream);
  void* args[] = {&p};
  hipError_t e = hipLaunchCooperativeKernel((void*)mega, dim3(grid_blocks), dim3(256), args, 0, stream);
  if (e != hipSuccess) fprintf(stderr, "cooperative launch failed: %s (grid %d)\n", hipGetErrorString(e), grid_blocks);
#endif
}
```

```cpp
#include <hip/hip_runtime.h>
#include <hip/hip_cooperative_groups.h>
#include <cstdio>
#include <cstdint>
namespace cg = cooperative_groups;

typedef _Float16 h16;
typedef __attribute__((ext_vector_type(8))) _Float16 h16x8;
typedef __attribute__((ext_vector_type(4))) _Float16 h16x4;
typedef __attribute__((ext_vector_type(4))) float f32x4;
typedef __attribute__((ext_vector_type(4))) unsigned int u32x4;

#define T_ALL 16384
#define T_CTX 8192
#define ZLD 2976
#define LOG2E 1.4426950408889634f

#define O_AK   16777216
#define O_AV   18874368
#define O_CKV  20971520
#define O_KPE  23068672
#define O_NK   23592960
#define O_NV   27787264
#define O_SRE  31981568
#define O_SIM  32112640

struct Params {
  const float *x_prompt, *x_sample, *cache_a_k, *cache_a_v, *cache_mla_ckv, *cache_mla_kpe, *cache_na_k, *cache_na_v,
      *state_re, *state_im, *c, *c_ctx, *w_mod, *b_mod, *norm_g, *w_in, *w_merge, *a_sink, *mla_q_norm, *mla_w_q_up,
      *mla_kv_norm, *mla_w_kv_up, *s5_lam_re, *s5_lam_im, *s5_log_dt, *s5_b_re, *s5_b_im, *s5_c_re, *s5_c_im, *s5_d,
      *s5_w_glu, *na_rpb, *w_branch, *w_out, *final_norm_g;
  float* out;
  h16 *wt_in, *wt_merge, *wt_branch, *wt_out, *wt_qup, *wt_kvup, *wt_kvraw, *wt_glu;
  h16 *hbuf, *zbuf, *br, *qm, *kmla, *kcx, *vt_a_ctx, *vt_a_lat, *vt_d_ctx, *vt_d_lat, *vt_m_ctx, *vt_m_lat, *vcx_t,
      *ck_a, *cvt_a, *ck_n, *cvt_n, *ckv_c, *s5_bmt, *s5_cmt;
  float *s5_abar, *s5_lamdt, *s5_dt, *s5_e, *modv, *cs16, *cs8;
  unsigned* bar;
};


__device__ __forceinline__ int otid() { int t = __builtin_amdgcn_workitem_id_x(); asm volatile("" : "+v"(t)); return t; }
__device__ __forceinline__ float sigmoidf_(float x) { return 1.f / (1.f + __expf(-x)); }
__device__ __forceinline__ float siluf_(float x) { return x * sigmoidf_(x); }
__device__ __forceinline__ float geluf_(float x) {
  float u = 0.7978845608028654f * (x + 0.044715f * x * x * x);
  return x / (1.f + __expf(-2.f * u));
}
__device__ __forceinline__ float wave_sum(float v) {
#pragma unroll
  for (int o = 32; o > 0; o >>= 1) v += __shfl_xor(v, o);
  return v;
}
__device__ __forceinline__ const float* xptr(const Params p, int layer, int tok) {
  if (layer == 0) return tok < T_CTX ? p.x_prompt + (size_t)tok * 1024 : p.x_sample + (size_t)(tok - T_CTX) * 1024;
  return p.out + (size_t)tok * 1024;
}
__device__ __forceinline__ int cond_of(int tok) { return tok < T_CTX ? 0 : 1 + ((tok - T_CTX) >> 11); }

#define SWZ(row, slot) (((row) << 7) + ((((slot) ^ (((row) >> 1) & 7))) << 4))

template <int BM, int BN, bool LOWREG = false>
__device__ __forceinline__ void gemm_acc(f32x4 (&acc)[BM / 32][BN / 32], const h16* __restrict__ A, int lda,
                                         const h16* __restrict__ Bt, int ldb, int K, char* smem) {
  constexpr int MREP = BM / 32, NREP = BN / 32;
  constexpr int ACH = BM * 8 / 256, BCH = BN * 8 / 256;
  constexpr int ABYTES = BM * 128, STAGE = (BM + BN) * 128;
  const int tid = otid(), lane = tid & 63, wid = tid >> 6;
  const int wr = wid >> 1, wc = wid & 1;
  const int l15 = lane & 15, g = lane >> 4;
  const int nk = K >> 6;
  const int ls = (tid & 7) ^ ((tid >> 4) & 7);
  const h16* Ap = A + (size_t)(tid >> 3) * lda + ls * 8;
  const h16* Bp = Bt + (size_t)(tid >> 3) * ldb + ls * 8;
  char* dstA = smem + tid * 16;
  char* dstB = smem + ABYTES + tid * 16;
#pragma unroll
  for (int i = 0; i < ACH; i++)
    __builtin_amdgcn_global_load_lds((const unsigned*)(Ap + (size_t)(i * 32) * lda), (__attribute__((address_space(3))) unsigned*)(dstA + i * 4096), 16, 0, 0);
#pragma unroll
  for (int i = 0; i < BCH; i++)
    __builtin_amdgcn_global_load_lds((const unsigned*)(Bp + (size_t)(i * 32) * ldb), (__attribute__((address_space(3))) unsigned*)(dstB + i * 4096), 16, 0, 0);
  for (int kt = 0; kt < nk; kt++) {
    asm volatile("s_waitcnt vmcnt(0)" ::: "memory");
    __syncthreads();
    if (kt + 1 < nk) {
      const int nb = ((kt + 1) & 1) * STAGE;
#pragma unroll
      for (int i = 0; i < ACH; i++)
        __builtin_amdgcn_global_load_lds((const unsigned*)(Ap + (size_t)(i * 32) * lda + (kt + 1) * 64), (__attribute__((address_space(3))) unsigned*)(dstA + nb + i * 4096), 16, 0, 0);
#pragma unroll
      for (int i = 0; i < BCH; i++)
        __builtin_amdgcn_global_load_lds((const unsigned*)(Bp + (size_t)(i * 32) * ldb + (kt + 1) * 64), (__attribute__((address_space(3))) unsigned*)(dstB + nb + i * 4096), 16, 0, 0);
    }
    const char* sa = smem + (kt & 1) * STAGE;
    const char* sb = sa + ABYTES;
    if (!LOWREG) {
      h16x8 af[2][MREP], bf[2][NREP];
#pragma unroll
      for (int ks = 0; ks < 2; ks++) {
#pragma unroll
        for (int mi = 0; mi < MREP; mi++) af[ks][mi] = *(const h16x8*)(sa + SWZ(wr * (BM / 2) + mi * 16 + l15, ks * 4 + g));
#pragma unroll
        for (int ni = 0; ni < NREP; ni++) bf[ks][ni] = *(const h16x8*)(sb + SWZ(wc * (BN / 2) + ni * 16 + l15, ks * 4 + g));
      }
      __builtin_amdgcn_sched_barrier(0);
#pragma unroll
      for (int ks = 0; ks < 2; ks++)
#pragma unroll
        for (int mi = 0; mi < MREP; mi++)
#pragma unroll
          for (int ni = 0; ni < NREP; ni++)
            acc[mi][ni] = __builtin_amdgcn_mfma_f32_16x16x32_f16(bf[ks][ni], af[ks][mi], acc[mi][ni], 0, 0, 0);
      __builtin_amdgcn_sched_barrier(0);
    } else {
#pragma unroll
      for (int ks = 0; ks < 2; ks++) {
        h16x8 af[MREP], bf[NREP];
#pragma unroll
        for (int mi = 0; mi < MREP; mi++) af[mi] = *(const h16x8*)(sa + SWZ(wr * (BM / 2) + mi * 16 + l15, ks * 4 + g));
#pragma unroll
        for (int ni = 0; ni < NREP; ni++) bf[ni] = *(const h16x8*)(sb + SWZ(wc * (BN / 2) + ni * 16 + l15, ks * 4 + g));
        __builtin_amdgcn_sched_barrier(0);
#pragma unroll
        for (int mi = 0; mi < MREP; mi++)
#pragma unroll
          for (int ni = 0; ni < NREP; ni++)
            acc[mi][ni] = __builtin_amdgcn_mfma_f32_16x16x32_f16(bf[ni], af[mi], acc[mi][ni], 0, 0, 0);
        __builtin_amdgcn_sched_barrier(0);
      }
    }
  }
  __syncthreads();
}

__device__ __forceinline__ bool xcd_tile(int i, int RT, int CT, int& rt, int& ct) {
  const int nbx = gridDim.x >> 3, x = blockIdx.x & 7, j = blockIdx.x >> 3;
  const int RTL = RT >> 3;
  const int L = i * nbx + j;
  if (L >= RTL * CT) return false;
  if ((CT & 7) == 0 && (RTL & 7) == 0) {
    const int gi = L >> 6, w = L & 63, nrg = RTL >> 3;
    rt = x * RTL + (gi % nrg) * 8 + (w >> 3);
    ct = (gi / nrg) * 8 + (w & 7);
  } else {
    rt = x * RTL + L / CT;
    ct = L % CT;
  }
  return true;
}

template <int M, int N>
__device__ __forceinline__ void zero_acc(f32x4 (&a)[M][N]) {
#pragma unroll
  for (int i = 0; i < M; i++)
#pragma unroll
    for (int j = 0; j < N; j++) a[i][j] = f32x4{0.f, 0.f, 0.f, 0.f};
}

__device__ __forceinline__ void store_h4(h16* dst, float a, float b, float c, float d) {
  h16x4 v = {(h16)a, (h16)b, (h16)c, (h16)d};
  *(h16x4*)dst = v;
}

__device__ void tr_tile(const float* __restrict__ src, int lds_, h16* __restrict__ dst, int ldd, int k0, int n0, int N,
                        char* smem) {
  float* tile = (float*)smem;
  const int tid = otid();
  const int r = tid >> 4, c4 = tid & 15;
#pragma unroll
  for (int rr = 0; rr < 4; rr++) {
    int kl = r + rr * 16;
    int n = n0 + c4 * 4;
    float4 v = make_float4(0.f, 0.f, 0.f, 0.f);
    if (n < N) v = *(const float4*)(src + (size_t)(k0 + kl) * lds_ + n);
    tile[kl * 65 + c4 * 4 + 0] = v.x;
    tile[kl * 65 + c4 * 4 + 1] = v.y;
    tile[kl * 65 + c4 * 4 + 2] = v.z;
    tile[kl * 65 + c4 * 4 + 3] = v.w;
  }
  __syncthreads();
  const int nl = tid >> 2, kq = tid & 3;
  h16x8 o0, o1;
#pragma unroll
  for (int i = 0; i < 8; i++) {
    o0[i] = (h16)tile[(kq * 16 + i) * 65 + nl];
    o1[i] = (h16)tile[(kq * 16 + 8 + i) * 65 + nl];
  }
  h16* d = dst + (size_t)(n0 + nl) * ldd + k0 + kq * 16;
  *(h16x8*)d = o0;
  *(h16x8*)(d + 8) = o1;
  __syncthreads();
}

__device__ void phase_prep(const Params p, char* smem) {
  const int tid = otid();
  const size_t gtid = (size_t)blockIdx.x * 256 + tid, gsz = (size_t)gridDim.x * 256;
  for (size_t i = gtid; i < 2 * 384 * 256; i += gsz) {
    int l = i / (384 * 256), r = i % (384 * 256), n = r / 256, k = r % 256;
    p.wt_qup[i] = (h16)(p.mla_q_norm[l * 256 + k] * p.mla_w_q_up[(size_t)l * 256 * 384 + k * 384 + n]);
  }
  for (size_t i = gtid; i < 2 * 512 * 128; i += gsz) {
    int l = i / (512 * 128), r = i % (512 * 128), n = r / 128, k = r % 128;
    float w = p.mla_w_kv_up[(size_t)l * 128 * 512 + k * 512 + n];
    p.wt_kvraw[i] = (h16)w;
    p.wt_kvup[i] = (h16)(w * p.mla_kv_norm[l * 128 + k]);
  }
  for (size_t i = gtid; i < 2 * 512 * 256; i += gsz) {
    int l = i / (512 * 256), r = i % (512 * 256), n = r / 256, k = r % 256;
    int q = n >> 5, w = n & 31;
    int orig = (w < 16) ? (q * 16 + w) : (256 + q * 16 + (w - 16));
    p.wt_glu[i] = (h16)p.s5_w_glu[(size_t)l * 256 * 512 + k * 512 + orig];
  }
  for (size_t i = gtid; i < 262144; i += gsz) {
    const float* src; h16* dst; size_t e;
    if (i < 65536) { src = p.cache_a_k; dst = p.ck_a; e = i * 8; }
    else if (i < 131072) { src = p.cache_mla_ckv; dst = p.ckv_c; e = (i - 65536) * 8; }
    else { src = p.cache_na_k; dst = p.ck_n; e = (i - 131072) * 8; }
    const f32x4 a = __builtin_nontemporal_load((const f32x4*)(src + e)), b = __builtin_nontemporal_load((const f32x4*)(src + e + 4));
    h16x8 o = {(h16)a[0], (h16)a[1], (h16)a[2], (h16)a[3], (h16)b[0], (h16)b[1], (h16)b[2], (h16)b[3]};
    *(h16x8*)(dst + e) = o;
  }
  for (size_t ii = gtid; ii < 65536; ii += gsz) {
    const int i = ii >> 4, c = ii & 15;
    int ldg = i >> 6;
    float lr = fminf(p.s5_lam_re[i], -1e-4f), li = p.s5_lam_im[i];
    float dt = __expf(p.s5_log_dt[ldg]);
    float er = expf(lr * dt), sn, cs;
    sincosf(li * dt, &sn, &cs);
    float ar = er * cs, ai = er * sn;
    if (c == 0) {
      p.s5_abar[i * 2] = ar;
      p.s5_abar[i * 2 + 1] = ai;
      p.s5_lamdt[i * 2] = lr * dt;
      p.s5_lamdt[i * 2 + 1] = li * dt;
      if ((i & 63) == 0) p.s5_dt[ldg] = dt;
    }
    float nr = ar - 1.f, ni = ai, den = lr * lr + li * li;
    float cr = (nr * lr + ni * li) / den / dt, ci = (ni * lr - nr * li) / den / dt;
    int pp = i & 63;
    {
      float br_ = p.s5_b_re[(size_t)i * 16 + c], bi_ = p.s5_b_im[(size_t)i * 16 + c];
      p.s5_bmt[((size_t)ldg * 128 + pp) * 16 + c] = (h16)(cr * br_ - ci * bi_);
      p.s5_bmt[((size_t)ldg * 128 + 64 + pp) * 16 + c] = (h16)(cr * bi_ + ci * br_);
      p.s5_cmt[((size_t)ldg * 16 + c) * 128 + pp] = (h16)p.s5_c_re[((size_t)ldg * 16 + c) * 64 + pp];
      p.s5_cmt[((size_t)ldg * 16 + c) * 128 + 64 + pp] = (h16)(-p.s5_c_im[((size_t)ldg * 16 + c) * 64 + pp]);
    }
  }
  for (size_t i = gtid; i < 64 * 16; i += gsz) {
    int pos = i >> 4, k = i & 15;
    float inv = powf(10000.f, -(float)k / 16.f), sn, cs;
    sincosf((float)pos * inv, &sn, &cs);
    p.cs16[i * 2] = cs;
    p.cs16[i * 2 + 1] = sn;
  }
  for (size_t i = gtid; i < 64 * 8; i += gsz) {
    int pos = i >> 3, k = i & 7;
    float inv = powf(10000.f, -(float)k / 8.f), sn, cs;
    sincosf((float)pos * inv, &sn, &cs);
    p.cs8[i * 2] = cs;
    p.cs8[i * 2 + 1] = sn;
  }
  for (int it = blockIdx.x; it < 384; it += gridDim.x) {
    float* sc = (float*)smem;
    float* red = sc + 5 * 1024;
    const int layer = it / 192, col0 = (it % 192) * 16;
    for (int i = tid; i < 5120; i += 256) {
      int c = i >> 10, k = i & 1023;
      float v = (c == 0) ? p.c_ctx[k] : p.c[(c - 1) * 1024 + k];
      sc[i] = siluf_(v);
    }
    __syncthreads();
    const int cl = tid & 15, kg = tid >> 4;
    float a0 = 0, a1 = 0, a2 = 0, a3 = 0, a4 = 0;
    const float* w = p.w_mod + (size_t)layer * 1024 * 3072 + col0 + cl;
#pragma unroll 16
    for (int kk = 0; kk < 64; kk++) {
      int k = kg * 64 + kk;
      float wv = __builtin_nontemporal_load(w + (size_t)k * 3072);
      a0 += sc[k] * wv;
      a1 += sc[1024 + k] * wv;
      a2 += sc[2048 + k] * wv;
      a3 += sc[3072 + k] * wv;
      a4 += sc[4096 + k] * wv;
    }
    red[(kg * 5 + 0) * 16 + cl] = a0;
    red[(kg * 5 + 1) * 16 + cl] = a1;
    red[(kg * 5 + 2) * 16 + cl] = a2;
    red[(kg * 5 + 3) * 16 + cl] = a3;
    red[(kg * 5 + 4) * 16 + cl] = a4;
    __syncthreads();
    if (tid < 80) {
      int c = tid >> 4, cc = tid & 15;
      float s = 0;
      for (int q = 0; q < 16; q++) s += red[(q * 5 + c) * 16 + cc];
      p.modv[(layer * 5 + c) * 3072 + col0 + cc] = s + p.b_mod[layer * 3072 + col0 + cc];
    }
    __syncthreads();
  }
  {
    float* tl = (float*)smem;
    const int r = tid >> 4, c4 = tid & 15, nl = tid >> 2, kq = tid & 3;
    const float* src = nullptr; h16* dst = nullptr; int lds_ = 0, ldd = 0, N = 0, k0 = 0, n0 = 0;
    f32x4 v[4];
#define TR_DECODE(it_)                                                                                                  \
    {                                                                                                                   \
      int NT_, tile_;                                                                                                   \
      if ((it_) < 4608) {                                                                                               \
        const int l = (it_) / 2304, rr_ = (it_) % 2304;                                                                 \
        if (rr_ < 768) { src = p.w_in + (size_t)l * 1024 * 2976; lds_ = 2976; dst = p.wt_in + (size_t)l * 3072 * 1024; ldd = 1024; N = 2976; NT_ = 48; tile_ = rr_; } \
        else if (rr_ < 1792) { src = p.w_merge + (size_t)l * 1024 * 4096; lds_ = 4096; dst = p.wt_merge + (size_t)l * 4096 * 1024; ldd = 1024; N = 4096; NT_ = 64; tile_ = rr_ - 768; } \
        else if (rr_ < 2048) { const int k = (rr_ - 1792) >> 6; src = p.w_branch + (size_t)(l * 4 + k) * 256 * 1024; lds_ = 1024; dst = p.wt_branch + (size_t)(l * 4 + k) * 1024 * 256; ldd = 256; N = 1024; NT_ = 16; tile_ = (rr_ - 1792) & 63; } \
        else { src = p.w_out + (size_t)l * 1048576; lds_ = 1024; dst = p.wt_out + (size_t)l * 1048576; ldd = 1024; N = 1024; NT_ = 16; tile_ = rr_ - 2048; } \
      } else {                                                                                                          \
        int rr_ = (it_) - 4608;                                                                                         \
        if (rr_ < 128) { const int m = rr_ >> 4; src = p.cache_a_v + (size_t)m * 512 * 128; lds_ = 128; dst = p.cvt_a + (size_t)m * 128 * 512; ldd = 512; N = 128; NT_ = 2; tile_ = rr_ & 15; } \
        else { rr_ -= 128; const int m = rr_ >> 5; src = p.cache_na_v + (size_t)m * 512 * 256; lds_ = 256; dst = p.cvt_n + (size_t)m * 256 * 512; ldd = 512; N = 256; NT_ = 4; tile_ = rr_ & 31; } \
      }                                                                                                                 \
      k0 = (tile_ / NT_) * 64; n0 = (tile_ % NT_) * 64;                                                                 \
      _Pragma("unroll") for (int q = 0; q < 4; q++) {                                                                   \
        v[q] = f32x4{0.f, 0.f, 0.f, 0.f};                                                                               \
        if (n0 + c4 * 4 < N) v[q] = __builtin_nontemporal_load((const f32x4*)(src + (size_t)(k0 + r + q * 16) * lds_ + n0 + c4 * 4));              \
      }                                                                                                                 \
    }
    int it = blockIdx.x, tstride = gridDim.x, tend = 4992;
    if (gridDim.x == 512) {
      if (blockIdx.x < 384) { tstride = 384; tend = 3072; }
      else { it = 3072 + (blockIdx.x - 384); tstride = 128; }
    }
    if (it < tend) TR_DECODE(it)
    while (it < tend) {
#pragma unroll
      for (int q = 0; q < 4; q++) {
        const int kl = r + q * 16;
        tl[kl * 65 + c4 * 4 + 0] = v[q][0];
        tl[kl * 65 + c4 * 4 + 1] = v[q][1];
        tl[kl * 65 + c4 * 4 + 2] = v[q][2];
        tl[kl * 65 + c4 * 4 + 3] = v[q][3];
      }
      h16* d = dst + (size_t)(n0 + nl) * ldd + k0 + kq * 16;
      it += tstride;
      if (it < tend) TR_DECODE(it)
      __syncthreads();
      h16x8 o0, o1;
#pragma unroll
      for (int i = 0; i < 8; i++) {
        o0[i] = (h16)tl[(kq * 16 + i) * 65 + nl];
        o1[i] = (h16)tl[(kq * 16 + 8 + i) * 65 + nl];
      }
      *(h16x8*)d = o0;
      *(h16x8*)(d + 8) = o1;
      __syncthreads();
    }
  }
}

__device__ void phase_norm(const Params p, int layer) {
  const int lane = otid() & 63, wid = otid() >> 6;
  const float* g = p.norm_g + layer * 1024;
  const int stride = gridDim.x * 4;
  for (int row0 = blockIdx.x * 4 + wid; row0 < T_ALL; row0 += 2 * stride) {
    const int row1 = row0 + stride;
    const bool has1 = row1 < T_ALL;
    const int r1 = has1 ? row1 : row0;
    const float* x0 = xptr(p, layer, row0);
    const float* x1 = xptr(p, layer, r1);
    f32x4 v0[4], v1[4];
    float s0 = 0.f, s1 = 0.f;
#pragma unroll
    for (int i = 0; i < 4; i++) {
      v0[i] = __builtin_nontemporal_load((const f32x4*)(x0 + i * 256 + lane * 4));
      v1[i] = __builtin_nontemporal_load((const f32x4*)(x1 + i * 256 + lane * 4));
    }
#pragma unroll
    for (int i = 0; i < 4; i++) {
      s0 += v0[i][0] * v0[i][0] + v0[i][1] * v0[i][1] + v0[i][2] * v0[i][2] + v0[i][3] * v0[i][3];
      s1 += v1[i][0] * v1[i][0] + v1[i][1] * v1[i][1] + v1[i][2] * v1[i][2] + v1[i][3] * v1[i][3];
    }
    s0 = wave_sum(s0);
    s1 = wave_sum(s1);
    const float rs0 = rsqrtf(s0 * (1.f / 1024.f) + 1e-6f), rs1 = rsqrtf(s1 * (1.f / 1024.f) + 1e-6f);
    const float* m0 = p.modv + (layer * 5 + cond_of(row0)) * 3072;
    const float* m1 = p.modv + (layer * 5 + cond_of(r1)) * 3072;
    f32x4 ggv[4], sh0v[4], sc0v[4], sh1v[4], sc1v[4];
#pragma unroll
    for (int i = 0; i < 4; i++) {
      const int k = i * 256 + lane * 4;
      ggv[i] = *(const f32x4*)(g + k);
      sh0v[i] = *(const f32x4*)(m0 + k); sc0v[i] = *(const f32x4*)(m0 + 1024 + k);
      sh1v[i] = *(const f32x4*)(m1 + k); sc1v[i] = *(const f32x4*)(m1 + 1024 + k);
    }
#pragma unroll
    for (int i = 0; i < 4; i++) {
      const int k = i * 256 + lane * 4;
      const f32x4 gg = ggv[i], sh0 = sh0v[i], sc0 = sc0v[i], sh1 = sh1v[i], sc1 = sc1v[i];
      const f32x4 o0 = v0[i] * rs0 * gg * (sc0 + 1.f) + sh0;
      const f32x4 o1 = v1[i] * rs1 * gg * (sc1 + 1.f) + sh1;
      store_h4(p.hbuf + (size_t)row0 * 1024 + k, o0[0], o0[1], o0[2], o0[3]);
      if (has1) store_h4(p.hbuf + (size_t)row1 * 1024 + k, o1[0], o1[1], o1[2], o1[3]);
    }
  }
}

__device__ void phase_final(const Params p) {
  const int lane = otid() & 63, wid = otid() >> 6;
  const float* g = p.final_norm_g;
  const int stride = gridDim.x * 4;
  for (int row0 = blockIdx.x * 4 + wid; row0 < T_ALL; row0 += 2 * stride) {
    const int row1 = row0 + stride;
    const bool has1 = row1 < T_ALL;
    float* x0 = p.out + (size_t)row0 * 1024;
    float* x1 = p.out + (size_t)(has1 ? row1 : row0) * 1024;
    f32x4 v0[4], v1[4];
    float s0 = 0.f, s1 = 0.f;
#pragma unroll
    for (int i = 0; i < 4; i++) {
      v0[i] = __builtin_nontemporal_load((const f32x4*)(x0 + i * 256 + lane * 4));
      v1[i] = __builtin_nontemporal_load((const f32x4*)(x1 + i * 256 + lane * 4));
    }
#pragma unroll
    for (int i = 0; i < 4; i++) {
      s0 += v0[i][0] * v0[i][0] + v0[i][1] * v0[i][1] + v0[i][2] * v0[i][2] + v0[i][3] * v0[i][3];
      s1 += v1[i][0] * v1[i][0] + v1[i][1] * v1[i][1] + v1[i][2] * v1[i][2] + v1[i][3] * v1[i][3];
    }
    s0 = wave_sum(s0);
    s1 = wave_sum(s1);
    const float rs0 = rsqrtf(s0 * (1.f / 1024.f) + 1e-6f), rs1 = rsqrtf(s1 * (1.f / 1024.f) + 1e-6f);
    f32x4 ggv[4];
#pragma unroll
    for (int i = 0; i < 4; i++) ggv[i] = *(const f32x4*)(g + i * 256 + lane * 4);
#pragma unroll
    for (int i = 0; i < 4; i++) {
      const int k = i * 256 + lane * 4;
      const f32x4 gg = ggv[i];
      __builtin_nontemporal_store(v0[i] * rs0 * gg, (f32x4*)(x0 + k));
      if (has1) __builtin_nontemporal_store(v1[i] * rs1 * gg, (f32x4*)(x1 + k));
    }
  }
}

__device__ void phase_g1(const Params p, int layer, char* smem) {
  const int lane = otid() & 63, wid = otid() >> 6, wr = wid >> 1, wc = wid & 1, l15 = lane & 15, g = lane >> 4;
  const h16* Wt = p.wt_in + (size_t)layer * 3072 * 1024;
  for (int tile = blockIdx.x; tile < 128 * 24; tile += gridDim.x) {
    const int rt = tile / 24, ct = tile % 24;
    const int r0 = rt * 128, n0 = ct * 128;
    f32x4 acc[4][4];
    zero_acc(acc);
    gemm_acc<128, 128>(acc, p.hbuf + (size_t)r0 * 1024, 1024, Wt + (size_t)n0 * 1024, 1024, 1024, smem);
    const bool ctx = r0 < T_CTX;
#pragma unroll
    for (int ni = 0; ni < 4; ni++) {
      const int col = n0 + wc * 64 + ni * 16 + 4 * g;
      if (col >= ZLD) continue;
      const int fb = n0 + wc * 64 + ni * 16;
#pragma unroll
      for (int mi = 0; mi < 4; mi++) {
        const int tok = r0 + wr * 64 + mi * 16 + l15;
        f32x4 v = acc[mi][ni];
        store_h4(p.zbuf + (size_t)tok * ZLD + col, v[0], v[1], v[2], v[3]);
        int b, l, Ls;
        if (ctx) { b = tok >> 8; l = tok & 255; Ls = 256; } else { b = (tok - T_CTX) >> 11; l = (tok - T_CTX) & 2047; Ls = 2048; }
        if (fb >= 384 && fb < 512) {
          h16* vt = p.vt_a_ctx + (ctx ? 0 : 1048576);
          int cc = col - 384;
#pragma unroll
          for (int j = 0; j < 4; j++) vt[((size_t)(b * 2 + ((cc + j) >> 6)) * 64 + ((cc + j) & 63)) * Ls + l] = (h16)v[j];
        } else if (fb >= 2464 && fb < 2720) {
          h16* vt = p.vt_d_ctx + (ctx ? 0 : 2097152);
          int cc = col - 2464;
#pragma unroll
          for (int j = 0; j < 4; j++) vt[((size_t)(b * 4 + ((cc + j) >> 6)) * 64 + ((cc + j) & 63)) * Ls + l] = (h16)v[j];
        }
        if (ctx) {
          const size_t rowi = (size_t)(b * 2 + layer) * 256 + l;
          const f32x4 fv = v;
          if (fb >= 256 && fb < 384) __builtin_nontemporal_store(fv, (f32x4*)(p.out + O_AK + rowi * 128 + (col - 256)));
          else if (fb >= 384 && fb < 512) __builtin_nontemporal_store(fv, (f32x4*)(p.out + O_AV + rowi * 128 + (col - 384)));
          else if (fb >= 1152 && fb < 1184) __builtin_nontemporal_store(fv, (f32x4*)(p.out + O_KPE + rowi * 32 + (col - 1152)));
          else if (fb >= 2208 && fb < 2464) __builtin_nontemporal_store(fv, (f32x4*)(p.out + O_NK + rowi * 256 + (col - 2208)));
          else if (fb >= 2464 && fb < 2720) __builtin_nontemporal_store(fv, (f32x4*)(p.out + O_NV + rowi * 256 + (col - 2464)));
        }
      }
    }
  }
}

#define BUS 136
__device__ void s5_item(const Params p, int layer, int mode0, int b0, int g0, int chunk0, int mode1, int b1, int g1, int chunk1, char* smem) {
  const int tid = otid(), lane = tid & 63, wid = tid >> 6, l15 = lane & 15, gq = lane >> 4;
  const int pr = wid >> 1, ptid = tid & 127;
  const int mode = pr ? mode1 : mode0, b = pr ? b1 : b0, g = pr ? g1 : g0, chunk = pr ? chunk1 : chunk0;
  char* pbase = smem + pr * 33280;
  h16* su = (h16*)pbase;
  h16* sbu = su + 256 * 16;
  h16* sy = sbu + 2 * 16 * BUS;
  const int tok0 = (mode == 0) ? b * 256 : T_CTX + b * 2048 + chunk * 256;
  if (mode >= 0) {
    for (int i = ptid; i < 512; i += 128) {
      int t = i >> 1, hf = i & 1;
      *(u32x4*)(su + t * 16 + hf * 8) = *(const u32x4*)(p.zbuf + (size_t)(tok0 + t) * ZLD + 1440 + g * 16 + hf * 8);
    }
  }
  __syncthreads();
  if (mode >= 0) {
    const int dir = wid & 1;
    const int ldg = (layer * 2 + dir) * 16 + g;
    const float ar = p.s5_abar[(ldg * 64 + lane) * 2], ai = p.s5_abar[(ldg * 64 + lane) * 2 + 1];
    const float dt = p.s5_dt[ldg];
    float hr = 0.f, hi = 0.f;
    if (mode == 2) {
      const size_t sidx = ((((size_t)b * 2 + layer) * 2 + dir) * 16 + g) * 64 + lane;
      hr = p.state_re[sidx];
      hi = p.state_im[sidx];
      float lr = p.s5_lamdt[(ldg * 64 + lane) * 2] * 256.f, li = p.s5_lamdt[(ldg * 64 + lane) * 2 + 1] * 256.f;
      float er = expf(lr), sn, cs;
      sincosf(li, &sn, &cs);
      const float pr = er * cs, pi = er * sn;
      const float* e = p.s5_e + ((((size_t)b * 16 + g) * 2 + dir) * 8) * 128;
      float ev_r[8], ev_i[8];
#pragma unroll
      for (int c2 = 0; c2 < 8; c2++) { ev_r[c2] = e[c2 * 128 + lane * 2]; ev_i[c2] = e[c2 * 128 + lane * 2 + 1]; }
      if (dir == 0) {
#pragma unroll
        for (int c2 = 0; c2 < 8; c2++)
          if (c2 < chunk) { const float nr = pr * hr - pi * hi + ev_r[c2], ni = pr * hi + pi * hr + ev_i[c2]; hr = nr; hi = ni; }
      } else {
#pragma unroll
        for (int c2 = 7; c2 >= 0; c2--)
          if (c2 > chunk) { const float nr = pr * hr - pi * hi + ev_r[c2], ni = pr * hi + pi * hr + ev_i[c2]; hr = nr; hi = ni; }
      }
    }
    h16x4 bfr[8];
    const h16* bmt = p.s5_bmt + (size_t)ldg * 128 * 16;
#pragma unroll
    for (int nf = 0; nf < 8; nf++) bfr[nf] = *(const h16x4*)(bmt + (nf * 16 + l15) * 16 + 4 * gq);
    h16x8 cfr[4];
    const h16* cmt = p.s5_cmt + (size_t)ldg * 16 * 128;
#pragma unroll
    for (int ks = 0; ks < 4; ks++) cfr[ks] = *(const h16x8*)(cmt + l15 * 128 + ks * 32 + 8 * gq);
    h16* bu = sbu + dir * 16 * BUS;
    h16* ydir = sy + dir * 256 * 16;
    for (int sub = 0; sub < 16; sub++) {
      const int sc = dir == 0 ? sub : 15 - sub;
      const int tt0 = sc * 16;
      h16x4 ua = *(const h16x4*)(su + (tt0 + l15) * 16 + 4 * gq);
#pragma unroll
      for (int nf = 0; nf < 8; nf++) {
        f32x4 r = __builtin_amdgcn_mfma_f32_16x16x16f16(bfr[nf], ua, f32x4{0.f, 0.f, 0.f, 0.f}, 0, 0, 0);
        store_h4(bu + l15 * BUS + nf * 16 + 4 * gq, r[0], r[1], r[2], r[3]);
      }
      __builtin_amdgcn_wave_barrier();
      {
        float vr[16], vi[16];
#pragma unroll
        for (int s = 0; s < 16; s++) { vr[s] = (float)bu[s * BUS + lane]; vi[s] = (float)bu[s * BUS + 64 + lane]; }
        if (dir == 0) {
#pragma unroll
          for (int s = 0; s < 16; s++) {
            const float nr = ar * hr - ai * hi + dt * vr[s], ni = ar * hi + ai * hr + dt * vi[s];
            hr = nr; hi = ni; vr[s] = nr; vi[s] = ni;
          }
        } else {
#pragma unroll
          for (int s = 15; s >= 0; s--) {
            const float nr = ar * hr - ai * hi + dt * vr[s], ni = ar * hi + ai * hr + dt * vi[s];
            hr = nr; hi = ni; vr[s] = nr; vi[s] = ni;
          }
        }
#pragma unroll
        for (int s = 0; s < 16; s++) { bu[s * BUS + lane] = (h16)vr[s]; bu[s * BUS + 64 + lane] = (h16)vi[s]; }
      }
      __builtin_amdgcn_wave_barrier();
      if (mode != 1) {
        f32x4 y = {0.f, 0.f, 0.f, 0.f};
#pragma unroll
        for (int ks = 0; ks < 4; ks++) {
          h16x8 ha = *(const h16x8*)(bu + l15 * BUS + ks * 32 + 8 * gq);
          y = __builtin_amdgcn_mfma_f32_16x16x32_f16(cfr[ks], ha, y, 0, 0, 0);
        }
        store_h4(ydir + (tt0 + l15) * 16 + 4 * gq, y[0], y[1], y[2], y[3]);
      }
      __builtin_amdgcn_wave_barrier();
    }
    if (mode == 0) {
      const size_t oi = ((((size_t)b * 2 + layer) * 2 + dir) * 16 + g) * 64 + lane;
      p.out[O_SRE + oi] = hr;
      p.out[O_SIM + oi] = hi;
    } else if (mode == 1) {
      float* e = p.s5_e + (((((size_t)b * 16 + g) * 2 + dir) * 8) + chunk) * 128;
      e[lane * 2] = hr;
      e[lane * 2 + 1] = hi;
    }
  }
  __syncthreads();
  if (mode == 0 || mode == 2) {
    const float dsk = p.s5_d[layer * 256 + g * 16 + (ptid & 15)];
    for (int i = ptid; i < 256 * 16; i += 128) {
      int t = i >> 4, c = i & 15;
      float u = (float)su[i];
      float v = (float)sy[i] + (float)sy[256 * 16 + i] + dsk * u;
      p.zbuf[(size_t)(tok0 + t) * ZLD + 1440 + g * 16 + c] = (h16)geluf_(v);
    }
  }
  __syncthreads();
}


template <int NCOL>
__device__ __forceinline__ void row_rstd(const h16* __restrict__ base, float* rs) {
  const int tid = otid(), row = tid >> 1, hf = tid & 1;
  const h16* ptr = base + (size_t)row * ZLD + hf * (NCOL / 2);
  float s = 0.f;
#pragma unroll
  for (int i = 0; i < NCOL / 16; i++) {
    h16x8 v = *(const h16x8*)(ptr + i * 8);
#pragma unroll
    for (int j = 0; j < 8; j++) s += (float)v[j] * (float)v[j];
  }
  s += __shfl_xor(s, 1);
  if (hf == 0) rs[row] = rsqrtf(s * (1.f / NCOL) + 1e-6f);
}

__device__ void phase_g2(const Params p, int layer, char* smem) {
  const int tid = otid(), lane = tid & 63, wid = tid >> 6, wr = wid >> 1, wc = wid & 1, l15 = lane & 15, g = lane >> 4;
  for (int it = blockIdx.x; it < 512; it += gridDim.x)
    s5_item(p, layer, 0, it >> 4, it & 15, 0, 1, it >> 7, (it >> 3) & 15, it & 7, smem);
  int qrt, qct;
  for (int qi_ = 0; xcd_tile(qi_, 128, 6, qrt, qct); qi_++) {
    {
      const int rt = qrt, ct = qct, r0 = rt * 128, n0 = ct * 64;
      float* rs = (float*)(smem + 49152);
      row_rstd<256>(p.zbuf + (size_t)r0 * ZLD + 768, rs);
      f32x4 acc[4][2];
      zero_acc(acc);
      gemm_acc<128, 64>(acc, p.zbuf + (size_t)r0 * ZLD + 768, ZLD, p.wt_qup + (size_t)layer * 384 * 256 + (size_t)n0 * 256, 256, 256, smem);
      __syncthreads();
      const bool lat = r0 >= T_CTX;
#pragma unroll
      for (int mi = 0; mi < 4; mi++) {
        const int row = wr * 64 + mi * 16 + l15, tok = r0 + row;
        const float rstd = rs[row];
#pragma unroll
        for (int ni = 0; ni < 2; ni++) {
          const int fb = n0 + wc * 32 + ni * 16;
          f32x4 v = acc[mi][ni] * rstd;
          store_h4(p.qm + (size_t)tok * 384 + fb + 4 * g, v[0], v[1], v[2], v[3]);
        }
      }
      __syncthreads();
      if (lat && ct != 0 && ct != 3) {
        const int rc0 = n0 + ((ct == 2 || ct == 5) ? 32 : 0);
        float rx1[8], rx2[8], rcs[8], rsn[8];
#pragma unroll
        for (int q = 0; q < 8; q++) {
          const int i = tid + q * 256, row = i >> 4, e = i & 15, tok = r0 + row;
          const int i8 = e & 7, base = (e < 8) ? 0 : 16;
          const int lpos = (tok - T_CTX) & 2047;
          const int pos = (e < 8) ? (lpos >> 6) : (lpos & 63);
          const h16* ptr = p.qm + (size_t)tok * 384 + rc0 + base + i8;
          rx1[q] = (float)ptr[0]; rx2[q] = (float)ptr[8];
          rcs[q] = p.cs8[(pos * 8 + i8) * 2]; rsn[q] = p.cs8[(pos * 8 + i8) * 2 + 1];
        }
#pragma unroll
        for (int q = 0; q < 8; q++) {
          const int i = tid + q * 256, row = i >> 4, e = i & 15, tok = r0 + row;
          const int i8 = e & 7, base = (e < 8) ? 0 : 16;
          h16* ptr = p.qm + (size_t)tok * 384 + rc0 + base + i8;
          ptr[0] = (h16)(rx1[q] * rcs[q] - rx2[q] * rsn[q]);
          ptr[8] = (h16)(rx1[q] * rsn[q] + rx2[q] * rcs[q]);
        }
      }
      __syncthreads();
    }
  }
  for (int it = gridDim.x - 1 - blockIdx.x; it < 1024 + 128; it += gridDim.x) {
    const int N_KV = 1024;
    {
      const bool cached = it >= N_KV;
      int rt, ct;
      const h16 *A, *Bt;
      int lda;
      if (!cached) { rt = it >> 3; ct = it & 7; A = p.zbuf + (size_t)(rt * 128) * ZLD + 1024; lda = ZLD; Bt = p.wt_kvup + (size_t)layer * 512 * 128; }
      else { int i2 = it - N_KV; rt = i2 >> 3; ct = i2 & 7; int b = rt >> 2, k0 = (rt & 3) * 128; A = p.ckv_c + ((size_t)(b * 2 + layer) * 512 + k0) * 128; lda = 128; Bt = p.wt_kvraw + (size_t)layer * 512 * 128; }
      const int r0 = rt * 128, n0 = ct * 64;
      float* rs = (float*)(smem + 49152);
      if (!cached) {
        row_rstd<128>(p.zbuf + (size_t)r0 * ZLD + 1024, rs);
      } else {
        if (tid < 128) rs[tid] = 1.f;
      }
      f32x4 acc[4][2];
      zero_acc(acc);
      gemm_acc<128, 64>(acc, A, lda, Bt + (size_t)n0 * 128, 128, 128, smem);
      const int head = n0 >> 7;
      const bool vtype = (n0 & 64) != 0;
#pragma unroll
      for (int mi = 0; mi < 4; mi++) {
        const int row = wr * 64 + mi * 16 + l15, tok = r0 + row;
        const float rstd = rs[row];
#pragma unroll
        for (int ni = 0; ni < 2; ni++) {
          const int d0 = wc * 32 + ni * 16 + 4 * g;
          f32x4 v = acc[mi][ni] * rstd;
          if (!vtype) {
            h16* dst = p.kmla + (cached ? (size_t)T_ALL * 384 : (size_t)0);
            store_h4(dst + (size_t)tok * 384 + head * 96 + d0, v[0], v[1], v[2], v[3]);
          } else {
            h16* vt; int bb, l, Ls;
            int voff;
            if (cached) { voff = 4194304; bb = tok >> 9; l = tok & 511; Ls = 512; }
            else if (tok < T_CTX) { voff = 0; bb = tok >> 8; l = tok & 255; Ls = 256; }
            else { voff = 2097152; bb = (tok - T_CTX) >> 11; l = (tok - T_CTX) & 2047; Ls = 2048; }
            vt = p.vt_m_ctx + voff;
#pragma unroll
            for (int j = 0; j < 4; j++) vt[((size_t)(bb * 4 + head) * 64 + d0 + j) * Ls + l] = (h16)v[j];
          }
        }
      }
      if (ct == 0 && !cached && r0 < T_CTX) {
        const float* gk = p.mla_kv_norm + layer * 128;
#pragma unroll
        for (int q = 0; q < 8; q++) {
          const int i = tid + q * 256, row = i >> 4, k = (i & 15) * 8, tok = r0 + row;
          const h16x8 zv = *(const h16x8*)(p.zbuf + (size_t)tok * ZLD + 1024 + k);
          const float rr = rs[row];
          const f32x4 g0 = *(const f32x4*)(gk + k), g1 = *(const f32x4*)(gk + k + 4);
          float* dst = p.out + O_CKV + ((size_t)((tok >> 8) * 2 + layer) * 256 + (tok & 255)) * 128 + k;
          __builtin_nontemporal_store(f32x4{(float)zv[0] * rr * g0[0], (float)zv[1] * rr * g0[1], (float)zv[2] * rr * g0[2], (float)zv[3] * rr * g0[3]}, (f32x4*)dst);
          __builtin_nontemporal_store(f32x4{(float)zv[4] * rr * g1[0], (float)zv[5] * rr * g1[1], (float)zv[6] * rr * g1[2], (float)zv[7] * rr * g1[3]}, (f32x4*)(dst + 4));
        }
      }
      if (ct == 1) {
        float kx1[8], kx2[8];
#pragma unroll
        for (int q = 0; q < 8; q++) {
          const int i = tid + q * 256, row = i >> 4, e = i & 15, tok = r0 + row;
          if (cached) {
            const int bb = tok >> 9, key = tok & 511;
            const float* src = p.cache_mla_kpe + ((size_t)(bb * 2 + layer) * 512 + key) * 32;
            kx1[q] = src[e]; kx2[q] = src[16 + e];
          } else {
            const h16* src = p.zbuf + (size_t)tok * ZLD + 1152;
            const int i8 = e & 7, base = (e < 8) ? 0 : 16;
            float x1 = (float)src[base + i8], x2 = (float)src[base + 8 + i8];
            if (tok >= T_CTX) {
              const int lpos = (tok - T_CTX) & 2047;
              const int pos = (e < 8) ? (lpos >> 6) : (lpos & 63);
              const float cs = p.cs8[(pos * 8 + i8) * 2], sn = p.cs8[(pos * 8 + i8) * 2 + 1];
              const float o1 = x1 * cs - x2 * sn, o2 = x1 * sn + x2 * cs;
              x1 = o1; x2 = o2;
            }
            kx1[q] = x1; kx2[q] = x2;
          }
        }
#pragma unroll
        for (int q = 0; q < 8; q++) {
          const int i = tid + q * 256, row = i >> 4, e = i & 15, tok = r0 + row;
          const h16 v1 = (h16)kx1[q], v2 = (h16)kx2[q];
          if (cached) {
            h16* dst = p.kmla + (size_t)T_ALL * 384 + (size_t)tok * 384;
#pragma unroll
            for (int h = 0; h < 4; h++) { dst[h * 96 + 64 + e] = v1; dst[h * 96 + 80 + e] = v2; }
          } else {
            const int i8 = e & 7, base = (e < 8) ? 0 : 16;
            h16* dst = p.kmla + (size_t)tok * 384;
#pragma unroll
            for (int h = 0; h < 4; h++) { dst[h * 96 + 64 + base + i8] = v1; dst[h * 96 + 64 + base + 8 + i8] = v2; }
          }
        }
      }
      __syncthreads();
    }
  }
  for (int it = (blockIdx.x + (gridDim.x >> 1)) % gridDim.x; it < 128; it += gridDim.x) {
    {
      const int t0 = T_CTX + it * 64;
#pragma unroll
      for (int q = 0; q < 6; q++) {
        const int i = tid + q * 256;
        const int tl = i / 24, vi = i % 24;
        const int tok = t0 + tl, lpos = (tok - T_CTX) & 2047;
        const int head = vi >> 2, part = (vi >> 1) & 1, grp = vi & 1;
        const int pos = part ? (lpos & 63) : (lpos >> 6);
        h16* ptr = p.zbuf + (size_t)tok * ZLD + head * 64 + part * 32 + grp * 8;
        const h16x8 x1 = *(const h16x8*)ptr, x2 = *(const h16x8*)(ptr + 16);
        const float* tb = p.cs16 + (pos * 16 + grp * 8) * 2;
        h16x8 o1, o2;
#pragma unroll
        for (int j = 0; j < 8; j++) {
          const float cs = tb[2 * j], sn = tb[2 * j + 1];
          o1[j] = (h16)((float)x1[j] * cs - (float)x2[j] * sn);
          o2[j] = (h16)((float)x1[j] * sn + (float)x2[j] * cs);
        }
        *(h16x8*)ptr = o1;
        *(h16x8*)(ptr + 16) = o2;
      }
    }
  }
}

struct Seg { const h16* K; const h16* Vt; int ldk, ldv, ntiles; };

#define LDSP(x) ((__attribute__((address_space(3))) unsigned*)(x))
template <int DQK, int MODE, int QREP>
__device__ void attn_item(const h16* __restrict__ Q, int ldq, Seg s0, Seg s1, float scale_l2, bool has_sink, float sink_l2,
                          int qpos0, int kpos0, const float* __restrict__ rpb_h, int qrow, int krow0,
                          h16* __restrict__ outp, const h16* __restrict__ gate, char* smem) {
  constexpr int KCH = DQK / 8;
  constexpr int KROWB = DQK * 2;
  constexpr int KPT = 64 * KCH / 256;
  constexpr int KBYTES = 64 * KROWB;
  constexpr int STAGE = KBYTES + 8192;
  constexpr int NKS = DQK / 32;
  constexpr int G = KPT + 2;
  const int tid = otid(), lane = tid & 63, wid = tid >> 6, l15 = lane & 15, g = lane >> 4;
  float* sbias = (float*)(smem + 49152);
  if (MODE == 2) {
    for (int i = tid; i < 15 * 31; i += 256) sbias[i] = rpb_h[i] * LOG2E;
  }
  h16x8 qf[QREP][NKS];
#pragma unroll
  for (int qi = 0; qi < QREP; qi++)
#pragma unroll
    for (int ks = 0; ks < NKS; ks++) {
      h16x8 qv = *(const h16x8*)(Q + (size_t)(wid * 16 * QREP + qi * 16 + l15) * ldq + ks * 32 + 8 * g);
#pragma unroll
      for (int j = 0; j < 8; j++) qv[j] = (h16)((float)qv[j] * scale_l2);
      qf[qi][ks] = qv;
    }
  float m[QREP], lsum[QREP];
  f32x4 o[QREP][4];
#pragma unroll
  for (int qi = 0; qi < QREP; qi++) {
    m[qi] = has_sink ? sink_l2 : -1e30f;
    lsum[qi] = (has_sink && g == 0) ? 1.f : 0.f;
#pragma unroll
    for (int i = 0; i < 4; i++) o[qi][i] = f32x4{0.f, 0.f, 0.f, 0.f};
  }
  const int ntot = s0.ntiles + s1.ntiles;
  const int lsl = (tid & 7) ^ ((tid >> 4) & 7);
#define TILE_PTRS(ti_) \
    const h16 *kp, *vp; int ldk, ldv; \
    if ((ti_) < s0.ntiles) { kp = s0.K + (size_t)(ti_) * 64 * s0.ldk; vp = s0.Vt + (ti_) * 64; ldk = s0.ldk; ldv = s0.ldv; } \
    else { int t2 = (ti_) - s0.ntiles; kp = s1.K + (size_t)t2 * 64 * s1.ldk; vp = s1.Vt + t2 * 64; ldk = s1.ldk; ldv = s1.ldv; }
#define ATT_ISSUE(ti_, st_)                                                                                         \
  {                                                                                                                 \
    TILE_PTRS(ti_)                                                                                                  \
    char* dk_ = smem + (st_) * STAGE + tid * 16;                                                                    \
    _Pragma("unroll") for (int i = 0; i < KPT; i++) {                                                               \
      const h16* src_;                                                                                              \
      if (DQK == 64) src_ = kp + (size_t)((tid >> 3) + i * 32) * ldk + lsl * 8;                                     \
      else { const int c_ = tid + i * 256; src_ = kp + (size_t)(c_ / KCH) * ldk + (c_ % KCH) * 8; }                 \
      __builtin_amdgcn_global_load_lds((const unsigned*)src_, LDSP(dk_ + i * 4096), 16, 0, 0);                      \
    }                                                                                                               \
    _Pragma("unroll") for (int i = 0; i < 2; i++)                                                                   \
      __builtin_amdgcn_global_load_lds((const unsigned*)(vp + (size_t)((tid >> 3) + i * 32) * ldv + lsl * 8), LDSP(dk_ + KBYTES + i * 4096), 16, 0, 0); \
  }
  asm volatile("s_waitcnt vmcnt(0)" ::: "memory");
  ATT_ISSUE(0, 0)
  if (ntot > 1) ATT_ISSUE(1, 1)
  int st = 0;
  for (int ti = 0; ti < ntot; ti++) {
    if (ti + 1 < ntot) asm volatile("s_waitcnt vmcnt(%0)" ::"n"(G) : "memory");
    else asm volatile("s_waitcnt vmcnt(0)" ::: "memory");
    asm volatile("s_waitcnt lgkmcnt(0)" ::: "memory");
    __builtin_amdgcn_s_barrier();
    asm volatile("" ::: "memory");
    if (ti + 2 < ntot) { const int st2 = (st == 0) ? 2 : st - 1; ATT_ISSUE(ti + 2, st2) }
    const char* sk = smem + st * STAGE;
    const char* sv = sk + KBYTES;
    st = (st == 2) ? 0 : st + 1;
    f32x4 s[QREP][4];
#pragma unroll
    for (int kf = 0; kf < 4; kf++) {
#pragma unroll
      for (int qi = 0; qi < QREP; qi++) s[qi][kf] = f32x4{0.f, 0.f, 0.f, 0.f};
#pragma unroll
      for (int ks = 0; ks < NKS; ks++) {
        const int row = kf * 16 + l15, sl = ks * 4 + g;
        const int off = (DQK == 64) ? SWZ(row, sl) : (row * KROWB + sl * 16);
        h16x8 ka = *(const h16x8*)(sk + off);
#pragma unroll
        for (int qi = 0; qi < QREP; qi++) s[qi][kf] = __builtin_amdgcn_mfma_f32_16x16x32_f16(ka, qf[qi][ks], s[qi][kf], 0, 0, 0);
      }
    }
    const bool masked = (MODE != 0) && (ti < s0.ntiles);
    typedef float f32x2 __attribute__((ext_vector_type(2)));
    h16x8 pb[QREP][2];
    float alpha[QREP];
#pragma unroll
    for (int qi = 0; qi < QREP; qi++) {
      if (MODE != 0 && masked) {
#pragma unroll
        for (int kf = 0; kf < 4; kf++)
#pragma unroll
          for (int j = 0; j < 4; j++) {
            float x = s[qi][kf][j];
            if (MODE == 1) {
              int kpos = kpos0 + ti * 64 + kf * 16 + 4 * g + j, qpos = qpos0 + wid * 16 * QREP + qi * 16 + l15;
              int d = qpos - kpos;
              if (d > 128 || d < -128) x = -INFINITY;
            }
            if (MODE == 2) {
              int ck = kf * 16 + 4 * g + j, cq = wid * 16 * QREP + qi * 16 + l15;
              int cs = min(max(cq - 8, 0), 48);
              int rel = ck - cs;
              if (rel < 0 || rel >= 16) x = -INFINITY;
              else {
                int co = min(max(ck - cq, -15), 15) + 15;
                int ro = (krow0 + ti) - qrow + 7;
                x += sbias[ro * 31 + co];
              }
            }
            s[qi][kf][j] = x;
          }
      }
      float mx = fmaxf(fmaxf(fmaxf(s[qi][0][0], s[qi][0][1]), fmaxf(s[qi][0][2], s[qi][0][3])), fmaxf(fmaxf(s[qi][1][0], s[qi][1][1]), fmaxf(s[qi][1][2], s[qi][1][3])));
      mx = fmaxf(mx, fmaxf(fmaxf(fmaxf(s[qi][2][0], s[qi][2][1]), fmaxf(s[qi][2][2], s[qi][2][3])), fmaxf(fmaxf(s[qi][3][0], s[qi][3][1]), fmaxf(s[qi][3][2], s[qi][3][3]))));
      mx = fmaxf(mx, __shfl_xor(mx, 16));
      mx = fmaxf(mx, __shfl_xor(mx, 32));
      const float mnew = fmaxf(m[qi], mx);
      alpha[qi] = __builtin_amdgcn_exp2f(m[qi] - mnew);
      m[qi] = mnew;
      const f32x2 mn2 = {mnew, mnew};
      f32x2 ps2 = {0.f, 0.f};
#pragma unroll
      for (int kf = 0; kf < 4; kf++)
#pragma unroll
        for (int jp = 0; jp < 2; jp++) {
          f32x2 d2 = f32x2{s[qi][kf][2 * jp], s[qi][kf][2 * jp + 1]} - mn2;
          f32x2 e2 = {__builtin_amdgcn_exp2f(d2[0]), __builtin_amdgcn_exp2f(d2[1])};
          ps2 += e2;
          pb[qi][kf >> 1][(kf & 1) * 4 + 2 * jp] = (h16)e2[0];
          pb[qi][kf >> 1][(kf & 1) * 4 + 2 * jp + 1] = (h16)e2[1];
        }
      lsum[qi] = lsum[qi] * alpha[qi] + (ps2[0] + ps2[1]);
    }
#pragma unroll
    for (int df = 0; df < 4; df++) {
#pragma unroll
      for (int qi = 0; qi < QREP; qi++) o[qi][df] = o[qi][df] * alpha[qi];
#pragma unroll
      for (int kk = 0; kk < 2; kk++) {
        const int row = df * 16 + l15;
        const int c0 = 8 * kk + g, c1 = 8 * kk + 4 + g;
        h16x4 v0 = *(const h16x4*)(sv + SWZ(row, c0 >> 1) + (c0 & 1) * 8);
        h16x4 v1 = *(const h16x4*)(sv + SWZ(row, c1 >> 1) + (c1 & 1) * 8);
        h16x8 va = {v0[0], v0[1], v0[2], v0[3], v1[0], v1[1], v1[2], v1[3]};
#pragma unroll
        for (int qi = 0; qi < QREP; qi++) o[qi][df] = __builtin_amdgcn_mfma_f32_16x16x32_f16(va, pb[qi][kk], o[qi][df], 0, 0, 0);
      }
    }
  }
  asm volatile("" ::: "memory");
  __builtin_amdgcn_s_barrier();
  asm volatile("" ::: "memory");
#pragma unroll
  for (int qi = 0; qi < QREP; qi++) {
    float l = lsum[qi];
    l += __shfl_xor(l, 16);
    l += __shfl_xor(l, 32);
    const float inv = 1.f / l;
    const int qr = wid * 16 * QREP + qi * 16 + l15;
    h16x4 gva[4];
#pragma unroll
    for (int df = 0; df < 4; df++) gva[df] = *(const h16x4*)(gate + (size_t)qr * ZLD + df * 16 + 4 * g);
#pragma unroll
    for (int df = 0; df < 4; df++) {
      const int d = df * 16 + 4 * g;
      const h16x4 gv = gva[df];
      store_h4(outp + (size_t)qr * 1024 + d, o[qi][df][0] * inv * siluf_((float)gv[0]), o[qi][df][1] * inv * siluf_((float)gv[1]),
               o[qi][df][2] * inv * siluf_((float)gv[2]), o[qi][df][3] * inv * siluf_((float)gv[3]));
    }
  }
}

__device__ void phase_att(const Params p, int layer, char* smem) {
  const float sc64 = 0.125f * LOG2E, sc96 = 0.10206207261596575f * LOG2E;
  Seg s0, s1;
  for (int vb = blockIdx.x; vb < 512; vb += gridDim.x) {
    const bool first = vb < 256;
    const int i = (vb & 7) * 32 + ((vb >> 3) & 31);
    {
      const int idx = vb;
      s5_item(p, layer, 2, idx >> 7, (idx >> 3) & 15, idx & 7, -1, 0, 0, 0, smem);
    }
    if (first)
    for (int e3 = 0; e3 < 2; e3++) {
      const bool first = e3 == 0;
      int b, h, tokb, tok0;
      if (first) { b = i >> 6; h = (i >> 4) & 3; tokb = T_CTX + b * 2048; tok0 = tokb + (i & 15) * 128; }
      else { b = i >> 3; h = (i >> 1) & 3; tokb = b * 256; tok0 = tokb + (i & 1) * 128; }
      s0.K = p.kmla + (size_t)tokb * 384 + h * 96; s0.ldk = 384;
      if (first) {
        s0.Vt = p.vt_m_lat + (size_t)(b * 4 + h) * 64 * 2048; s0.ldv = 2048; s0.ntiles = 32;
        s1.K = p.kcx + (size_t)(b * 512) * 384 + h * 96; s1.ldk = 384; s1.Vt = p.vcx_t + (size_t)(b * 4 + h) * 64 * 512; s1.ldv = 512; s1.ntiles = 8;
      } else {
        s0.Vt = p.vt_m_ctx + (size_t)(b * 4 + h) * 64 * 256; s0.ldv = 256; s0.ntiles = 4;
        s1.K = s0.K; s1.Vt = s0.Vt; s1.ldk = 0; s1.ldv = 0; s1.ntiles = 0;
      }
      attn_item<96, 0, 2>(p.qm + (size_t)tok0 * 384 + h * 96, 384, s0, s1, sc96, false, 0.f, 0, 0, nullptr, 0, 0,
                          p.br + (size_t)tok0 * 1024 + 256 + h * 64, p.zbuf + (size_t)tok0 * ZLD + 1184 + h * 64, smem);
    }
    if (first)
    for (int e2 = 0; e2 < 2; e2++) {
      const bool isA = e2 == 0;
      const int b = i >> 3, h = (i >> 1) & 3, qt = i & 1;
      const int tokb = b * 256, tok0 = tokb + qt * 128;
      int qcol, kcol, gcol, bcol;
      if (isA) { const int hk = h >> 1; qcol = h * 64; kcol = 256 + hk * 64; gcol = 512 + h * 64; bcol = h * 64; s0.Vt = p.vt_a_ctx + (size_t)(b * 2 + hk) * 64 * 256; }
      else { qcol = 1952 + h * 64; kcol = 2208 + h * 64; gcol = 2720 + h * 64; bcol = 768 + h * 64; s0.Vt = p.vt_d_ctx + (size_t)(b * 4 + h) * 64 * 256; }
      s0.K = p.zbuf + (size_t)tokb * ZLD + kcol; s0.ldk = ZLD; s0.ldv = 256; s0.ntiles = 4;
      s1.K = s0.K; s1.Vt = s0.Vt; s1.ldk = 0; s1.ldv = 0; s1.ntiles = 0;
      const float sink = isA ? p.a_sink[layer * 4 + h] * LOG2E : 0.f;
      attn_item<64, 0, 2>(p.zbuf + (size_t)tok0 * ZLD + qcol, ZLD, s0, s1, sc64, isA, sink, 0, 0, nullptr, 0, 0,
                          p.br + (size_t)tok0 * 1024 + bcol, p.zbuf + (size_t)tok0 * ZLD + gcol, smem);
    }
    if (!first) {
      for (int e = 0; e < 2; e++) {
        const int idx = 2 * i + e;
        const int b = idx >> 7, h = (idx >> 5) & 3, qt = idx & 31;
        const int tokb = T_CTX + b * 2048, tok0 = tokb + qt * 64;
        const int r = qt, rs = min(max(r - 4, 0), 24);
        s0.K = p.zbuf + (size_t)(tokb + rs * 64) * ZLD + 2208 + h * 64; s0.ldk = ZLD; s0.Vt = p.vt_d_lat + (size_t)(b * 4 + h) * 64 * 2048 + rs * 64; s0.ldv = 2048; s0.ntiles = 8;
        s1.K = p.ck_n + (size_t)((b * 2 + layer) * 512) * 256 + h * 64; s1.ldk = 256; s1.Vt = p.cvt_n + (size_t)((b * 2 + layer) * 4 + h) * 64 * 512; s1.ldv = 512; s1.ntiles = 8;
        attn_item<64, 2, 1>(p.zbuf + (size_t)tok0 * ZLD + 1952 + h * 64, ZLD, s0, s1, sc64, false, 0.f, 0, 0,
                            p.na_rpb + (size_t)(layer * 4 + h) * 15 * 31, r, rs,
                            p.br + (size_t)tok0 * 1024 + 768 + h * 64, p.zbuf + (size_t)tok0 * ZLD + 2720 + h * 64, smem);
      }
      for (int e = 0; e < 2; e++) {
        const int idx = 2 * i + e;
        const int b = idx >> 7, h = (idx >> 5) & 3, qt = idx & 31;
        const int tokb = T_CTX + b * 2048, tok0 = tokb + qt * 64;
        const int hk = h >> 1, q0 = qt * 64;
        const int ks = max(0, q0 - 128), ke = min(2048, q0 + 192);
        s0.K = p.zbuf + (size_t)(tokb + ks) * ZLD + 256 + hk * 64; s0.ldk = ZLD; s0.Vt = p.vt_a_lat + (size_t)(b * 2 + hk) * 64 * 2048 + ks; s0.ldv = 2048; s0.ntiles = (ke - ks) >> 6;
        s1.K = p.ck_a + (size_t)((b * 2 + layer) * 512) * 128 + hk * 64; s1.ldk = 128; s1.Vt = p.cvt_a + (size_t)((b * 2 + layer) * 2 + hk) * 64 * 512; s1.ldv = 512; s1.ntiles = 8;
        attn_item<64, 1, 1>(p.zbuf + (size_t)tok0 * ZLD + h * 64, ZLD, s0, s1, sc64, true, p.a_sink[layer * 4 + h] * LOG2E, q0, ks, nullptr, 0, 0,
                            p.br + (size_t)tok0 * 1024 + h * 64, p.zbuf + (size_t)tok0 * ZLD + 512 + h * 64, smem);
      }
    }
  }
}

__device__ void phase_glu(const Params p, int layer, char* smem) {
  const int lane = otid() & 63, wid = otid() >> 6, wr = wid >> 1, wc = wid & 1, l15 = lane & 15, g = lane >> 4;
  int rt, ct;
  for (int ti = 0; xcd_tile(ti, 128, 4, rt, ct); ti++) {
    const int r0 = rt * 128, n0 = ct * 128;
    f32x4 acc[4][4];
    zero_acc(acc);
    gemm_acc<128, 128>(acc, p.zbuf + (size_t)r0 * ZLD + 1440, ZLD, p.wt_glu + (size_t)layer * 512 * 256 + (size_t)n0 * 256, 256, 256, smem);
    h16x4 cgv[4][2];
#pragma unroll
    for (int mi = 0; mi < 4; mi++)
#pragma unroll
      for (int np = 0; np < 2; np++) {
        const int tok = r0 + wr * 64 + mi * 16 + l15, col = ((n0 + wc * 64 + np * 32) >> 5) * 16 + 4 * g;
        cgv[mi][np] = *(const h16x4*)(p.zbuf + (size_t)tok * ZLD + 1696 + col);
      }
#pragma unroll
    for (int mi = 0; mi < 4; mi++) {
      const int tok = r0 + wr * 64 + mi * 16 + l15;
#pragma unroll
      for (int np = 0; np < 2; np++) {
        const int pn = n0 + wc * 64 + np * 32;
        const int col = (pn >> 5) * 16 + 4 * g;
        f32x4 val = acc[mi][np * 2], gt = acc[mi][np * 2 + 1];
        const h16x4 cg_ = cgv[mi][np];
        store_h4(p.br + (size_t)tok * 1024 + 512 + col, val[0] * sigmoidf_(gt[0]) * siluf_((float)cg_[0]),
                 val[1] * sigmoidf_(gt[1]) * siluf_((float)cg_[1]), val[2] * sigmoidf_(gt[2]) * siluf_((float)cg_[2]),
                 val[3] * sigmoidf_(gt[3]) * siluf_((float)cg_[3]));
      }
    }
  }
}

__device__ void phase_g3(const Params p, int layer, char* smem) {
  const int lane = otid() & 63, wid = otid() >> 6, wr = wid >> 1, wc = wid & 1, l15 = lane & 15, g = lane >> 4;
  const h16* Wm = p.wt_merge + (size_t)layer * 4096 * 1024;
  const h16* Wb = p.wt_branch + (size_t)layer * 4 * 1024 * 256;
  h16* mbuf = p.zbuf;
  typedef __attribute__((ext_vector_type(2))) unsigned u32x2;
  int rt, ct;
  for (int ti = 0; xcd_tile(ti, 128, 8, rt, ct); ti++) {
    const int r0 = rt * 128, d0 = ct * 128;
    h16x4 macc[4][4];
#pragma unroll
    for (int mi = 0; mi < 4; mi++)
#pragma unroll
      for (int ni = 0; ni < 4; ni++) macc[mi][ni] = h16x4{(h16)0.f, (h16)0.f, (h16)0.f, (h16)0.f};
#pragma unroll 1
    for (int k = 0; k < 4; k++) {
      u32x2 sg[4][4];
      {
        f32x4 a1[4][4];
        zero_acc(a1);
        gemm_acc<128, 128, true>(a1, p.hbuf + (size_t)r0 * 1024, 1024, Wm + (size_t)(k * 1024 + d0) * 1024, 1024, 1024, smem);
#pragma unroll
        for (int mi = 0; mi < 4; mi++)
#pragma unroll
          for (int ni = 0; ni < 4; ni++) {
            h16x4 hv = {(h16)sigmoidf_(a1[mi][ni][0]), (h16)sigmoidf_(a1[mi][ni][1]), (h16)sigmoidf_(a1[mi][ni][2]), (h16)sigmoidf_(a1[mi][ni][3])};
            sg[mi][ni] = __builtin_bit_cast(u32x2, hv);
          }
      }
      f32x4 a2[4][4];
      zero_acc(a2);
      gemm_acc<128, 128, true>(a2, p.br + (size_t)r0 * 1024 + k * 256, 1024, Wb + (size_t)(k * 1024 + d0) * 256, 256, 256, smem);
#pragma unroll
      for (int mi = 0; mi < 4; mi++)
#pragma unroll
        for (int ni = 0; ni < 4; ni++) {
          const h16x4 hv = __builtin_bit_cast(h16x4, sg[mi][ni]);
          const h16x4 a2h = {(h16)a2[mi][ni][0], (h16)a2[mi][ni][1], (h16)a2[mi][ni][2], (h16)a2[mi][ni][3]};
          macc[mi][ni] = hv * a2h + macc[mi][ni];
        }
    }
#pragma unroll
    for (int mi = 0; mi < 4; mi++)
#pragma unroll
      for (int ni = 0; ni < 4; ni++) {
        const int tok = r0 + wr * 64 + mi * 16 + l15, col = d0 + wc * 64 + ni * 16 + 4 * g;
        *(h16x4*)(mbuf + (size_t)tok * 1024 + col) = macc[mi][ni];
      }
  }
}

__device__ void phase_g4(const Params p, int layer, char* smem) {
  const int lane = otid() & 63, wid = otid() >> 6, wr = wid >> 1, wc = wid & 1, l15 = lane & 15, g = lane >> 4;
  const h16* Wo = p.wt_out + (size_t)layer * 1048576;
  const h16* mbuf = p.zbuf;
  int rt, ct;
  for (int ti = 0; xcd_tile(ti, 128, 8, rt, ct); ti++) {
    const int r0 = rt * 128, n0 = ct * 128;
    f32x4 acc[4][4];
    zero_acc(acc);
    gemm_acc<128, 128>(acc, mbuf + (size_t)r0 * 1024, 1024, Wo + (size_t)n0 * 1024, 1024, 1024, smem);
    f32x4 gv[4];
    {
      const float* gt = p.modv + (layer * 5 + cond_of(r0)) * 3072 + 2048;
#pragma unroll
      for (int ni = 0; ni < 4; ni++) gv[ni] = *(const f32x4*)(gt + n0 + wc * 64 + ni * 16 + 4 * g);
    }
    f32x4 xv[4][4];
#pragma unroll
    for (int mi = 0; mi < 4; mi++) {
      const float* xo = xptr(p, layer, r0 + wr * 64 + mi * 16 + l15);
#pragma unroll
      for (int ni = 0; ni < 4; ni++) xv[mi][ni] = __builtin_nontemporal_load((const f32x4*)(xo + n0 + wc * 64 + ni * 16 + 4 * g));
    }
#pragma unroll
    for (int mi = 0; mi < 4; mi++) {
      const int tok = r0 + wr * 64 + mi * 16 + l15;
#pragma unroll
      for (int ni = 0; ni < 4; ni++) {
        const int col = n0 + wc * 64 + ni * 16 + 4 * g;
        *(f32x4*)(p.out + (size_t)tok * 1024 + col) = xv[mi][ni] + gv[ni] * acc[mi][ni];
      }
    }
  }
}


#define XB_TMO      128
#define XB_XCNT(j)  (256  + 64 * (j))
#define XB_XSUB(j)  (1280 + 64 * (j))
#define XB_XGEN(j)  (2304 + 64 * (j))
#define XB_TOP      3328
#define XB_TOPGEN   3392
#define XCD_BAR_WORDS 3456
#define XB_SPIN_CAP (1u << 20)
__device__ __forceinline__ unsigned xb_ld(unsigned* p) { return __hip_atomic_load(p, __ATOMIC_RELAXED, __HIP_MEMORY_SCOPE_AGENT); }
__device__ __forceinline__ unsigned xb_add(unsigned* p, unsigned v) { return __hip_atomic_fetch_add(p, v, __ATOMIC_RELAXED, __HIP_MEMORY_SCOPE_AGENT); }
__device__ __forceinline__ unsigned xb_xcc_id() { return (unsigned)__builtin_amdgcn_s_getreg((3 << 11) | 20) & 0xFu; }
#define XB_SPIN(cond, bar) do { unsigned _sp = 0; while (cond) { __builtin_amdgcn_s_sleep(1); \
    if ((++_sp & 255u) == 0u) { if (xb_ld(&(bar)[XB_TMO])) break; if (_sp > XB_SPIN_CAP) { atomicAdd(&(bar)[XB_TMO], 1u); break; } } } } while (0)
struct XB { unsigned* bar; unsigned x, nloc, nx; };
__device__ __forceinline__ void xb_post(XB& b, unsigned* bar) {
  b.bar = bar; b.x = xb_xcc_id(); b.nloc = 0u; b.nx = 0u;
  if (otid() == 0) (void)xb_add(&bar[XB_XCNT(b.x)], 1u);
}
__device__ __forceinline__ void xb_complete(unsigned* bar, unsigned x, unsigned& nloc, unsigned& nx) {
  const unsigned G = gridDim.x;
  unsigned sum, cnt, mine, sp = 0u;
  for (;;) {
    sum = 0u; cnt = 0u; mine = 0u;
#pragma unroll
    for (unsigned j = 0; j < 16; ++j) { const unsigned c = xb_ld(&bar[XB_XCNT(j)]); sum += c; cnt += (c > 0u) ? 1u : 0u; mine = (j == x) ? c : mine; }
    if (sum == G) break;
    __builtin_amdgcn_s_sleep(1);
    if ((++sp & 255u) == 0u) { if (xb_ld(&bar[XB_TMO])) break; if (sp > XB_SPIN_CAP) { atomicAdd(&bar[XB_TMO], 1u); break; } }
  }
  nloc = mine > 0u ? mine : 1u; nx = cnt > 0u ? cnt : 1u;
}
__device__ __forceinline__ void xb_sync(XB& b) {
  asm volatile("s_waitcnt vmcnt(0)" ::: "memory");
  __syncthreads();
  if (otid() == 0) {
    unsigned* bar = b.bar;
    __builtin_amdgcn_s_waitcnt(0);
    if (b.nloc == 0u) xb_complete(bar, b.x, b.nloc, b.nx);
    const unsigned nloc = b.nloc, nx = b.nx;
    const unsigned old = xb_add(&bar[XB_XSUB(b.x)], 1u);
    const unsigned gen = old / nloc;
    if (old + 1u == (gen + 1u) * nloc) {
      __builtin_amdgcn_fence(__ATOMIC_RELEASE, "agent");
      asm volatile("s_waitcnt vmcnt(0)" ::: "memory");
      const unsigned og = xb_add(&bar[XB_TOP], 1u);
      const unsigned tg = og / nx;
      if (og + 1u == (tg + 1u) * nx) xb_add(&bar[XB_TOPGEN], 1u);
      else XB_SPIN(xb_ld(&bar[XB_TOPGEN]) == tg, bar);
      __builtin_amdgcn_fence(__ATOMIC_ACQUIRE, "agent");
      xb_add(&bar[XB_XGEN(b.x)], 1u);
      asm volatile("s_waitcnt vmcnt(0)" ::: "memory");
    } else {
      XB_SPIN(xb_ld(&bar[XB_XGEN(b.x)]) == gen, bar);
      __builtin_amdgcn_fence(__ATOMIC_ACQUIRE, "agent");
      asm volatile("s_waitcnt vmcnt(0)" ::: "memory");
    }
  }
  __syncthreads();
}

#define N_PHASES 16
template <int PH>
__device__ __forceinline__ void run_phase(const Params p, char* smem) {
  if constexpr (PH == 0) phase_prep(p, smem);
  else if constexpr (PH == 15) phase_final(p);
  else {
    constexpr int layer = (PH - 1) / 7, s = (PH - 1) % 7;
    if constexpr (s == 0) phase_norm(p, layer);
    else if constexpr (s == 1) phase_g1(p, layer, smem);
    else if constexpr (s == 2) phase_g2(p, layer, smem);
    else if constexpr (s == 3) phase_att(p, layer, smem);
    else if constexpr (s == 4) phase_glu(p, layer, smem);
    else if constexpr (s == 5) phase_g3(p, layer, smem);
    else phase_g4(p, layer, smem);
  }
}

template <int PH>
__global__ void __launch_bounds__(256, 2) phase_kernel(Params p) {
  __shared__ __attribute__((aligned(16))) char smem[65536];
  run_phase<PH>(p, smem);
}

#ifndef MULTI_LAUNCH
#ifndef PROBE_MASK
#define PROBE_MASK 0
#endif
#define PROBE_MULT 4
template <int PH>
__device__ __forceinline__ void run_from(const Params p, char* smem, XB& xb, unsigned long long tprev, unsigned long long& tacc) {
  run_phase<PH>(p, smem);
  if constexpr (PH + 1 < N_PHASES) {
    xb_sync(xb);
  }
  unsigned long long tnow = tprev;
  if constexpr (PROBE_MASK != 0) {
    tnow = wall_clock64();
    if constexpr ((PROBE_MASK >> PH) & 1) tacc += tnow - tprev;
  }
  if constexpr (PH + 1 < N_PHASES) run_from<PH + 1>(p, smem, xb, tnow, tacc);
}

__global__ void __launch_bounds__(256, 2) mega(Params p) {
  __shared__ __attribute__((aligned(16))) char smem[65536];
  XB xb;
  xb_post(xb, p.bar);
  unsigned long long tacc = 0;
  unsigned long long t0 = 0;
  if constexpr (PROBE_MASK != 0) t0 = wall_clock64();
  run_from<0>(p, smem, xb, t0, tacc);
  if constexpr (PROBE_MASK != 0) {
    if (blockIdx.x == 0 && otid() == 0) {
      const unsigned long long tend = wall_clock64();
      while (wall_clock64() - tend < tacc * PROBE_MULT) __builtin_amdgcn_s_sleep(8);
    }
  }
}
#endif

template <int PH>
static void launch_phases(const Params p, int grid, hipStream_t stream) {
  hipLaunchKernelGGL(phase_kernel<PH>, dim3(grid), dim3(256), 0, stream, p);
  if constexpr (PH + 1 < N_PHASES) launch_phases<PH + 1>(p, grid, stream);
}

static inline size_t al256(size_t x) { return (x + 255) & ~(size_t)255; }

extern "C" void kernel_launch(void* const* d_in, const int* in_sizes, int n_in, void* d_out, int out_size, void* d_ws,
                              size_t ws_size, hipStream_t stream) {
  Params p{};
  const float** ip = (const float**)&p;
  for (int i = 0; i < 35; i++) ip[i] = (const float*)d_in[i];
  p.out = (float*)d_out;
  char* w = (char*)d_ws;
  size_t off = 0;
  auto take = [&](size_t bytes) { char* r = w + off; off = al256(off + bytes); return r; };
  p.wt_in = (h16*)take((size_t)2 * 3072 * 1024 * 2);
  p.wt_merge = (h16*)take((size_t)2 * 4096 * 1024 * 2);
  p.wt_branch = (h16*)take((size_t)2 * 4 * 1024 * 256 * 2);
  p.wt_out = (h16*)take((size_t)2 * 1024 * 1024 * 2);
  p.wt_qup = (h16*)take((size_t)2 * 384 * 256 * 2);
  p.wt_kvup = (h16*)take((size_t)2 * 512 * 128 * 2);
  p.wt_kvraw = (h16*)take((size_t)2 * 512 * 128 * 2);
  p.wt_glu = (h16*)take((size_t)2 * 512 * 256 * 2);
  p.hbuf = (h16*)take((size_t)T_ALL * 1024 * 2);
  p.zbuf = (h16*)take((size_t)T_ALL * ZLD * 2);
  p.br = (h16*)take((size_t)T_ALL * 1024 * 2);
  p.qm = (h16*)take((size_t)T_ALL * 384 * 2);
  p.kmla = (h16*)take((size_t)T_ALL * 384 * 2);
  p.kcx = (h16*)take((size_t)2048 * 384 * 2);
  p.vt_a_ctx = (h16*)take((size_t)32 * 2 * 64 * 256 * 2);
  p.vt_a_lat = (h16*)take((size_t)4 * 2 * 64 * 2048 * 2);
  p.vt_d_ctx = (h16*)take((size_t)32 * 4 * 64 * 256 * 2);
  p.vt_d_lat = (h16*)take((size_t)4 * 4 * 64 * 2048 * 2);
  p.vt_m_ctx = (h16*)take((size_t)32 * 4 * 64 * 256 * 2);
  p.vt_m_lat = (h16*)take((size_t)4 * 4 * 64 * 2048 * 2);
  p.vcx_t = (h16*)take((size_t)4 * 4 * 64 * 512 * 2);
  p.ck_a = (h16*)take((size_t)524288 * 2);
  p.cvt_a = (h16*)take((size_t)524288 * 2);
  p.ck_n = (h16*)take((size_t)1048576 * 2);
  p.cvt_n = (h16*)take((size_t)1048576 * 2);
  p.ckv_c = (h16*)take((size_t)524288 * 2);
  p.s5_bmt = (h16*)take((size_t)64 * 128 * 16 * 2);
  p.s5_cmt = (h16*)take((size_t)64 * 16 * 128 * 2);
  p.s5_abar = (float*)take(4096 * 2 * 4);
  p.s5_lamdt = (float*)take(4096 * 2 * 4);
  p.s5_dt = (float*)take(64 * 4);
  p.s5_e = (float*)take((size_t)4 * 16 * 2 * 8 * 128 * 4);
  p.modv = (float*)take(2 * 5 * 3072 * 4);
  p.cs16 = (float*)take(64 * 16 * 2 * 4);
  p.cs8 = (float*)take(64 * 8 * 2 * 4);
  p.bar = (unsigned*)take(XCD_BAR_WORDS * 4);
  if (off > ws_size) { fprintf(stderr, "workspace too small: need %zu have %zu\n", off, ws_size); return; }

  static int grid_blocks = 0;
  if (!grid_blocks) {
    int dev = 0, cus = 0, per_cu = 0;
    (void)hipGetDevice(&dev);
    (void)hipDeviceGetAttribute(&cus, hipDeviceAttributeMultiprocessorCount, dev);
    #ifdef MULTI_LAUNCH
    (void)hipOccupancyMaxActiveBlocksPerMultiprocessor(&per_cu, phase_kernel<3>, 256, 0);
#else
    (void)hipOccupancyMaxActiveBlocksPerMultiprocessor(&per_cu, mega, 256, 0);
#endif
    if (per_cu > 2) per_cu = 2;
    if (per_cu < 1) per_cu = 1;
    grid_blocks = cus * per_cu;
  }
#ifdef MULTI_LAUNCH
  launch_phases<0>(p, grid_blocks, stream);
#else
  (void)hipMemsetAsync(p.bar, 0, XCD_BAR_WORDS * 4, stream);
  void* args[] = {&p};
  hipError_t e = hipLaunchCooperativeKernel((void*)mega, dim3(grid_blocks), dim3(256), args, 0, stream);
  if (e != hipSuccess) fprintf(stderr, "cooperative launch failed: %s (grid %d)\n", hipGetErrorString(e), grid_blocks);
#endif
}
```

```cpp
#include <hip/hip_runtime.h>
#include <hip/hip_cooperative_groups.h>
#include <cstdio>
#include <cstdint>
namespace cg = cooperative_groups;

typedef _Float16 h16;
typedef __attribute__((ext_vector_type(8))) _Float16 h16x8;
typedef __attribute__((ext_vector_type(4))) _Float16 h16x4;
typedef __attribute__((ext_vector_type(4))) float f32x4;
typedef __attribute__((ext_vector_type(4))) unsigned int u32x4;

#define T_ALL 16384
#define T_CTX 8192
#define ZLD 2976
#define LOG2E 1.4426950408889634f

#define O_AK   16777216
#define O_AV   18874368
#define O_CKV  20971520
#define O_KPE  23068672
#define O_NK   23592960
#define O_NV   27787264
#define O_SRE  31981568
#define O_SIM  32112640

struct Params {
  const float *x_prompt, *x_sample, *cache_a_k, *cache_a_v, *cache_mla_ckv, *cache_mla_kpe, *cache_na_k, *cache_na_v,
      *state_re, *state_im, *c, *c_ctx, *w_mod, *b_mod, *norm_g, *w_in, *w_merge, *a_sink, *mla_q_norm, *mla_w_q_up,
      *mla_kv_norm, *mla_w_kv_up, *s5_lam_re, *s5_lam_im, *s5_log_dt, *s5_b_re, *s5_b_im, *s5_c_re, *s5_c_im, *s5_d,
      *s5_w_glu, *na_rpb, *w_branch, *w_out, *final_norm_g;
  float* out;
  h16 *wt_in, *wt_merge, *wt_branch, *wt_out, *wt_qup, *wt_kvup, *wt_kvraw, *wt_glu;
  h16 *hbuf, *zbuf, *br, *qm, *kmla, *kcx, *vt_a_ctx, *vt_a_lat, *vt_d_ctx, *vt_d_lat, *vt_m_ctx, *vt_m_lat, *vcx_t,
      *ck_a, *cvt_a, *ck_n, *cvt_n, *ckv_c, *s5_bmt, *s5_cmt;
  float *s5_abar, *s5_lamdt, *s5_dt, *s5_e, *modv, *cs16, *cs8;
  unsigned* bar;
};


__device__ __forceinline__ int otid() { int t = __builtin_amdgcn_workitem_id_x(); asm volatile("" : "+v"(t)); return t; }
__device__ __forceinline__ float sigmoidf_(float x) { return 1.f / (1.f + __expf(-x)); }
__device__ __forceinline__ float siluf_(float x) { return x * sigmoidf_(x); }
__device__ __forceinline__ float geluf_(float x) {
  float u = 0.7978845608028654f * (x + 0.044715f * x * x * x);
  return x / (1.f + __expf(-2.f * u));
}
__device__ __forceinline__ float wave_sum(float v) {
#pragma unroll
  for (int o = 32; o > 0; o >>= 1) v += __shfl_xor(v, o);
  return v;
}
__device__ __forceinline__ const float* xptr(const Params p, int layer, int tok) {
  if (layer == 0) return tok < T_CTX ? p.x_prompt + (size_t)tok * 1024 : p.x_sample + (size_t)(tok - T_CTX) * 1024;
  return p.out + (size_t)tok * 1024;
}
__device__ __forceinline__ int cond_of(int tok) { return tok < T_CTX ? 0 : 1 + ((tok - T_CTX) >> 11); }

#define SWZ(row, slot) (((row) << 7) + ((((slot) ^ (((row) >> 1) & 7))) << 4))

template <int BM, int BN, bool LOWREG = false>
__device__ __forceinline__ void gemm_acc(f32x4 (&acc)[BM / 32][BN / 32], const h16* __restrict__ A, int lda,
                                         const h16* __restrict__ Bt, int ldb, int K, char* smem) {
  constexpr int MREP = BM / 32, NREP = BN / 32;
  constexpr int ACH = BM * 8 / 256, BCH = BN * 8 / 256;
  constexpr int ABYTES = BM * 128, STAGE = (BM + BN) * 128;
  const int tid = otid(), lane = tid & 63, wid = tid >> 6;
  const int wr = wid >> 1, wc = wid & 1;
  const int l15 = lane & 15, g = lane >> 4;
  const int nk = K >> 6;
  const int ls = (tid & 7) ^ ((tid >> 4) & 7);
  const h16* Ap = A + (size_t)(tid >> 3) * lda + ls * 8;
  const h16* Bp = Bt + (size_t)(tid >> 3) * ldb + ls * 8;
  char* dstA = smem + tid * 16;
  char* dstB = smem + ABYTES + tid * 16;
#pragma unroll
  for (int i = 0; i < ACH; i++)
    __builtin_amdgcn_global_load_lds((const unsigned*)(Ap + (size_t)(i * 32) * lda), (__attribute__((address_space(3))) unsigned*)(dstA + i * 4096), 16, 0, 0);
#pragma unroll
  for (int i = 0; i < BCH; i++)
    __builtin_amdgcn_global_load_lds((const unsigned*)(Bp + (size_t)(i * 32) * ldb), (__attribute__((address_space(3))) unsigned*)(dstB + i * 4096), 16, 0, 0);
  for (int kt = 0; kt < nk; kt++) {
    asm volatile("s_waitcnt vmcnt(0)" ::: "memory");
    __syncthreads();
    if (kt + 1 < nk) {
      const int nb = ((kt + 1) & 1) * STAGE;
#pragma unroll
      for (int i = 0; i < ACH; i++)
        __builtin_amdgcn_global_load_lds((const unsigned*)(Ap + (size_t)(i * 32) * lda + (kt + 1) * 64), (__attribute__((address_space(3))) unsigned*)(dstA + nb + i * 4096), 16, 0, 0);
#pragma unroll
      for (int i = 0; i < BCH; i++)
        __builtin_amdgcn_global_load_lds((const unsigned*)(Bp + (size_t)(i * 32) * ldb + (kt + 1) * 64), (__attribute__((address_space(3))) unsigned*)(dstB + nb + i * 4096), 16, 0, 0);
    }
    const char* sa = smem + (kt & 1) * STAGE;
    const char* sb = sa + ABYTES;
    if (!LOWREG) {
      h16x8 af[2][MREP], bf[2][NREP];
#pragma unroll
      for (int ks = 0; ks < 2; ks++) {
#pragma unroll
        for (int mi = 0; mi < MREP; mi++) af[ks][mi] = *(const h16x8*)(sa + SWZ(wr * (BM / 2) + mi * 16 + l15, ks * 4 + g));
#pragma unroll
        for (int ni = 0; ni < NREP; ni++) bf[ks][ni] = *(const h16x8*)(sb + SWZ(wc * (BN / 2) + ni * 16 + l15, ks * 4 + g));
      }
      __builtin_amdgcn_sched_barrier(0);
#pragma unroll
      for (int ks = 0; ks < 2; ks++)
#pragma unroll
        for (int mi = 0; mi < MREP; mi++)
#pragma unroll
          for (int ni = 0; ni < NREP; ni++)
            acc[mi][ni] = __builtin_amdgcn_mfma_f32_16x16x32_f16(bf[ks][ni], af[ks][mi], acc[mi][ni], 0, 0, 0);
      __builtin_amdgcn_sched_barrier(0);
    } else {
#pragma unroll
      for (int ks = 0; ks < 2; ks++) {
        h16x8 af[MREP], bf[NREP];
#pragma unroll
        for (int mi = 0; mi < MREP; mi++) af[mi] = *(const h16x8*)(sa + SWZ(wr * (BM / 2) + mi * 16 + l15, ks * 4 + g));
#pragma unroll
        for (int ni = 0; ni < NREP; ni++) bf[ni] = *(const h16x8*)(sb + SWZ(wc * (BN / 2) + ni * 16 + l15, ks * 4 + g));
        __builtin_amdgcn_sched_barrier(0);
#pragma unroll
        for (int mi = 0; mi < MREP; mi++)
#pragma unroll
          for (int ni = 0; ni < NREP; ni++)
            acc[mi][ni] = __builtin_amdgcn_mfma_f32_16x16x32_f16(bf[ni], af[mi], acc[mi][ni], 0, 0, 0);
        __builtin_amdgcn_sched_barrier(0);
      }
    }
  }
  __syncthreads();
}

__device__ __forceinline__ bool xcd_tile(int i, int RT, int CT, int& rt, int& ct) {
  const int nbx = gridDim.x >> 3, x = blockIdx.x & 7, j = blockIdx.x >> 3;
  const int RTL = RT >> 3;
  const int L = i * nbx + j;
  if (L >= RTL * CT) return false;
  if ((CT & 7) == 0 && (RTL & 7) == 0) {
    const int gi = L >> 6, w = L & 63, nrg = RTL >> 3;
    rt = x * RTL + (gi % nrg) * 8 + (w >> 3);
    ct = (gi / nrg) * 8 + (w & 7);
  } else {
    rt = x * RTL + L / CT;
    ct = L % CT;
  }
  return true;
}

template <int M, int N>
__device__ __forceinline__ void zero_acc(f32x4 (&a)[M][N]) {
#pragma unroll
  for (int i = 0; i < M; i++)
#pragma unroll
    for (int j = 0; j < N; j++) a[i][j] = f32x4{0.f, 0.f, 0.f, 0.f};
}

__device__ __forceinline__ void store_h4(h16* dst, float a, float b, float c, float d) {
  h16x4 v = {(h16)a, (h16)b, (h16)c, (h16)d};
  *(h16x4*)dst = v;
}

__device__ void tr_tile(const float* __restrict__ src, int lds_, h16* __restrict__ dst, int ldd, int k0, int n0, int N,
                        char* smem) {
  float* tile = (float*)smem;
  const int tid = otid();
  const int r = tid >> 4, c4 = tid & 15;
#pragma unroll
  for (int rr = 0; rr < 4; rr++) {
    int kl = r + rr * 16;
    int n = n0 + c4 * 4;
    float4 v = make_float4(0.f, 0.f, 0.f, 0.f);
    if (n < N) v = *(const float4*)(src + (size_t)(k0 + kl) * lds_ + n);
    tile[kl * 65 + c4 * 4 + 0] = v.x;
    tile[kl * 65 + c4 * 4 + 1] = v.y;
    tile[kl * 65 + c4 * 4 + 2] = v.z;
    tile[kl * 65 + c4 * 4 + 3] = v.w;
  }
  __syncthreads();
  const int nl = tid >> 2, kq = tid & 3;
  h16x8 o0, o1;
#pragma unroll
  for (int i = 0; i < 8; i++) {
    o0[i] = (h16)tile[(kq * 16 + i) * 65 + nl];
    o1[i] = (h16)tile[(kq * 16 + 8 + i) * 65 + nl];
  }
  h16* d = dst + (size_t)(n0 + nl) * ldd + k0 + kq * 16;
  *(h16x8*)d = o0;
  *(h16x8*)(d + 8) = o1;
  __syncthreads();
}

__device__ void phase_prep(const Params p, char* smem) {
  const int tid = otid();
  const size_t gtid = (size_t)blockIdx.x * 256 + tid, gsz = (size_t)gridDim.x * 256;
  for (size_t i = gtid; i < 2 * 384 * 256; i += gsz) {
    int l = i / (384 * 256), r = i % (384 * 256), n = r / 256, k = r % 256;
    p.wt_qup[i] = (h16)(p.mla_q_norm[l * 256 + k] * p.mla_w_q_up[(size_t)l * 256 * 384 + k * 384 + n]);
  }
  for (size_t i = gtid; i < 2 * 512 * 128; i += gsz) {
    int l = i / (512 * 128), r = i % (512 * 128), n = r / 128, k = r % 128;
    float w = p.mla_w_kv_up[(size_t)l * 128 * 512 + k * 512 + n];
    p.wt_kvraw[i] = (h16)w;
    p.wt_kvup[i] = (h16)(w * p.mla_kv_norm[l * 128 + k]);
  }
  for (size_t i = gtid; i < 2 * 512 * 256; i += gsz) {
    int l = i / (512 * 256), r = i % (512 * 256), n = r / 256, k = r % 256;
    int q = n >> 5, w = n & 31;
    int orig = (w < 16) ? (q * 16 + w) : (256 + q * 16 + (w - 16));
    p.wt_glu[i] = (h16)p.s5_w_glu[(size_t)l * 256 * 512 + k * 512 + orig];
  }
  for (size_t i = gtid; i < 262144; i += gsz) {
    const float* src; h16* dst; size_t e;
    if (i < 65536) { src = p.cache_a_k; dst = p.ck_a; e = i * 8; }
    else if (i < 131072) { src = p.cache_mla_ckv; dst = p.ckv_c; e = (i - 65536) * 8; }
    else { src = p.cache_na_k; dst = p.ck_n; e = (i - 131072) * 8; }
    const f32x4 a = __builtin_nontemporal_load((const f32x4*)(src + e)), b = __builtin_nontemporal_load((const f32x4*)(src + e + 4));
    h16x8 o = {(h16)a[0], (h16)a[1], (h16)a[2], (h16)a[3], (h16)b[0], (h16)b[1], (h16)b[2], (h16)b[3]};
    *(h16x8*)(dst + e) = o;
  }
  for (size_t ii = gtid; ii < 65536; ii += gsz) {
    const int i = ii >> 4, c = ii & 15;
    int ldg = i >> 6;
    float lr = fminf(p.s5_lam_re[i], -1e-4f), li = p.s5_lam_im[i];
    float dt = __expf(p.s5_log_dt[ldg]);
    float er = expf(lr * dt), sn, cs;
    sincosf(li * dt, &sn, &cs);
    float ar = er * cs, ai = er * sn;
    if (c == 0) {
      p.s5_abar[i * 2] = ar;
      p.s5_abar[i * 2 + 1] = ai;
      p.s5_lamdt[i * 2] = lr * dt;
      p.s5_lamdt[i * 2 + 1] = li * dt;
      if ((i & 63) == 0) p.s5_dt[ldg] = dt;
    }
    float nr = ar - 1.f, ni = ai, den = lr * lr + li * li;
    float cr = (nr * lr + ni * li) / den / dt, ci = (ni * lr - nr * li) / den / dt;
    int pp = i & 63;
    {
      float br_ = p.s5_b_re[(size_t)i * 16 + c], bi_ = p.s5_b_im[(size_t)i * 16 + c];
      p.s5_bmt[((size_t)ldg * 128 + pp) * 16 + c] = (h16)(cr * br_ - ci * bi_);
      p.s5_bmt[((size_t)ldg * 128 + 64 + pp) * 16 + c] = (h16)(cr * bi_ + ci * br_);
      p.s5_cmt[((size_t)ldg * 16 + c) * 128 + pp] = (h16)p.s5_c_re[((size_t)ldg * 16 + c) * 64 + pp];
      p.s5_cmt[((size_t)ldg * 16 + c) * 128 + 64 + pp] = (h16)(-p.s5_c_im[((size_t)ldg * 16 + c) * 64 + pp]);
    }
  }
  for (size_t i = gtid; i < 64 * 16; i += gsz) {
    int pos = i >> 4, k = i & 15;
    float inv = powf(10000.f, -(float)k / 16.f), sn, cs;
    sincosf((float)pos * inv, &sn, &cs);
    p.cs16[i * 2] = cs;
    p.cs16[i * 2 + 1] = sn;
  }
  for (size_t i = gtid; i < 64 * 8; i += gsz) {
    int pos = i >> 3, k = i & 7;
    float inv = powf(10000.f, -(float)k / 8.f), sn, cs;
    sincosf((float)pos * inv, &sn, &cs);
    p.cs8[i * 2] = cs;
    p.cs8[i * 2 + 1] = sn;
  }
  for (int it = blockIdx.x; it < 384; it += gridDim.x) {
    float* sc = (float*)smem;
    float* red = sc + 5 * 1024;
    const int layer = it / 192, col0 = (it % 192) * 16;
    for (int i = tid; i < 5120; i += 256) {
      int c = i >> 10, k = i & 1023;
      float v = (c == 0) ? p.c_ctx[k] : p.c[(c - 1) * 1024 + k];
      sc[i] = siluf_(v);
    }
    __syncthreads();
    const int cl = tid & 15, kg = tid >> 4;
    float a0 = 0, a1 = 0, a2 = 0, a3 = 0, a4 = 0;
    const float* w = p.w_mod + (size_t)layer * 1024 * 3072 + col0 + cl;
#pragma unroll 16
    for (int kk = 0; kk < 64; kk++) {
      int k = kg * 64 + kk;
      float wv = __builtin_nontemporal_load(w + (size_t)k * 3072);
      a0 += sc[k] * wv;
      a1 += sc[1024 + k] * wv;
      a2 += sc[2048 + k] * wv;
      a3 += sc[3072 + k] * wv;
      a4 += sc[4096 + k] * wv;
    }
    red[(kg * 5 + 0) * 16 + cl] = a0;
    red[(kg * 5 + 1) * 16 + cl] = a1;
    red[(kg * 5 + 2) * 16 + cl] = a2;
    red[(kg * 5 + 3) * 16 + cl] = a3;
    red[(kg * 5 + 4) * 16 + cl] = a4;
    __syncthreads();
    if (tid < 80) {
      int c = tid >> 4, cc = tid & 15;
      float s = 0;
      for (int q = 0; q < 16; q++) s += red[(q * 5 + c) * 16 + cc];
      p.modv[(layer * 5 + c) * 3072 + col0 + cc] = s + p.b_mod[layer * 3072 + col0 + cc];
    }
    __syncthreads();
  }
  {
    float* tl = (float*)smem;
    const int r = tid >> 4, c4 = tid & 15, nl = tid >> 2, kq = tid & 3;
    const float* src = nullptr; h16* dst = nullptr; int lds_ = 0, ldd = 0, N = 0, k0 = 0, n0 = 0;
    f32x4 v[4];
#define TR_DECODE(it_)                                                                                                  \
    {                                                                                                                   \
      int NT_, tile_;                                                                                                   \
      if ((it_) < 4608) {                                                                                               \
        const int l = (it_) / 2304, rr_ = (it_) % 2304;                                                                 \
        if (rr_ < 768) { src = p.w_in + (size_t)l * 1024 * 2976; lds_ = 2976; dst = p.wt_in + (size_t)l * 3072 * 1024; ldd = 1024; N = 2976; NT_ = 48; tile_ = rr_; } \
        else if (rr_ < 1792) { src = p.w_merge + (size_t)l * 1024 * 4096; lds_ = 4096; dst = p.wt_merge + (size_t)l * 4096 * 1024; ldd = 1024; N = 4096; NT_ = 64; tile_ = rr_ - 768; } \
        else if (rr_ < 2048) { const int k = (rr_ - 1792) >> 6; src = p.w_branch + (size_t)(l * 4 + k) * 256 * 1024; lds_ = 1024; dst = p.wt_branch + (size_t)(l * 4 + k) * 1024 * 256; ldd = 256; N = 1024; NT_ = 16; tile_ = (rr_ - 1792) & 63; } \
        else { src = p.w_out + (size_t)l * 1048576; lds_ = 1024; dst = p.wt_out + (size_t)l * 1048576; ldd = 1024; N = 1024; NT_ = 16; tile_ = rr_ - 2048; } \
      } else {                                                                                                          \
        int rr_ = (it_) - 4608;                                                                                         \
        if (rr_ < 128) { const int m = rr_ >> 4; src = p.cache_a_v + (size_t)m * 512 * 128; lds_ = 128; dst = p.cvt_a + (size_t)m * 128 * 512; ldd = 512; N = 128; NT_ = 2; tile_ = rr_ & 15; } \
        else { rr_ -= 128; const int m = rr_ >> 5; src = p.cache_na_v + (size_t)m * 512 * 256; lds_ = 256; dst = p.cvt_n + (size_t)m * 256 * 512; ldd = 512; N = 256; NT_ = 4; tile_ = rr_ & 31; } \
      }                                                                                                                 \
      k0 = (tile_ / NT_) * 64; n0 = (tile_ % NT_) * 64;                                                                 \
      _Pragma("unroll") for (int q = 0; q < 4; q++) {                                                                   \
        v[q] = f32x4{0.f, 0.f, 0.f, 0.f};                                                                               \
        if (n0 + c4 * 4 < N) v[q] = __builtin_nontemporal_load((const f32x4*)(src + (size_t)(k0 + r + q * 16) * lds_ + n0 + c4 * 4));              \
      }                                                                                                                 \
    }
    int it = blockIdx.x, tstride = gridDim.x, tend = 4992;
    if (gridDim.x == 512) {
      if (blockIdx.x < 384) { tstride = 384; tend = 3072; }
      else { it = 3072 + (blockIdx.x - 384); tstride = 128; }
    }
    if (it < tend) TR_DECODE(it)
    while (it < tend) {
#pragma unroll
      for (int q = 0; q < 4; q++) {
        const int kl = r + q * 16;
        tl[kl * 65 + c4 * 4 + 0] = v[q][0];
        tl[kl * 65 + c4 * 4 + 1] = v[q][1];
        tl[kl * 65 + c4 * 4 + 2] = v[q][2];
        tl[kl * 65 + c4 * 4 + 3] = v[q][3];
      }
      h16* d = dst + (size_t)(n0 + nl) * ldd + k0 + kq * 16;
      it += tstride;
      if (it < tend) TR_DECODE(it)
      __syncthreads();
      h16x8 o0, o1;
#pragma unroll
      for (int i = 0; i < 8; i++) {
        o0[i] = (h16)tl[(kq * 16 + i) * 65 + nl];
        o1[i] = (h16)tl[(kq * 16 + 8 + i) * 65 + nl];
      }
      *(h16x8*)d = o0;
      *(h16x8*)(d + 8) = o1;
      __syncthreads();
    }
  }
}

__device__ void phase_norm(const Params p, int layer) {
  const int lane = otid() & 63, wid = otid() >> 6;
  const float* g = p.norm_g + layer * 1024;
  const int stride = gridDim.x * 4;
  for (int row0 = blockIdx.x * 4 + wid; row0 < T_ALL; row0 += 2 * stride) {
    const int row1 = row0 + stride;
    const bool has1 = row1 < T_ALL;
    const int r1 = has1 ? row1 : row0;
    const float* x0 = xptr(p, layer, row0);
    const float* x1 = xptr(p, layer, r1);
    f32x4 v0[4], v1[4];
    float s0 = 0.f, s1 = 0.f;
#pragma unroll
    for (int i = 0; i < 4; i++) {
      v0[i] = __builtin_nontemporal_load((const f32x4*)(x0 + i * 256 + lane * 4));
      v1[i] = __builtin_nontemporal_load((const f32x4*)(x1 + i * 256 + lane * 4));
    }
#pragma unroll
    for (int i = 0; i < 4; i++) {
      s0 += v0[i][0] * v0[i][0] + v0[i][1] * v0[i][1] + v0[i][2] * v0[i][2] + v0[i][3] * v0[i][3];
      s1 += v1[i][0] * v1[i][0] + v1[i][1] * v1[i][1] + v1[i][2] * v1[i][2] + v1[i][3] * v1[i][3];
    }
    s0 = wave_sum(s0);
    s1 = wave_sum(s1);
    const float rs0 = rsqrtf(s0 * (1.f / 1024.f) + 1e-6f), rs1 = rsqrtf(s1 * (1.f / 1024.f) + 1e-6f);
    const float* m0 = p.modv + (layer * 5 + cond_of(row0)) * 3072;
    const float* m1 = p.modv + (layer * 5 + cond_of(r1)) * 3072;
    f32x4 ggv[4], sh0v[4], sc0v[4], sh1v[4], sc1v[4];
#pragma unroll
    for (int i = 0; i < 4; i++) {
      const int k = i * 256 + lane * 4;
      ggv[i] = *(const f32x4*)(g + k);
      sh0v[i] = *(const f32x4*)(m0 + k); sc0v[i] = *(const f32x4*)(m0 + 1024 + k);
      sh1v[i] = *(const f32x4*)(m1 + k); sc1v[i] = *(const f32x4*)(m1 + 1024 + k);
    }
#pragma unroll
    for (int i = 0; i < 4; i++) {
      const int k = i * 256 + lane * 4;
      const f32x4 gg = ggv[i], sh0 = sh0v[i], sc0 = sc0v[i], sh1 = sh1v[i], sc1 = sc1v[i];
      const f32x4 o0 = v0[i] * rs0 * gg * (sc0 + 1.f) + sh0;
      const f32x4 o1 = v1[i] * rs1 * gg * (sc1 + 1.f) + sh1;
      store_h4(p.hbuf + (size_t)row0 * 1024 + k, o0[0], o0[1], o0[2], o0[3]);
      if (has1) store_h4(p.hbuf + (size_t)row1 * 1024 + k, o1[0], o1[1], o1[2], o1[3]);
    }
  }
}

__device__ void phase_final(const Params p) {
  const int lane = otid() & 63, wid = otid() >> 6;
  const float* g = p.final_norm_g;
  const int stride = gridDim.x * 4;
  for (int row0 = blockIdx.x * 4 + wid; row0 < T_ALL; row0 += 2 * stride) {
    const int row1 = row0 + stride;
    const bool has1 = row1 < T_ALL;
    float* x0 = p.out + (size_t)row0 * 1024;
    float* x1 = p.out + (size_t)(has1 ? row1 : row0) * 1024;
    f32x4 v0[4], v1[4];
    float s0 = 0.f, s1 = 0.f;
#pragma unroll
    for (int i = 0; i < 4; i++) {
      v0[i] = __builtin_nontemporal_load((const f32x4*)(x0 + i * 256 + lane * 4));
      v1[i] = __builtin_nontemporal_load((const f32x4*)(x1 + i * 256 + lane * 4));
    }
#pragma unroll
    for (int i = 0; i < 4; i++) {
      s0 += v0[i][0] * v0[i][0] + v0[i][1] * v0[i][1] + v0[i][2] * v0[i][2] + v0[i][3] * v0[i][3];
      s1 += v1[i][0] * v1[i][0] + v1[i][1] * v1[i][1] + v1[i][2] * v1[i][2] + v1[i][3] * v1[i][3];
    }
    s0 = wave_sum(s0);
    s1 = wave_sum(s1);
    const float rs0 = rsqrtf(s0 * (1.f / 1024.f) + 1e-6f), rs1 = rsqrtf(s1 * (1.f / 1024.f) + 1e-6f);
    f32x4 ggv[4];
#pragma unroll
    for (int i = 0; i < 4; i++) ggv[i] = *(const f32x4*)(g + i * 256 + lane * 4);
#pragma unroll
    for (int i = 0; i < 4; i++) {
      const int k = i * 256 + lane * 4;
      const f32x4 gg = ggv[i];
      __builtin_nontemporal_store(v0[i] * rs0 * gg, (f32x4*)(x0 + k));
      if (has1) __builtin_nontemporal_store(v1[i] * rs1 * gg, (f32x4*)(x1 + k));
    }
  }
}

__device__ void phase_g1(const Params p, int layer, char* smem) {
  const int lane = otid() & 63, wid = otid() >> 6, wr = wid >> 1, wc = wid & 1, l15 = lane & 15, g = lane >> 4;
  const h16* Wt = p.wt_in + (size_t)layer * 3072 * 1024;
  for (int tile = blockIdx.x; tile < 128 * 24; tile += gridDim.x) {
    const int rt = tile / 24, ct = tile % 24;
    const int r0 = rt * 128, n0 = ct * 128;
    f32x4 acc[4][4];
    zero_acc(acc);
    gemm_acc<128, 128>(acc, p.hbuf + (size_t)r0 * 1024, 1024, Wt + (size_t)n0 * 1024, 1024, 1024, smem);
    const bool ctx = r0 < T_CTX;
#pragma unroll
    for (int ni = 0; ni < 4; ni++) {
      const int col = n0 + wc * 64 + ni * 16 + 4 * g;
      if (col >= ZLD) continue;
      const int fb = n0 + wc * 64 + ni * 16;
#pragma unroll
      for (int mi = 0; mi < 4; mi++) {
        const int tok = r0 + wr * 64 + mi * 16 + l15;
        f32x4 v = acc[mi][ni];
        store_h4(p.zbuf + (size_t)tok * ZLD + col, v[0], v[1], v[2], v[3]);
        int b, l, Ls;
        if (ctx) { b = tok >> 8; l = tok & 255; Ls = 256; } else { b = (tok - T_CTX) >> 11; l = (tok - T_CTX) & 2047; Ls = 2048; }
        if (fb >= 384 && fb < 512) {
          h16* vt = p.vt_a_ctx + (ctx ? 0 : 1048576);
          int cc = col - 384;
#pragma unroll
          for (int j = 0; j < 4; j++) vt[((size_t)(b * 2 + ((cc + j) >> 6)) * 64 + ((cc + j) & 63)) * Ls + l] = (h16)v[j];
        } else if (fb >= 2464 && fb < 2720) {
          h16* vt = p.vt_d_ctx + (ctx ? 0 : 2097152);
          int cc = col - 2464;
#pragma unroll
          for (int j = 0; j < 4; j++) vt[((size_t)(b * 4 + ((cc + j) >> 6)) * 64 + ((cc + j) & 63)) * Ls + l] = (h16)v[j];
        }
        if (ctx) {
          const size_t rowi = (size_t)(b * 2 + layer) * 256 + l;
          const f32x4 fv = v;
          if (fb >= 256 && fb < 384) __builtin_nontemporal_store(fv, (f32x4*)(p.out + O_AK + rowi * 128 + (col - 256)));
          else if (fb >= 384 && fb < 512) __builtin_nontemporal_store(fv, (f32x4*)(p.out + O_AV + rowi * 128 + (col - 384)));
          else if (fb >= 1152 && fb < 1184) __builtin_nontemporal_store(fv, (f32x4*)(p.out + O_KPE + rowi * 32 + (col - 1152)));
          else if (fb >= 2208 && fb < 2464) __builtin_nontemporal_store(fv, (f32x4*)(p.out + O_NK + rowi * 256 + (col - 2208)));
          else if (fb >= 2464 && fb < 2720) __builtin_nontemporal_store(fv, (f32x4*)(p.out + O_NV + rowi * 256 + (col - 2464)));
        }
      }
    }
  }
}

#define BUS 136
__device__ void s5_item(const Params p, int layer, int mode0, int b0, int g0, int chunk0, int mode1, int b1, int g1, int chunk1, char* smem) {
  const int tid = otid(), lane = tid & 63, wid = tid >> 6, l15 = lane & 15, gq = lane >> 4;
  const int pr = wid >> 1, ptid = tid & 127;
  const int mode = pr ? mode1 : mode0, b = pr ? b1 : b0, g = pr ? g1 : g0, chunk = pr ? chunk1 : chunk0;
  char* pbase = smem + pr * 33280;
  h16* su = (h16*)pbase;
  h16* sbu = su + 256 * 16;
  h16* sy = sbu + 2 * 16 * BUS;
  const int tok0 = (mode == 0) ? b * 256 : T_CTX + b * 2048 + chunk * 256;
  if (mode >= 0) {
    for (int i = ptid; i < 512; i += 128) {
      int t = i >> 1, hf = i & 1;
      *(u32x4*)(su + t * 16 + hf * 8) = *(const u32x4*)(p.zbuf + (size_t)(tok0 + t) * ZLD + 1440 + g * 16 + hf * 8);
    }
  }
  __syncthreads();
  if (mode >= 0) {
    const int dir = wid & 1;
    const int ldg = (layer * 2 + dir) * 16 + g;
    const float ar = p.s5_abar[(ldg * 64 + lane) * 2], ai = p.s5_abar[(ldg * 64 + lane) * 2 + 1];
    const float dt = p.s5_dt[ldg];
    float hr = 0.f, hi = 0.f;
    if (mode == 2) {
      const size_t sidx = ((((size_t)b * 2 + layer) * 2 + dir) * 16 + g) * 64 + lane;
      hr = p.state_re[sidx];
      hi = p.state_im[sidx];
      float lr = p.s5_lamdt[(ldg * 64 + lane) * 2] * 256.f, li = p.s5_lamdt[(ldg * 64 + lane) * 2 + 1] * 256.f;
      float er = expf(lr), sn, cs;
      sincosf(li, &sn, &cs);
      const float pr = er * cs, pi = er * sn;
      const float* e = p.s5_e + ((((size_t)b * 16 + g) * 2 + dir) * 8) * 128;
      float ev_r[8], ev_i[8];
#pragma unroll
      for (int c2 = 0; c2 < 8; c2++) { ev_r[c2] = e[c2 * 128 + lane * 2]; ev_i[c2] = e[c2 * 128 + lane * 2 + 1]; }
      if (dir == 0) {
#pragma unroll
        for (int c2 = 0; c2 < 8; c2++)
          if (c2 < chunk) { const float nr = pr * hr - pi * hi + ev_r[c2], ni = pr * hi + pi * hr + ev_i[c2]; hr = nr; hi = ni; }
      } else {
#pragma unroll
        for (int c2 = 7; c2 >= 0; c2--)
          if (c2 > chunk) { const float nr = pr * hr - pi * hi + ev_r[c2], ni = pr * hi + pi * hr + ev_i[c2]; hr = nr; hi = ni; }
      }
    }
    h16x4 bfr[8];
    const h16* bmt = p.s5_bmt + (size_t)ldg * 128 * 16;
#pragma unroll
    for (int nf = 0; nf < 8; nf++) bfr[nf] = *(const h16x4*)(bmt + (nf * 16 + l15) * 16 + 4 * gq);
    h16x8 cfr[4];
    const h16* cmt = p.s5_cmt + (size_t)ldg * 16 * 128;
#pragma unroll
    for (int ks = 0; ks < 4; ks++) cfr[ks] = *(const h16x8*)(cmt + l15 * 128 + ks * 32 + 8 * gq);
    h16* bu = sbu + dir * 16 * BUS;
    h16* ydir = sy + dir * 256 * 16;
    for (int sub = 0; sub < 16; sub++) {
      const int sc = dir == 0 ? sub : 15 - sub;
      const int tt0 = sc * 16;
      h16x4 ua = *(const h16x4*)(su + (tt0 + l15) * 16 + 4 * gq);
#pragma unroll
      for (int nf = 0; nf < 8; nf++) {
        f32x4 r = __builtin_amdgcn_mfma_f32_16x16x16f16(bfr[nf], ua, f32x4{0.f, 0.f, 0.f, 0.f}, 0, 0, 0);
        store_h4(bu + l15 * BUS + nf * 16 + 4 * gq, r[0], r[1], r[2], r[3]);
      }
      __builtin_amdgcn_wave_barrier();
      {
        float vr[16], vi[16];
#pragma unroll
        for (int s = 0; s < 16; s++) { vr[s] = (float)bu[s * BUS + lane]; vi[s] = (float)bu[s * BUS + 64 + lane]; }
        if (dir == 0) {
#pragma unroll
          for (int s = 0; s < 16; s++) {
            const float nr = ar * hr - ai * hi + dt * vr[s], ni = ar * hi + ai * hr + dt * vi[s];
            hr = nr; hi = ni; vr[s] = nr; vi[s] = ni;
          }
        } else {
#pragma unroll
          for (int s = 15; s >= 0; s--) {
            const float nr = ar * hr - ai * hi + dt * vr[s], ni = ar * hi + ai * hr + dt * vi[s];
            hr = nr; hi = ni; vr[s] = nr; vi[s] = ni;
          }
        }
#pragma unroll
        for (int s = 0; s < 16; s++) { bu[s * BUS + lane] = (h16)vr[s]; bu[s * BUS + 64 + lane] = (h16)vi[s]; }
      }
      __builtin_amdgcn_wave_barrier();
      if (mode != 1) {
        f32x4 y = {0.f, 0.f, 0.f, 0.f};
#pragma unroll
        for (int ks = 0; ks < 4; ks++) {
          h16x8 ha = *(const h16x8*)(bu + l15 * BUS + ks * 32 + 8 * gq);
          y = __builtin_amdgcn_mfma_f32_16x16x32_f16(cfr[ks], ha, y, 0, 0, 0);
        }
        store_h4(ydir + (tt0 + l15) * 16 + 4 * gq, y[0], y[1], y[2], y[3]);
      }
      __builtin_amdgcn_wave_barrier();
    }
    if (mode == 0) {
      const size_t oi = ((((size_t)b * 2 + layer) * 2 + dir) * 16 + g) * 64 + lane;
      p.out[O_SRE + oi] = hr;
      p.out[O_SIM + oi] = hi;
    } else if (mode == 1) {
      float* e = p.s5_e + (((((size_t)b * 16 + g) * 2 + dir) * 8) + chunk) * 128;
      e[lane * 2] = hr;
      e[lane * 2 + 1] = hi;
    }
  }
  __syncthreads();
  if (mode == 0 || mode == 2) {
    const float dsk = p.s5_d[layer * 256 + g * 16 + (ptid & 15)];
    for (int i = ptid; i < 256 * 16; i += 128) {
      int t = i >> 4, c = i & 15;
      float u = (float)su[i];
      float v = (float)sy[i] + (float)sy[256 * 16 + i] + dsk * u;
      p.zbuf[(size_t)(tok0 + t) * ZLD + 1440 + g * 16 + c] = (h16)geluf_(v);
    }
  }
  __syncthreads();
}


template <int NCOL>
__device__ __forceinline__ void row_rstd(const h16* __restrict__ base, float* rs) {
  const int tid = otid(), row = tid >> 1, hf = tid & 1;
  const h16* ptr = base + (size_t)row * ZLD + hf * (NCOL / 2);
  float s = 0.f;
#pragma unroll
  for (int i = 0; i < NCOL / 16; i++) {
    h16x8 v = *(const h16x8*)(ptr + i * 8);
#pragma unroll
    for (int j = 0; j < 8; j++) s += (float)v[j] * (float)v[j];
  }
  s += __shfl_xor(s, 1);
  if (hf == 0) rs[row] = rsqrtf(s * (1.f / NCOL) + 1e-6f);
}

__device__ void phase_g2(const Params p, int layer, char* smem) {
  const int tid = otid(), lane = tid & 63, wid = tid >> 6, wr = wid >> 1, wc = wid & 1, l15 = lane & 15, g = lane >> 4;
  for (int it = blockIdx.x; it < 512; it += gridDim.x)
    s5_item(p, layer, 0, it >> 4, it & 15, 0, 1, it >> 7, (it >> 3) & 15, it & 7, smem);
  int qrt, qct;
  for (int qi_ = 0; xcd_tile(qi_, 128, 6, qrt, qct); qi_++) {
    {
      const int rt = qrt, ct = qct, r0 = rt * 128, n0 = ct * 64;
      float* rs = (float*)(smem + 49152);
      row_rstd<256>(p.zbuf + (size_t)r0 * ZLD + 768, rs);
      f32x4 acc[4][2];
      zero_acc(acc);
      gemm_acc<128, 64>(acc, p.zbuf + (size_t)r0 * ZLD + 768, ZLD, p.wt_qup + (size_t)layer * 384 * 256 + (size_t)n0 * 256, 256, 256, smem);
      __syncthreads();
      const bool lat = r0 >= T_CTX;
#pragma unroll
      for (int mi = 0; mi < 4; mi++) {
        const int row = wr * 64 + mi * 16 + l15, tok = r0 + row;
        const float rstd = rs[row];
#pragma unroll
        for (int ni = 0; ni < 2; ni++) {
          const int fb = n0 + wc * 32 + ni * 16;
          f32x4 v = acc[mi][ni] * rstd;
          store_h4(p.qm + (size_t)tok * 384 + fb + 4 * g, v[0], v[1], v[2], v[3]);
        }
      }
      __syncthreads();
      if (lat && ct != 0 && ct != 3) {
        const int rc0 = n0 + ((ct == 2 || ct == 5) ? 32 : 0);
        float rx1[8], rx2[8], rcs[8], rsn[8];
#pragma unroll
        for (int q = 0; q < 8; q++) {
          const int i = tid + q * 256, row = i >> 4, e = i & 15, tok = r0 + row;
          const int i8 = e & 7, base = (e < 8) ? 0 : 16;
          const int lpos = (tok - T_CTX) & 2047;
          const int pos = (e < 8) ? (lpos >> 6) : (lpos & 63);
          const h16* ptr = p.qm + (size_t)tok * 384 + rc0 + base + i8;
          rx1[q] = (float)ptr[0]; rx2[q] = (float)ptr[8];
          rcs[q] = p.cs8[(pos * 8 + i8) * 2]; rsn[q] = p.cs8[(pos * 8 + i8) * 2 + 1];
        }
#pragma unroll
        for (int q = 0; q < 8; q++) {
          const int i = tid + q * 256, row = i >> 4, e = i & 15, tok = r0 + row;
          const int i8 = e & 7, base = (e < 8) ? 0 : 16;
          h16* ptr = p.qm + (size_t)tok * 384 + rc0 + base + i8;
          ptr[0] = (h16)(rx1[q] * rcs[q] - rx2[q] * rsn[q]);
          ptr[8] = (h16)(rx1[q] * rsn[q] + rx2[q] * rcs[q]);
        }
      }
      __syncthreads();
    }
  }
  const int kv_nbx = gridDim.x >> 3, kv_x = blockIdx.x & 7;
  for (int kvL = kv_nbx - 1 - (int)(blockIdx.x >> 3); kvL < 144; kvL += kv_nbx) {
    const int it = (kvL < 128) ? (128 * kv_x + kvL) : (1024 + 16 * kv_x + (kvL - 128));
    const int N_KV = 1024;
    {
      const bool cached = it >= N_KV;
      int rt, ct;
      const h16 *A, *Bt;
      int lda;
      if (!cached) { rt = it >> 3; ct = it & 7; A = p.zbuf + (size_t)(rt * 128) * ZLD + 1024; lda = ZLD; Bt = p.wt_kvup + (size_t)layer * 512 * 128; }
      else { int i2 = it - N_KV; rt = i2 >> 3; ct = i2 & 7; int b = rt >> 2, k0 = (rt & 3) * 128; A = p.ckv_c + ((size_t)(b * 2 + layer) * 512 + k0) * 128; lda = 128; Bt = p.wt_kvraw + (size_t)layer * 512 * 128; }
      const int r0 = rt * 128, n0 = ct * 64;
      float* rs = (float*)(smem + 49152);
      if (!cached) {
        row_rstd<128>(p.zbuf + (size_t)r0 * ZLD + 1024, rs);
      } else {
        if (tid < 128) rs[tid] = 1.f;
      }
      f32x4 acc[4][2];
      zero_acc(acc);
      gemm_acc<128, 64>(acc, A, lda, Bt + (size_t)n0 * 128, 128, 128, smem);
      const int head = n0 >> 7;
      const bool vtype = (n0 & 64) != 0;
#pragma unroll
      for (int mi = 0; mi < 4; mi++) {
        const int row = wr * 64 + mi * 16 + l15, tok = r0 + row;
        const float rstd = rs[row];
#pragma unroll
        for (int ni = 0; ni < 2; ni++) {
          const int d0 = wc * 32 + ni * 16 + 4 * g;
          f32x4 v = acc[mi][ni] * rstd;
          if (!vtype) {
            h16* dst = p.kmla + (cached ? (size_t)T_ALL * 384 : (size_t)0);
            store_h4(dst + (size_t)tok * 384 + head * 96 + d0, v[0], v[1], v[2], v[3]);
          } else {
            h16* vt; int bb, l, Ls;
            int voff;
            if (cached) { voff = 4194304; bb = tok >> 9; l = tok & 511; Ls = 512; }
            else if (tok < T_CTX) { voff = 0; bb = tok >> 8; l = tok & 255; Ls = 256; }
            else { voff = 2097152; bb = (tok - T_CTX) >> 11; l = (tok - T_CTX) & 2047; Ls = 2048; }
            vt = p.vt_m_ctx + voff;
#pragma unroll
            for (int j = 0; j < 4; j++) vt[((size_t)(bb * 4 + head) * 64 + d0 + j) * Ls + l] = (h16)v[j];
          }
        }
      }
      if (ct == 0 && !cached && r0 < T_CTX) {
        const float* gk = p.mla_kv_norm + layer * 128;
#pragma unroll
        for (int q = 0; q < 8; q++) {
          const int i = tid + q * 256, row = i >> 4, k = (i & 15) * 8, tok = r0 + row;
          const h16x8 zv = *(const h16x8*)(p.zbuf + (size_t)tok * ZLD + 1024 + k);
          const float rr = rs[row];
          const f32x4 g0 = *(const f32x4*)(gk + k), g1 = *(const f32x4*)(gk + k + 4);
          float* dst = p.out + O_CKV + ((size_t)((tok >> 8) * 2 + layer) * 256 + (tok & 255)) * 128 + k;
          __builtin_nontemporal_store(f32x4{(float)zv[0] * rr * g0[0], (float)zv[1] * rr * g0[1], (float)zv[2] * rr * g0[2], (float)zv[3] * rr * g0[3]}, (f32x4*)dst);
          __builtin_nontemporal_store(f32x4{(float)zv[4] * rr * g1[0], (float)zv[5] * rr * g1[1], (float)zv[6] * rr * g1[2], (float)zv[7] * rr * g1[3]}, (f32x4*)(dst + 4));
        }
      }
      if (ct == 1) {
        float kx1[8], kx2[8];
#pragma unroll
        for (int q = 0; q < 8; q++) {
          const int i = tid + q * 256, row = i >> 4, e = i & 15, tok = r0 + row;
          if (cached) {
            const int bb = tok >> 9, key = tok & 511;
            const float* src = p.cache_mla_kpe + ((size_t)(bb * 2 + layer) * 512 + key) * 32;
            kx1[q] = src[e]; kx2[q] = src[16 + e];
          } else {
            const h16* src = p.zbuf + (size_t)tok * ZLD + 1152;
            const int i8 = e & 7, base = (e < 8) ? 0 : 16;
            float x1 = (float)src[base + i8], x2 = (float)src[base + 8 + i8];
            if (tok >= T_CTX) {
              const int lpos = (tok - T_CTX) & 2047;
              const int pos = (e < 8) ? (lpos >> 6) : (lpos & 63);
              const float cs = p.cs8[(pos * 8 + i8) * 2], sn = p.cs8[(pos * 8 + i8) * 2 + 1];
              const float o1 = x1 * cs - x2 * sn, o2 = x1 * sn + x2 * cs;
              x1 = o1; x2 = o2;
            }
            kx1[q] = x1; kx2[q] = x2;
          }
        }
#pragma unroll
        for (int q = 0; q < 8; q++) {
          const int i = tid + q * 256, row = i >> 4, e = i & 15, tok = r0 + row;
          const h16 v1 = (h16)kx1[q], v2 = (h16)kx2[q];
          if (cached) {
            h16* dst = p.kmla + (size_t)T_ALL * 384 + (size_t)tok * 384;
#pragma unroll
            for (int h = 0; h < 4; h++) { dst[h * 96 + 64 + e] = v1; dst[h * 96 + 80 + e] = v2; }
          } else {
            const int i8 = e & 7, base = (e < 8) ? 0 : 16;
            h16* dst = p.kmla + (size_t)tok * 384;
#pragma unroll
            for (int h = 0; h < 4; h++) { dst[h * 96 + 64 + base + i8] = v1; dst[h * 96 + 64 + base + 8 + i8] = v2; }
          }
        }
      }
      __syncthreads();
    }
  }
  for (int it = (blockIdx.x + (gridDim.x >> 1)) % gridDim.x; it < 128; it += gridDim.x) {
    {
      const int t0 = T_CTX + it * 64;
#pragma unroll
      for (int q = 0; q < 6; q++) {
        const int i = tid + q * 256;
        const int tl = i / 24, vi = i % 24;
        const int tok = t0 + tl, lpos = (tok - T_CTX) & 2047;
        const int head = vi >> 2, part = (vi >> 1) & 1, grp = vi & 1;
        const int pos = part ? (lpos & 63) : (lpos >> 6);
        h16* ptr = p.zbuf + (size_t)tok * ZLD + head * 64 + part * 32 + grp * 8;
        const h16x8 x1 = *(const h16x8*)ptr, x2 = *(const h16x8*)(ptr + 16);
        const float* tb = p.cs16 + (pos * 16 + grp * 8) * 2;
        h16x8 o1, o2;
#pragma unroll
        for (int j = 0; j < 8; j++) {
          const float cs = tb[2 * j], sn = tb[2 * j + 1];
          o1[j] = (h16)((float)x1[j] * cs - (float)x2[j] * sn);
          o2[j] = (h16)((float)x1[j] * sn + (float)x2[j] * cs);
        }
        *(h16x8*)ptr = o1;
        *(h16x8*)(ptr + 16) = o2;
      }
    }
  }
}

struct Seg { const h16* K; const h16* Vt; int ldk, ldv, ntiles; };

#define LDSP(x) ((__attribute__((address_space(3))) unsigned*)(x))
template <int DQK, int MODE, int QREP>
__device__ void attn_item(const h16* __restrict__ Q, int ldq, Seg s0, Seg s1, float scale_l2, bool has_sink, float sink_l2,
                          int qpos0, int kpos0, const float* __restrict__ rpb_h, int qrow, int krow0,
                          h16* __restrict__ outp, const h16* __restrict__ gate, char* smem) {
  constexpr int KCH = DQK / 8;
  constexpr int KROWB = DQK * 2;
  constexpr int KPT = 64 * KCH / 256;
  constexpr int KBYTES = 64 * KROWB;
  constexpr int STAGE = KBYTES + 8192;
  constexpr int NKS = DQK / 32;
  constexpr int G = KPT + 2;
  const int tid = otid(), lane = tid & 63, wid = tid >> 6, l15 = lane & 15, g = lane >> 4;
  float* sbias = (float*)(smem + 49152);
  if (MODE == 2) {
    for (int i = tid; i < 15 * 31; i += 256) sbias[i] = rpb_h[i] * LOG2E;
  }
  h16x8 qf[QREP][NKS];
#pragma unroll
  for (int qi = 0; qi < QREP; qi++)
#pragma unroll
    for (int ks = 0; ks < NKS; ks++) {
      h16x8 qv = *(const h16x8*)(Q + (size_t)(wid * 16 * QREP + qi * 16 + l15) * ldq + ks * 32 + 8 * g);
#pragma unroll
      for (int j = 0; j < 8; j++) qv[j] = (h16)((float)qv[j] * scale_l2);
      qf[qi][ks] = qv;
    }
  float m[QREP], lsum[QREP];
  f32x4 o[QREP][4];
#pragma unroll
  for (int qi = 0; qi < QREP; qi++) {
    m[qi] = has_sink ? sink_l2 : -1e30f;
    lsum[qi] = (has_sink && g == 0) ? 1.f : 0.f;
#pragma unroll
    for (int i = 0; i < 4; i++) o[qi][i] = f32x4{0.f, 0.f, 0.f, 0.f};
  }
  const int ntot = s0.ntiles + s1.ntiles;
  const int lsl = (tid & 7) ^ ((tid >> 4) & 7);
#define TILE_PTRS(ti_) \
    const h16 *kp, *vp; int ldk, ldv; \
    if ((ti_) < s0.ntiles) { kp = s0.K + (size_t)(ti_) * 64 * s0.ldk; vp = s0.Vt + (ti_) * 64; ldk = s0.ldk; ldv = s0.ldv; } \
    else { int t2 = (ti_) - s0.ntiles; kp = s1.K + (size_t)t2 * 64 * s1.ldk; vp = s1.Vt + t2 * 64; ldk = s1.ldk; ldv = s1.ldv; }
#define ATT_ISSUE(ti_, st_)                                                                                         \
  {                                                                                                                 \
    TILE_PTRS(ti_)                                                                                                  \
    char* dk_ = smem + (st_) * STAGE + tid * 16;                                                                    \
    _Pragma("unroll") for (int i = 0; i < KPT; i++) {                                                               \
      const h16* src_;                                                                                              \
      if (DQK == 64) src_ = kp + (size_t)((tid >> 3) + i * 32) * ldk + lsl * 8;                                     \
      else { const int c_ = tid + i * 256; src_ = kp + (size_t)(c_ / KCH) * ldk + (c_ % KCH) * 8; }                 \
      __builtin_amdgcn_global_load_lds((const unsigned*)src_, LDSP(dk_ + i * 4096), 16, 0, 0);                      \
    }                                                                                                               \
    _Pragma("unroll") for (int i = 0; i < 2; i++)                                                                   \
      __builtin_amdgcn_global_load_lds((const unsigned*)(vp + (size_t)((tid >> 3) + i * 32) * ldv + lsl * 8), LDSP(dk_ + KBYTES + i * 4096), 16, 0, 0); \
  }
  asm volatile("s_waitcnt vmcnt(0)" ::: "memory");
  ATT_ISSUE(0, 0)
  if (ntot > 1) ATT_ISSUE(1, 1)
  int st = 0;
  for (int ti = 0; ti < ntot; ti++) {
    if (ti + 1 < ntot) asm volatile("s_waitcnt vmcnt(%0)" ::"n"(G) : "memory");
    else asm volatile("s_waitcnt vmcnt(0)" ::: "memory");
    asm volatile("s_waitcnt lgkmcnt(0)" ::: "memory");
    __builtin_amdgcn_s_barrier();
    asm volatile("" ::: "memory");
    if (ti + 2 < ntot) { const int st2 = (st == 0) ? 2 : st - 1; ATT_ISSUE(ti + 2, st2) }
    const char* sk = smem + st * STAGE;
    const char* sv = sk + KBYTES;
    st = (st == 2) ? 0 : st + 1;
    f32x4 s[QREP][4];
#pragma unroll
    for (int kf = 0; kf < 4; kf++) {
#pragma unroll
      for (int qi = 0; qi < QREP; qi++) s[qi][kf] = f32x4{0.f, 0.f, 0.f, 0.f};
#pragma unroll
      for (int ks = 0; ks < NKS; ks++) {
        const int row = kf * 16 + l15, sl = ks * 4 + g;
        const int off = (DQK == 64) ? SWZ(row, sl) : (row * KROWB + sl * 16);
        h16x8 ka = *(const h16x8*)(sk + off);
#pragma unroll
        for (int qi = 0; qi < QREP; qi++) s[qi][kf] = __builtin_amdgcn_mfma_f32_16x16x32_f16(ka, qf[qi][ks], s[qi][kf], 0, 0, 0);
      }
    }
    const bool masked = (MODE != 0) && (ti < s0.ntiles);
    typedef float f32x2 __attribute__((ext_vector_type(2)));
    h16x8 pb[QREP][2];
    float alpha[QREP];
#pragma unroll
    for (int qi = 0; qi < QREP; qi++) {
      if (MODE != 0 && masked) {
#pragma unroll
        for (int kf = 0; kf < 4; kf++)
#pragma unroll
          for (int j = 0; j < 4; j++) {
            float x = s[qi][kf][j];
            if (MODE == 1) {
              int kpos = kpos0 + ti * 64 + kf * 16 + 4 * g + j, qpos = qpos0 + wid * 16 * QREP + qi * 16 + l15;
              int d = qpos - kpos;
              if (d > 128 || d < -128) x = -INFINITY;
            }
            if (MODE == 2) {
              int ck = kf * 16 + 4 * g + j, cq = wid * 16 * QREP + qi * 16 + l15;
              int cs = min(max(cq - 8, 0), 48);
              int rel = ck - cs;
              if (rel < 0 || rel >= 16) x = -INFINITY;
              else {
                int co = min(max(ck - cq, -15), 15) + 15;
                int ro = (krow0 + ti) - qrow + 7;
                x += sbias[ro * 31 + co];
              }
            }
            s[qi][kf][j] = x;
          }
      }
      float mx = fmaxf(fmaxf(fmaxf(s[qi][0][0], s[qi][0][1]), fmaxf(s[qi][0][2], s[qi][0][3])), fmaxf(fmaxf(s[qi][1][0], s[qi][1][1]), fmaxf(s[qi][1][2], s[qi][1][3])));
      mx = fmaxf(mx, fmaxf(fmaxf(fmaxf(s[qi][2][0], s[qi][2][1]), fmaxf(s[qi][2][2], s[qi][2][3])), fmaxf(fmaxf(s[qi][3][0], s[qi][3][1]), fmaxf(s[qi][3][2], s[qi][3][3]))));
      mx = fmaxf(mx, __shfl_xor(mx, 16));
      mx = fmaxf(mx, __shfl_xor(mx, 32));
      const float mnew = fmaxf(m[qi], mx);
      alpha[qi] = __builtin_amdgcn_exp2f(m[qi] - mnew);
      m[qi] = mnew;
      const f32x2 mn2 = {mnew, mnew};
      f32x2 ps2 = {0.f, 0.f};
#pragma unroll
      for (int kf = 0; kf < 4; kf++)
#pragma unroll
        for (int jp = 0; jp < 2; jp++) {
          f32x2 d2 = f32x2{s[qi][kf][2 * jp], s[qi][kf][2 * jp + 1]} - mn2;
          f32x2 e2 = {__builtin_amdgcn_exp2f(d2[0]), __builtin_amdgcn_exp2f(d2[1])};
          ps2 += e2;
          pb[qi][kf >> 1][(kf & 1) * 4 + 2 * jp] = (h16)e2[0];
          pb[qi][kf >> 1][(kf & 1) * 4 + 2 * jp + 1] = (h16)e2[1];
        }
      lsum[qi] = lsum[qi] * alpha[qi] + (ps2[0] + ps2[1]);
    }
#pragma unroll
    for (int df = 0; df < 4; df++) {
#pragma unroll
      for (int qi = 0; qi < QREP; qi++) o[qi][df] = o[qi][df] * alpha[qi];
#pragma unroll
      for (int kk = 0; kk < 2; kk++) {
        const int row = df * 16 + l15;
        const int c0 = 8 * kk + g, c1 = 8 * kk + 4 + g;
        h16x4 v0 = *(const h16x4*)(sv + SWZ(row, c0 >> 1) + (c0 & 1) * 8);
        h16x4 v1 = *(const h16x4*)(sv + SWZ(row, c1 >> 1) + (c1 & 1) * 8);
        h16x8 va = {v0[0], v0[1], v0[2], v0[3], v1[0], v1[1], v1[2], v1[3]};
#pragma unroll
        for (int qi = 0; qi < QREP; qi++) o[qi][df] = __builtin_amdgcn_mfma_f32_16x16x32_f16(va, pb[qi][kk], o[qi][df], 0, 0, 0);
      }
    }
  }
  asm volatile("" ::: "memory");
  __builtin_amdgcn_s_barrier();
  asm volatile("" ::: "memory");
#pragma unroll
  for (int qi = 0; qi < QREP; qi++) {
    float l = lsum[qi];
    l += __shfl_xor(l, 16);
    l += __shfl_xor(l, 32);
    const float inv = 1.f / l;
    const int qr = wid * 16 * QREP + qi * 16 + l15;
    h16x4 gva[4];
#pragma unroll
    for (int df = 0; df < 4; df++) gva[df] = *(const h16x4*)(gate + (size_t)qr * ZLD + df * 16 + 4 * g);
#pragma unroll
    for (int df = 0; df < 4; df++) {
      const int d = df * 16 + 4 * g;
      const h16x4 gv = gva[df];
      store_h4(outp + (size_t)qr * 1024 + d, o[qi][df][0] * inv * siluf_((float)gv[0]), o[qi][df][1] * inv * siluf_((float)gv[1]),
               o[qi][df][2] * inv * siluf_((float)gv[2]), o[qi][df][3] * inv * siluf_((float)gv[3]));
    }
  }
}

__device__ void phase_att(const Params p, int layer, char* smem) {
  const float sc64 = 0.125f * LOG2E, sc96 = 0.10206207261596575f * LOG2E;
  Seg s0, s1;
  for (int vb = blockIdx.x; vb < 512; vb += gridDim.x) {
    const bool first = vb < 256;
    const int i = (vb & 7) * 32 + ((vb >> 3) & 31);
    {
      const int idx = vb;
      s5_item(p, layer, 2, idx >> 7, (idx >> 3) & 15, idx & 7, -1, 0, 0, 0, smem);
    }
    if (first)
    for (int e3 = 0; e3 < 2; e3++) {
      const bool first = e3 == 0;
      int b, h, tokb, tok0;
      if (first) { b = i >> 6; h = (i >> 4) & 3; tokb = T_CTX + b * 2048; tok0 = tokb + (i & 15) * 128; }
      else { b = i >> 3; h = (i >> 1) & 3; tokb = b * 256; tok0 = tokb + (i & 1) * 128; }
      s0.K = p.kmla + (size_t)tokb * 384 + h * 96; s0.ldk = 384;
      if (first) {
        s0.Vt = p.vt_m_lat + (size_t)(b * 4 + h) * 64 * 2048; s0.ldv = 2048; s0.ntiles = 32;
        s1.K = p.kcx + (size_t)(b * 512) * 384 + h * 96; s1.ldk = 384; s1.Vt = p.vcx_t + (size_t)(b * 4 + h) * 64 * 512; s1.ldv = 512; s1.ntiles = 8;
      } else {
        s0.Vt = p.vt_m_ctx + (size_t)(b * 4 + h) * 64 * 256; s0.ldv = 256; s0.ntiles = 4;
        s1.K = s0.K; s1.Vt = s0.Vt; s1.ldk = 0; s1.ldv = 0; s1.ntiles = 0;
      }
      attn_item<96, 0, 2>(p.qm + (size_t)tok0 * 384 + h * 96, 384, s0, s1, sc96, false, 0.f, 0, 0, nullptr, 0, 0,
                          p.br + (size_t)tok0 * 1024 + 256 + h * 64, p.zbuf + (size_t)tok0 * ZLD + 1184 + h * 64, smem);
    }
    if (first)
    for (int e2 = 0; e2 < 2; e2++) {
      const bool isA = e2 == 0;
      const int b = i >> 3, h = (i >> 1) & 3, qt = i & 1;
      const int tokb = b * 256, tok0 = tokb + qt * 128;
      int qcol, kcol, gcol, bcol;
      if (isA) { const int hk = h >> 1; qcol = h * 64; kcol = 256 + hk * 64; gcol = 512 + h * 64; bcol = h * 64; s0.Vt = p.vt_a_ctx + (size_t)(b * 2 + hk) * 64 * 256; }
      else { qcol = 1952 + h * 64; kcol = 2208 + h * 64; gcol = 2720 + h * 64; bcol = 768 + h * 64; s0.Vt = p.vt_d_ctx + (size_t)(b * 4 + h) * 64 * 256; }
      s0.K = p.zbuf + (size_t)tokb * ZLD + kcol; s0.ldk = ZLD; s0.ldv = 256; s0.ntiles = 4;
      s1.K = s0.K; s1.Vt = s0.Vt; s1.ldk = 0; s1.ldv = 0; s1.ntiles = 0;
      const float sink = isA ? p.a_sink[layer * 4 + h] * LOG2E : 0.f;
      attn_item<64, 0, 2>(p.zbuf + (size_t)tok0 * ZLD + qcol, ZLD, s0, s1, sc64, isA, sink, 0, 0, nullptr, 0, 0,
                          p.br + (size_t)tok0 * 1024 + bcol, p.zbuf + (size_t)tok0 * ZLD + gcol, smem);
    }
    if (!first) {
      for (int e = 0; e < 2; e++) {
        const int idx = 2 * i + e;
        const int b = idx >> 7, h = (idx >> 5) & 3, qt = idx & 31;
        const int tokb = T_CTX + b * 2048, tok0 = tokb + qt * 64;
        const int r = qt, rs = min(max(r - 4, 0), 24);
        s0.K = p.zbuf + (size_t)(tokb + rs * 64) * ZLD + 2208 + h * 64; s0.ldk = ZLD; s0.Vt = p.vt_d_lat + (size_t)(b * 4 + h) * 64 * 2048 + rs * 64; s0.ldv = 2048; s0.ntiles = 8;
        s1.K = p.ck_n + (size_t)((b * 2 + layer) * 512) * 256 + h * 64; s1.ldk = 256; s1.Vt = p.cvt_n + (size_t)((b * 2 + layer) * 4 + h) * 64 * 512; s1.ldv = 512; s1.ntiles = 8;
        attn_item<64, 2, 1>(p.zbuf + (size_t)tok0 * ZLD + 1952 + h * 64, ZLD, s0, s1, sc64, false, 0.f, 0, 0,
                            p.na_rpb + (size_t)(layer * 4 + h) * 15 * 31, r, rs,
                            p.br + (size_t)tok0 * 1024 + 768 + h * 64, p.zbuf + (size_t)tok0 * ZLD + 2720 + h * 64, smem);
      }
      for (int e = 0; e < 2; e++) {
        const int idx = 2 * i + e;
        const int b = idx >> 7, h = (idx >> 5) & 3, qt = idx & 31;
        const int tokb = T_CTX + b * 2048, tok0 = tokb + qt * 64;
        const int hk = h >> 1, q0 = qt * 64;
        const int ks = max(0, q0 - 128), ke = min(2048, q0 + 192);
        s0.K = p.zbuf + (size_t)(tokb + ks) * ZLD + 256 + hk * 64; s0.ldk = ZLD; s0.Vt = p.vt_a_lat + (size_t)(b * 2 + hk) * 64 * 2048 + ks; s0.ldv = 2048; s0.ntiles = (ke - ks) >> 6;
        s1.K = p.ck_a + (size_t)((b * 2 + layer) * 512) * 128 + hk * 64; s1.ldk = 128; s1.Vt = p.cvt_a + (size_t)((b * 2 + layer) * 2 + hk) * 64 * 512; s1.ldv = 512; s1.ntiles = 8;
        attn_item<64, 1, 1>(p.zbuf + (size_t)tok0 * ZLD + h * 64, ZLD, s0, s1, sc64, true, p.a_sink[layer * 4 + h] * LOG2E, q0, ks, nullptr, 0, 0,
                            p.br + (size_t)tok0 * 1024 + h * 64, p.zbuf + (size_t)tok0 * ZLD + 512 + h * 64, smem);
      }
    }
  }
}

__device__ void phase_glu(const Params p, int layer, char* smem) {
  const int lane = otid() & 63, wid = otid() >> 6, wr = wid >> 1, wc = wid & 1, l15 = lane & 15, g = lane >> 4;
  int rt, ct;
  for (int ti = 0; xcd_tile(ti, 128, 4, rt, ct); ti++) {
    const int r0 = rt * 128, n0 = ct * 128;
    f32x4 acc[4][4];
    zero_acc(acc);
    gemm_acc<128, 128>(acc, p.zbuf + (size_t)r0 * ZLD + 1440, ZLD, p.wt_glu + (size_t)layer * 512 * 256 + (size_t)n0 * 256, 256, 256, smem);
    h16x4 cgv[4][2];
#pragma unroll
    for (int mi = 0; mi < 4; mi++)
#pragma unroll
      for (int np = 0; np < 2; np++) {
        const int tok = r0 + wr * 64 + mi * 16 + l15, col = ((n0 + wc * 64 + np * 32) >> 5) * 16 + 4 * g;
        cgv[mi][np] = *(const h16x4*)(p.zbuf + (size_t)tok * ZLD + 1696 + col);
      }
#pragma unroll
    for (int mi = 0; mi < 4; mi++) {
      const int tok = r0 + wr * 64 + mi * 16 + l15;
#pragma unroll
      for (int np = 0; np < 2; np++) {
        const int pn = n0 + wc * 64 + np * 32;
        const int col = (pn >> 5) * 16 + 4 * g;
        f32x4 val = acc[mi][np * 2], gt = acc[mi][np * 2 + 1];
        const h16x4 cg_ = cgv[mi][np];
        store_h4(p.br + (size_t)tok * 1024 + 512 + col, val[0] * sigmoidf_(gt[0]) * siluf_((float)cg_[0]),
                 val[1] * sigmoidf_(gt[1]) * siluf_((float)cg_[1]), val[2] * sigmoidf_(gt[2]) * siluf_((float)cg_[2]),
                 val[3] * sigmoidf_(gt[3]) * siluf_((float)cg_[3]));
      }
    }
  }
}

__device__ void phase_g3(const Params p, int layer, char* smem) {
  const int lane = otid() & 63, wid = otid() >> 6, wr = wid >> 1, wc = wid & 1, l15 = lane & 15, g = lane >> 4;
  const h16* Wm = p.wt_merge + (size_t)layer * 4096 * 1024;
  const h16* Wb = p.wt_branch + (size_t)layer * 4 * 1024 * 256;
  h16* mbuf = p.zbuf;
  typedef __attribute__((ext_vector_type(2))) unsigned u32x2;
  int rt, ct;
  for (int ti = 0; xcd_tile(ti, 128, 8, rt, ct); ti++) {
    const int r0 = rt * 128, d0 = ct * 128;
    h16x4 macc[4][4];
#pragma unroll
    for (int mi = 0; mi < 4; mi++)
#pragma unroll
      for (int ni = 0; ni < 4; ni++) macc[mi][ni] = h16x4{(h16)0.f, (h16)0.f, (h16)0.f, (h16)0.f};
#pragma unroll 1
    for (int k = 0; k < 4; k++) {
      u32x2 sg[4][4];
      {
        f32x4 a1[4][4];
        zero_acc(a1);
        gemm_acc<128, 128, true>(a1, p.hbuf + (size_t)r0 * 1024, 1024, Wm + (size_t)(k * 1024 + d0) * 1024, 1024, 1024, smem);
#pragma unroll
        for (int mi = 0; mi < 4; mi++)
#pragma unroll
          for (int ni = 0; ni < 4; ni++) {
            h16x4 hv = {(h16)sigmoidf_(a1[mi][ni][0]), (h16)sigmoidf_(a1[mi][ni][1]), (h16)sigmoidf_(a1[mi][ni][2]), (h16)sigmoidf_(a1[mi][ni][3])};
            sg[mi][ni] = __builtin_bit_cast(u32x2, hv);
          }
      }
      f32x4 a2[4][4];
      zero_acc(a2);
      gemm_acc<128, 128, true>(a2, p.br + (size_t)r0 * 1024 + k * 256, 1024, Wb + (size_t)(k * 1024 + d0) * 256, 256, 256, smem);
#pragma unroll
      for (int mi = 0; mi < 4; mi++)
#pragma unroll
        for (int ni = 0; ni < 4; ni++) {
          const h16x4 hv = __builtin_bit_cast(h16x4, sg[mi][ni]);
          const h16x4 a2h = {(h16)a2[mi][ni][0], (h16)a2[mi][ni][1], (h16)a2[mi][ni][2], (h16)a2[mi][ni][3]};
          macc[mi][ni] = hv * a2h + macc[mi][ni];
        }
    }
#pragma unroll
    for (int mi = 0; mi < 4; mi++)
#pragma unroll
      for (int ni = 0; ni < 4; ni++) {
        const int tok = r0 + wr * 64 + mi * 16 + l15, col = d0 + wc * 64 + ni * 16 + 4 * g;
        *(h16x4*)(mbuf + (size_t)tok * 1024 + col) = macc[mi][ni];
      }
  }
}

__device__ void phase_g4(const Params p, int layer, char* smem) {
  const int lane = otid() & 63, wid = otid() >> 6, wr = wid >> 1, wc = wid & 1, l15 = lane & 15, g = lane >> 4;
  const h16* Wo = p.wt_out + (size_t)layer * 1048576;
  const h16* mbuf = p.zbuf;
  int rt, ct;
  for (int ti = 0; xcd_tile(ti, 128, 8, rt, ct); ti++) {
    const int r0 = rt * 128, n0 = ct * 128;
    f32x4 acc[4][4];
    zero_acc(acc);
    gemm_acc<128, 128>(acc, mbuf + (size_t)r0 * 1024, 1024, Wo + (size_t)n0 * 1024, 1024, 1024, smem);
    f32x4 gv[4];
    {
      const float* gt = p.modv + (layer * 5 + cond_of(r0)) * 3072 + 2048;
#pragma unroll
      for (int ni = 0; ni < 4; ni++) gv[ni] = *(const f32x4*)(gt + n0 + wc * 64 + ni * 16 + 4 * g);
    }
    f32x4 xv[4][4];
#pragma unroll
    for (int mi = 0; mi < 4; mi++) {
      const float* xo = xptr(p, layer, r0 + wr * 64 + mi * 16 + l15);
#pragma unroll
      for (int ni = 0; ni < 4; ni++) xv[mi][ni] = __builtin_nontemporal_load((const f32x4*)(xo + n0 + wc * 64 + ni * 16 + 4 * g));
    }
#pragma unroll
    for (int mi = 0; mi < 4; mi++) {
      const int tok = r0 + wr * 64 + mi * 16 + l15;
#pragma unroll
      for (int ni = 0; ni < 4; ni++) {
        const int col = n0 + wc * 64 + ni * 16 + 4 * g;
        *(f32x4*)(p.out + (size_t)tok * 1024 + col) = xv[mi][ni] + gv[ni] * acc[mi][ni];
      }
    }
  }
}


#define XB_TMO      128
#define XB_XCNT(j)  (256  + 64 * (j))
#define XB_XSUB(j)  (1280 + 64 * (j))
#define XB_XGEN(j)  (2304 + 64 * (j))
#define XB_TOP      3328
#define XB_TOPGEN   3392
#define XCD_BAR_WORDS 3456
#define XB_SPIN_CAP (1u << 20)
__device__ __forceinline__ unsigned xb_ld(unsigned* p) { return __hip_atomic_load(p, __ATOMIC_RELAXED, __HIP_MEMORY_SCOPE_AGENT); }
__device__ __forceinline__ unsigned xb_add(unsigned* p, unsigned v) { return __hip_atomic_fetch_add(p, v, __ATOMIC_RELAXED, __HIP_MEMORY_SCOPE_AGENT); }
__device__ __forceinline__ unsigned xb_xcc_id() { return (unsigned)__builtin_amdgcn_s_getreg((3 << 11) | 20) & 0xFu; }
#define XB_SPIN(cond, bar) do { unsigned _sp = 0; while (cond) { __builtin_amdgcn_s_sleep(1); \
    if ((++_sp & 255u) == 0u) { if (xb_ld(&(bar)[XB_TMO])) break; if (_sp > XB_SPIN_CAP) { atomicAdd(&(bar)[XB_TMO], 1u); break; } } } } while (0)
struct XB { unsigned* bar; unsigned x, nloc, nx; };
__device__ __forceinline__ void xb_post(XB& b, unsigned* bar) {
  b.bar = bar; b.x = xb_xcc_id(); b.nloc = 0u; b.nx = 0u;
  if (otid() == 0) (void)xb_add(&bar[XB_XCNT(b.x)], 1u);
}
__device__ __forceinline__ void xb_complete(unsigned* bar, unsigned x, unsigned& nloc, unsigned& nx) {
  const unsigned G = gridDim.x;
  unsigned sum, cnt, mine, sp = 0u;
  for (;;) {
    sum = 0u; cnt = 0u; mine = 0u;
#pragma unroll
    for (unsigned j = 0; j < 16; ++j) { const unsigned c = xb_ld(&bar[XB_XCNT(j)]); sum += c; cnt += (c > 0u) ? 1u : 0u; mine = (j == x) ? c : mine; }
    if (sum == G) break;
    __builtin_amdgcn_s_sleep(1);
    if ((++sp & 255u) == 0u) { if (xb_ld(&bar[XB_TMO])) break; if (sp > XB_SPIN_CAP) { atomicAdd(&bar[XB_TMO], 1u); break; } }
  }
  nloc = mine > 0u ? mine : 1u; nx = cnt > 0u ? cnt : 1u;
}
__device__ __forceinline__ void xb_sync(XB& b) {
  asm volatile("s_waitcnt vmcnt(0)" ::: "memory");
  __syncthreads();
  if (otid() == 0) {
    unsigned* bar = b.bar;
    __builtin_amdgcn_s_waitcnt(0);
    if (b.nloc == 0u) xb_complete(bar, b.x, b.nloc, b.nx);
    const unsigned nloc = b.nloc, nx = b.nx;
    const unsigned old = xb_add(&bar[XB_XSUB(b.x)], 1u);
    const unsigned gen = old / nloc;
    if (old + 1u == (gen + 1u) * nloc) {
      __builtin_amdgcn_fence(__ATOMIC_RELEASE, "agent");
      asm volatile("s_waitcnt vmcnt(0)" ::: "memory");
      const unsigned og = xb_add(&bar[XB_TOP], 1u);
      const unsigned tg = og / nx;
      if (og + 1u == (tg + 1u) * nx) xb_add(&bar[XB_TOPGEN], 1u);
      else XB_SPIN(xb_ld(&bar[XB_TOPGEN]) == tg, bar);
      __builtin_amdgcn_fence(__ATOMIC_ACQUIRE, "agent");
      xb_add(&bar[XB_XGEN(b.x)], 1u);
      asm volatile("s_waitcnt vmcnt(0)" ::: "memory");
    } else {
      XB_SPIN(xb_ld(&bar[XB_XGEN(b.x)]) == gen, bar);
      __builtin_amdgcn_fence(__ATOMIC_ACQUIRE, "agent");
      asm volatile("s_waitcnt vmcnt(0)" ::: "memory");
    }
  }
  __syncthreads();
}

#define N_PHASES 16
template <int PH>
__device__ __forceinline__ void run_phase(const Params p, char* smem) {
  if constexpr (PH == 0) phase_prep(p, smem);
  else if constexpr (PH == 15) phase_final(p);
  else {
    constexpr int layer = (PH - 1) / 7, s = (PH - 1) % 7;
    if constexpr (s == 0) phase_norm(p, layer);
    else if constexpr (s == 1) phase_g1(p, layer, smem);
    else if constexpr (s == 2) phase_g2(p, layer, smem);
    else if constexpr (s == 3) phase_att(p, layer, smem);
    else if constexpr (s == 4) phase_glu(p, layer, smem);
    else if constexpr (s == 5) phase_g3(p, layer, smem);
    else phase_g4(p, layer, smem);
  }
}

template <int PH>
__global__ void __launch_bounds__(256, 2) phase_kernel(Params p) {
  __shared__ __attribute__((aligned(16))) char smem[65536];
  run_phase<PH>(p, smem);
}

#ifndef MULTI_LAUNCH
#ifndef PROBE_MASK
#define PROBE_MASK 0
#endif
#define PROBE_MULT 4
template <int PH>
__device__ __forceinline__ void run_from(const Params p, char* smem, XB& xb, unsigned long long tprev, unsigned long long& tacc) {
  run_phase<PH>(p, smem);
  if constexpr (PH + 1 < N_PHASES) {
    xb_sync(xb);
  }
  unsigned long long tnow = tprev;
  if constexpr (PROBE_MASK != 0) {
    tnow = wall_clock64();
    if constexpr ((PROBE_MASK >> PH) & 1) tacc += tnow - tprev;
  }
  if constexpr (PH + 1 < N_PHASES) run_from<PH + 1>(p, smem, xb, tnow, tacc);
}

__global__ void __launch_bounds__(256, 2) mega(Params p) {
  __shared__ __attribute__((aligned(16))) char smem[65536];
  XB xb;
  xb_post(xb, p.bar);
  unsigned long long tacc = 0;
  unsigned long long t0 = 0;
  if constexpr (PROBE_MASK != 0) t0 = wall_clock64();
  run_from<0>(p, smem, xb, t0, tacc);
  if constexpr (PROBE_MASK != 0) {
    if (blockIdx.x == 0 && otid() == 0) {
      const unsigned long long tend = wall_clock64();
      while (wall_clock64() - tend < tacc * PROBE_MULT) __builtin_amdgcn_s_sleep(8);
    }
  }
}
#endif

template <int PH>
static void launch_phases(const Params p, int grid, hipStream_t stream) {
  hipLaunchKernelGGL(phase_kernel<PH>, dim3(grid), dim3(256), 0, stream, p);
  if constexpr (PH + 1 < N_PHASES) launch_phases<PH + 1>(p, grid, stream);
}

static inline size_t al256(size_t x) { return (x + 255) & ~(size_t)255; }

extern "C" void kernel_launch(void* const* d_in, const int* in_sizes, int n_in, void* d_out, int out_size, void* d_ws,
                              size_t ws_size, hipStream_t stream) {
  Params p{};
  const float** ip = (const float**)&p;
  for (int i = 0; i < 35; i++) ip[i] = (const float*)d_in[i];
  p.out = (float*)d_out;
  char* w = (char*)d_ws;
  size_t off = 0;
  auto take = [&](size_t bytes) { char* r = w + off; off = al256(off + bytes); return r; };
  p.wt_in = (h16*)take((size_t)2 * 3072 * 1024 * 2);
  p.wt_merge = (h16*)take((size_t)2 * 4096 * 1024 * 2);
  p.wt_branch = (h16*)take((size_t)2 * 4 * 1024 * 256 * 2);
  p.wt_out = (h16*)take((size_t)2 * 1024 * 1024 * 2);
  p.wt_qup = (h16*)take((size_t)2 * 384 * 256 * 2);
  p.wt_kvup = (h16*)take((size_t)2 * 512 * 128 * 2);
  p.wt_kvraw = (h16*)take((size_t)2 * 512 * 128 * 2);
  p.wt_glu = (h16*)take((size_t)2 * 512 * 256 * 2);
  p.hbuf = (h16*)take((size_t)T_ALL * 1024 * 2);
  p.zbuf = (h16*)take((size_t)T_ALL * ZLD * 2);
  p.br = (h16*)take((size_t)T_ALL * 1024 * 2);
  p.qm = (h16*)take((size_t)T_ALL * 384 * 2);
  p.kmla = (h16*)take((size_t)T_ALL * 384 * 2);
  p.kcx = (h16*)take((size_t)2048 * 384 * 2);
  p.vt_a_ctx = (h16*)take((size_t)32 * 2 * 64 * 256 * 2);
  p.vt_a_lat = (h16*)take((size_t)4 * 2 * 64 * 2048 * 2);
  p.vt_d_ctx = (h16*)take((size_t)32 * 4 * 64 * 256 * 2);
  p.vt_d_lat = (h16*)take((size_t)4 * 4 * 64 * 2048 * 2);
  p.vt_m_ctx = (h16*)take((size_t)32 * 4 * 64 * 256 * 2);
  p.vt_m_lat = (h16*)take((size_t)4 * 4 * 64 * 2048 * 2);
  p.vcx_t = (h16*)take((size_t)4 * 4 * 64 * 512 * 2);
  p.ck_a = (h16*)take((size_t)524288 * 2);
  p.cvt_a = (h16*)take((size_t)524288 * 2);
  p.ck_n = (h16*)take((size_t)1048576 * 2);
  p.cvt_n = (h16*)take((size_t)1048576 * 2);
  p.ckv_c = (h16*)take((size_t)524288 * 2);
  p.s5_bmt = (h16*)take((size_t)64 * 128 * 16 * 2);
  p.s5_cmt = (h16*)take((size_t)64 * 16 * 128 * 2);
  p.s5_abar = (float*)take(4096 * 2 * 4);
  p.s5_lamdt = (float*)take(4096 * 2 * 4);
  p.s5_dt = (float*)take(64 * 4);
  p.s5_e = (float*)take((size_t)4 * 16 * 2 * 8 * 128 * 4);
  p.modv = (float*)take(2 * 5 * 3072 * 4);
  p.cs16 = (float*)take(64 * 16 * 2 * 4);
  p.cs8 = (float*)take(64 * 8 * 2 * 4);
  p.bar = (unsigned*)take(XCD_BAR_WORDS * 4);
  if (off > ws_size) { fprintf(stderr, "workspace too small: need %zu have %zu\n", off, ws_size); return; }

  static int grid_blocks = 0;
  if (!grid_blocks) {
    int dev = 0, cus = 0, per_cu = 0;
    (void)hipGetDevice(&dev);
    (void)hipDeviceGetAttribute(&cus, hipDeviceAttributeMultiprocessorCount, dev);
    #ifdef MULTI_LAUNCH
    (void)hipOccupancyMaxActiveBlocksPerMultiprocessor(&per_cu, phase_kernel<3>, 256, 0);
#else
    (void)hipOccupancyMaxActiveBlocksPerMultiprocessor(&per_cu, mega, 256, 0);
#endif
    if (per_cu > 2) per_cu = 2;
    if (per_cu < 1) per_cu = 1;
    grid_blocks = cus * per_cu;
  }
#ifdef MULTI_LAUNCH
  launch_phases<0>(p, grid_blocks, stream);
#else
  (void)hipMemsetAsync(p.bar, 0, XCD_BAR_WORDS * 4, stream);
  void* args[] = {&p};
  hipError_t e = hipLaunchCooperativeKernel((void*)mega, dim3(grid_blocks), dim3(256), args, 0, stream);
  if (e != hipSuccess) fprintf(stderr, "cooperative launch failed: %s (grid %d)\n", hipGetErrorString(e), grid_blocks);
#endif
}
```
